# Optimizing an MI355X kernel written in HIP

```python
import jax, jax.numpy as jnp
from jax import lax
import numpy as np

D_MODEL = 1024
BATCH = 8
SEQ = 4096
DEPTH = 2
DEC_BATCH = 2
DEC_SEQ = 16384
PAST_LEN = 128

HEAD_DIM = 64
N_HEADS_CONV = 8
N_HEADS_SG = 8
D_CONV = N_HEADS_CONV * HEAD_DIM
D_SG = N_HEADS_SG * HEAD_DIM
D_MIX = D_CONV + D_SG
D_IN = 3 * D_CONV + 2 * D_SG
CONV_WIDTH = 3
CHUNK = 128
D_FF = 2816
N_MOD = 9
EPS = 1e-6

kernel_name = "hybrid_conv_sgu_macaron_adaln_encoder"


def rms_norm(x, g):
    xf = x.astype(jnp.float32)
    y = xf * lax.rsqrt(jnp.mean(xf * xf, axis=-1, keepdims=True) + EPS)
    return (y * g.astype(jnp.float32)).astype(x.dtype)


def layer_norm(x, g):
    xf = x.astype(jnp.float32)
    mu = jnp.mean(xf, axis=-1, keepdims=True)
    d = xf - mu
    y = d * lax.rsqrt(jnp.mean(d * d, axis=-1, keepdims=True) + EPS)
    return (y * g.astype(jnp.float32)).astype(x.dtype)


def swiglu(h, w1, w2):
    gate, up = jnp.split(h @ w1, 2, axis=-1)
    return (jax.nn.silu(gate) * up) @ w2


def centred_depthwise_conv3(h, w):
    hp = jnp.pad(h, ((0, 0), (1, 1), (0, 0)))
    return hp[:, :-2] * w[0] + hp[:, 1:-1] * w[1] + hp[:, 2:] * w[2]


def token_mixing(h, w_in, conv_w, sg_norm_g, sg_ws, sg_bs, grp_norm_g, w_out):
    bsz, seq, _ = h.shape
    z = h @ w_in
    b_gate = z[..., :D_CONV]
    c_gate = z[..., D_CONV:2 * D_CONV]
    x_in = z[..., 2 * D_CONV:3 * D_CONV]
    uv = jax.nn.gelu(z[..., 3 * D_CONV:], approximate=False)
    y_a = b_gate * centred_depthwise_conv3(c_gate * x_in, conv_w)
    u, v = uv[..., :D_SG], uv[..., D_SG:]
    v = layer_norm(v, sg_norm_g)
    vc = v.reshape(bsz, seq // CHUNK, CHUNK, N_HEADS_SG, HEAD_DIM)
    sv = jnp.einsum('hpq,bnqhd->bnphd', sg_ws, vc) + sg_bs.T[None, None, :, :, None]
    y_b = u * sv.reshape(bsz, seq, D_SG)
    y = jnp.concatenate([rms_norm(y_a, grp_norm_g[:D_CONV]),
                         rms_norm(y_b, grp_norm_g[D_CONV:])], axis=-1)
    return y @ w_out


def trunk(x, c, ada_w, ada_b, norm_g, ffn_w1, ffn_w2, mix_w_in, conv_w,
          sg_norm_g, sg_ws, sg_bs, grp_norm_g, mix_w_out, final_g):
    bsz = x.shape[0]
    sc = jax.nn.silu(c)
    for l in range(DEPTH):
        mod = (sc @ ada_w[l] + ada_b[l]).reshape(bsz, N_MOD, 1, D_MODEL)

        def modulate(t, k):
            return rms_norm(t, norm_g[l, k]) * (1 + mod[:, 3 * k + 1]) + mod[:, 3 * k]

        x = x + 0.5 * mod[:, 2] * swiglu(modulate(x, 0), ffn_w1[l, 0], ffn_w2[l, 0])
        x = x + mod[:, 5] * token_mixing(modulate(x, 1), mix_w_in[l], conv_w[l], sg_norm_g[l],
                                         sg_ws[l], sg_bs[l], grp_norm_g[l], mix_w_out[l])
        x = x + 0.5 * mod[:, 8] * swiglu(modulate(x, 2), ffn_w1[l, 1], ffn_w2[l, 1])
    return rms_norm(x, final_g)


def setup_inputs(seed: int = 0) -> dict:
    key = jax.random.key(seed)
    ks = jax.random.split(key, 20)
    f32 = jnp.float32
    nrm = lambda k, s, sc: jax.random.normal(k, s, f32) * sc
    return {
        "x_prompt": nrm(ks[0], (BATCH, SEQ, D_MODEL), 1.0),
        "x_sample": nrm(ks[1], (DEC_BATCH, DEC_SEQ, D_MODEL), 1.0),
        "c_prompt": nrm(ks[2], (BATCH, D_MODEL), 1.0),
        "c_sample": nrm(ks[3], (DEC_BATCH, D_MODEL), 1.0),
        "ada_w": nrm(ks[4], (DEPTH, D_MODEL, N_MOD * D_MODEL), 0.5 * D_MODEL ** -0.5),
        "ada_b": nrm(ks[5], (DEPTH, N_MOD * D_MODEL), 0.01),
        "norm_g": 1.0 + nrm(ks[6], (DEPTH, 3, D_MODEL), 0.02),
        "ffn_w1": nrm(ks[7], (DEPTH, 2, D_MODEL, 2 * D_FF), D_MODEL ** -0.5),
        "ffn_w2": nrm(ks[8], (DEPTH, 2, D_FF, D_MODEL), D_FF ** -0.5),
        "mix_w_in": nrm(ks[9], (DEPTH, D_MODEL, D_IN), D_MODEL ** -0.5),
        "conv_w": nrm(ks[10], (DEPTH, CONV_WIDTH, D_CONV), CONV_WIDTH ** -0.5),
        "sg_norm_g": 1.0 + nrm(ks[11], (DEPTH, D_SG), 0.02),
        "sg_ws": nrm(ks[12], (DEPTH, N_HEADS_SG, CHUNK, CHUNK), CHUNK ** -0.5),
        "sg_bs": 1.0 + nrm(ks[13], (DEPTH, N_HEADS_SG, CHUNK), 0.01),
        "grp_norm_g": 1.0 + nrm(ks[14], (DEPTH, D_MIX), 0.02),
        "mix_w_out": nrm(ks[15], (DEPTH, D_MIX, D_MODEL), D_MIX ** -0.5),
        "final_g": 1.0 + nrm(ks[16], (D_MODEL,), 0.02),
    }


def reference(x_prompt, x_sample, c_prompt, c_sample, ada_w, ada_b, norm_g, ffn_w1, ffn_w2,
              mix_w_in, conv_w, sg_norm_g, sg_ws, sg_bs, grp_norm_g, mix_w_out, final_g):
    y_prompt = trunk(x_prompt, c_prompt, ada_w, ada_b, norm_g, ffn_w1, ffn_w2, mix_w_in, conv_w,
                     sg_norm_g, sg_ws, sg_bs, grp_norm_g, mix_w_out, final_g)
    y_sample = trunk(x_sample, c_sample, ada_w, ada_b, norm_g, ffn_w1, ffn_w2, mix_w_in, conv_w,
                     sg_norm_g, sg_ws, sg_bs, grp_norm_g, mix_w_out, final_g)
    return (y_prompt, y_sample)
```

```cpp
#include <hip/hip_runtime.h>
#include <hip/hip_cooperative_groups.h>
#include <cstdio>
#include <cstdint>
namespace cg = cooperative_groups;

#ifndef MK_ONE_LAUNCH
#define MK_ONE_LAUNCH 1
#endif

constexpr int D = 1024, FF = 2816, NUP = 2 * FF, DIN = 2560, ZW = 2048;
constexpr int MTOT = 65536, MP = 32768;
constexpr int NBATCH = 10, NMOD = 9 * D;
constexpr float EPS = 1e-6f;
constexpr int NWAVES = 8, NTHREADS = 512;
constexpr int NPHASES = 25;

constexpr size_t MiB = 1u << 20;
constexpr size_t WS_MOD = 1 * MiB;
constexpr size_t WS_GM = 2 * MiB;
constexpr size_t WS_SV = 3 * MiB;
constexpr size_t WS_RSS = 5 * MiB;
constexpr size_t WS_VST = 9 * MiB;
constexpr size_t WS_WSG = 13 * MiB;
constexpr size_t WS_W1T = 14 * MiB;
constexpr size_t WS_W2T = 58 * MiB;
constexpr size_t WS_WINT = 80 * MiB;
constexpr size_t WS_WOUTT = 90 * MiB;
constexpr size_t WS_XG = 94 * MiB;
constexpr size_t WS_ZH = 222 * MiB;
constexpr size_t WS_END = 478 * MiB;
constexpr int SV_LAYER = NBATCH * (NUP + DIN + NUP);

constexpr int LDS_BYTES = 147456;

namespace pg8 {
#define PG8_LAS __attribute__((address_space(3)))
typedef unsigned short bf16_t;
typedef short bf16x8 __attribute__((ext_vector_type(8)));
typedef float f32x4 __attribute__((ext_vector_type(4)));
typedef float f32x2 __attribute__((ext_vector_type(2)));
typedef unsigned u32x4 __attribute__((ext_vector_type(4)));
typedef unsigned u32x2 __attribute__((ext_vector_type(2)));
constexpr int BM = 256, BK = 64, HALF = 128, HTB = HALF * BK * 2, STAGE_BYTES = 8 * HTB, NXCD = 8, WGM = 8;

__host__ __device__ __forceinline__ int lds_byte(int r, int c) { const int st = (r >> 4) * 2 + (c >> 5), rr = r & 15, cc = c & 31, ob = rr * 64 + cc * 2; return st * 1024 + (ob ^ (((ob >> 9) & 1) << 5)); }
__host__ __device__ __forceinline__ void stage_rc(int b, int& R, int& C) { const int st = b / 1024, sb = b % 1024, swz = sb ^ (((sb >> 9) & 1) << 5); R = (st >> 1) * 16 + swz / 64; C = (st & 1) * 32 + (swz % 64) / 2; }
__host__ __device__ __forceinline__ int perm32(int rho) { const int n = rho >> 4, i = rho & 15; return 8 * (i >> 2) + 4 * n + (i & 3); }

struct Unit { int pm, pn; };
struct Gemm { const bf16_t* A; const bf16_t* Bt; int M, N, K, lda; };

struct StaticOrder {
    int nM, nN, nwg, G, c;
    __host__ __device__ void init(int M, int N, int G_, int c_) { nM = M / BM; nN = N / BM; nwg = nM * nN; G = G_; c = c_; }
    __host__ __device__ bool next(int i, Unit& u) const {
        const long L = (long)i * G + c; if (L >= nwg) return false;
        int wgid = (int)L; { const int q = nwg / NXCD, r = nwg % NXCD, xcd = wgid % NXCD, off = wgid / NXCD; wgid = (xcd < r ? xcd * (q + 1) : r * (q + 1) + (xcd - r) * q) + off; }
        const int nig = WGM * nN, gid = wgid / nig, fm = gid * WGM, gsz = (nM - fm) < WGM ? (nM - fm) : WGM;
        u.pm = fm + ((wgid % nig) % gsz); u.pn = (wgid % nig) / gsz; return true;
    }
};

__device__ __forceinline__ unsigned cvt_pk_bf16(float lo, float hi) { unsigned r; asm volatile("v_cvt_pk_bf16_f32 %0, %1, %2" : "=v"(r) : "v"(lo), "v"(hi)); return r; }
__device__ __forceinline__ f32x2 gelu_pk(f32x2 v) {
    const f32x2 av = __builtin_elementwise_abs(v), d = av * 0.2316418882f + 1.0f;
    f32x2 t; t.x = __builtin_amdgcn_rcpf(d.x); t.y = __builtin_amdgcn_rcpf(d.y);
    f32x2 q = t * 0.5307027145f + (-0.7265760135f); q = q * t + 0.7107068705f; q = q * t + (-0.142248368f); q = q * t + 0.127414796f; q = q * t;
    const f32x2 s = (v * v) * (-0.72134752044f);
    f32x2 e; e.x = __builtin_amdgcn_exp2f(s.x); e.y = __builtin_amdgcn_exp2f(s.y);
    const f32x2 m = v * (q * e), r = v - m;
    f32x2 o; o.x = v.x < 0.f ? m.x : r.x; o.y = v.y < 0.f ? m.y : r.y; return o;
}
__device__ __forceinline__ f32x4 gelu4(f32x4 v) { const f32x2 a = gelu_pk((f32x2){v[0], v[1]}), b = gelu_pk((f32x2){v[2], v[3]}); return (f32x4){a.x, a.y, b.x, b.y}; }
__device__ __forceinline__ float silu1(float g) { return g * __builtin_amdgcn_rcpf(1.0f + __builtin_amdgcn_exp2f(-1.4426950409f * g)); }

template <class Epi, class Sched, bool ALIGN_EPI, bool SP2>
__device__ __forceinline__ void gemm_phase(PG8_LAS unsigned char* lds, const Gemm g, const Sched& S, const Epi& E) {
    int tid = threadIdx.x; asm volatile("" : "+v"(tid));
    const int wid = __builtin_amdgcn_readfirstlane(tid >> 6), lane = tid & 63, wr = wid >> 2, wc = wid & 3, fr = lane & 15, fq = lane >> 4;
    const int K = g.K, nt = K / BK, lda = g.lda;
    unsigned voffA[2], voffB[2];
#pragma unroll
    for (int i = 0; i < 2; ++i) { int R, C; stage_rc(tid * 16 + i * 8192, R, C); const int Rb = Epi::PERM ? ((R & ~31) + perm32(R & 31)) : R;
        voffA[i] = (unsigned)(R * lda + C) * 2u; voffB[i] = (unsigned)(Rb * K + C) * 2u; }
    const size_t kstep = (size_t)(BK * 2);
    const size_t hstepA = (size_t)HALF * lda * 2, hstepB = (size_t)HALF * K * 2;
    const size_t tstepA = 2 * hstepA, tstepB = 2 * hstepB;
    const unsigned ldsw = (unsigned)wid * 1024u;
    const int aoff = lds_byte(wr * 64 + fr, fq * 8), boff = lds_byte(wc * 32 + fr, fq * 8);
#define PG8_SA(b, h) (((b) * 2 + (h)) * HTB)
#define PG8_SB(b, h) ((4 + (b) * 2 + (h)) * HTB)
#define PG8_STAGE(bufoff, gbase, voff) do { _Pragma("unroll") for (int _i = 0; _i < 2; ++_i) \
        __builtin_amdgcn_global_load_lds((const unsigned*)((const char*)(gbase) + (voff)[_i]), (PG8_LAS unsigned*)(lds + (bufoff) + ldsw + _i * 8192), 16, 0, 0); } while (0)
#define PG8_LDA(dst, b, h) do { _Pragma("unroll") for (int m = 0; m < 4; ++m) _Pragma("unroll") for (int k = 0; k < 2; ++k) dst[m][k] = *(const PG8_LAS bf16x8*)(lds + PG8_SA(b, h) + aoff + m * 2048 + k * 1024); } while (0)
#define PG8_LDB(dst, b, h) do { _Pragma("unroll") for (int n = 0; n < 2; ++n) _Pragma("unroll") for (int k = 0; k < 2; ++k) dst[n][k] = *(const PG8_LAS bf16x8*)(lds + PG8_SB(b, h) + boff + n * 2048 + k * 1024); } while (0)
#define PG8_MMA(ai, bj, At, Bt) do { __builtin_amdgcn_s_setprio(1); _Pragma("unroll") for (int m = 0; m < 4; ++m) _Pragma("unroll") for (int n = 0; n < 2; ++n) _Pragma("unroll") for (int k = 0; k < 2; ++k) \
        acc[ai][bj][m][n] = __builtin_amdgcn_mfma_f32_16x16x32_bf16(Bt[n][k], At[m][k], acc[ai][bj][m][n], 0, 0, 0); __builtin_amdgcn_s_setprio(0); } while (0)
#define PG8_WAIT_V(n) asm volatile("s_waitcnt vmcnt(" #n ")" ::: "memory")
#define PG8_WAIT_L(n) asm volatile("s_waitcnt lgkmcnt(" #n ")" ::: "memory")
#define PG8_BAR __builtin_amdgcn_s_barrier()
#define PG8_SCHED __builtin_amdgcn_sched_barrier(0)
    Unit cur, nxt; int ui = 0;
    if (!S.next(0, cur)) return;
    f32x4 acc[2][2][4][2];
#pragma unroll
    for (int a = 0; a < 2; ++a)
#pragma unroll
        for (int b = 0; b < 2; ++b)
#pragma unroll
            for (int m = 0; m < 4; ++m)
#pragma unroll
                for (int n = 0; n < 2; ++n) acc[a][b][m][n] = (f32x4){0.f, 0.f, 0.f, 0.f};
    bf16x8 At[4][2], B0[2][2], B1[2][2];
    const char* cA = (const char*)g.A + (size_t)cur.pm * tstepA; const char* cB = (const char*)g.Bt + (size_t)cur.pn * tstepB;
    if constexpr (SP2) {
        PG8_STAGE(PG8_SB(0, 0), cB, voffB); PG8_STAGE(PG8_SB(0, 1), cB + hstepB, voffB); PG8_STAGE(PG8_SA(0, 0), cA, voffA); PG8_STAGE(PG8_SA(0, 1), cA + hstepA, voffA);
        if (wr == 1) PG8_BAR;
        PG8_WAIT_V(2); PG8_BAR;
        PG8_STAGE(PG8_SB(1, 0), cB + kstep, voffB); PG8_STAGE(PG8_SA(1, 0), cA + kstep, voffA); PG8_STAGE(PG8_SB(1, 1), cB + hstepB + kstep, voffB);
        PG8_WAIT_V(6); PG8_BAR;
    } else {
        PG8_STAGE(PG8_SB(0, 0), cB, voffB); PG8_STAGE(PG8_SA(0, 0), cA, voffA); PG8_STAGE(PG8_SB(0, 1), cB + hstepB, voffB); PG8_STAGE(PG8_SA(0, 1), cA + hstepA, voffA);
        if (wr == 1) PG8_BAR;
        PG8_WAIT_V(4); PG8_BAR;
        PG8_STAGE(PG8_SB(1, 0), cB + kstep, voffB); PG8_STAGE(PG8_SA(1, 0), cA + kstep, voffA); PG8_STAGE(PG8_SB(1, 1), cB + hstepB + kstep, voffB);
        PG8_WAIT_V(6); PG8_BAR;
    }
    for (;;) {
        const bool has_next = S.next(ui + 1, nxt);
        const char* nA = has_next ? (const char*)g.A + (size_t)nxt.pm * tstepA : cA; const char* nB = has_next ? (const char*)g.Bt + (size_t)nxt.pn * tstepB : cB;
        for (int t = 0; t < nt; t += 2) {
            const bool last = (t == nt - 2);
            const char* a1 = cA + (size_t)(t + 1) * kstep;
            const char* a2 = last ? nA : cA + (size_t)(t + 2) * kstep; const char* b2 = last ? nB : cB + (size_t)(t + 2) * kstep;
            const char* a3 = a2 + kstep; const char* b3 = b2 + kstep;
            if constexpr (SP2) {
            PG8_LDB(B0, 0, 0); PG8_LDB(B1, 0, 1); PG8_SCHED; PG8_LDA(At, 0, 0); PG8_STAGE(PG8_SA(1, 1), a1 + hstepA, voffA);
            PG8_WAIT_V(8); PG8_WAIT_L(0); PG8_BAR; PG8_MMA(0, 0, At, B0); PG8_MMA(0, 1, At, B1); PG8_BAR; PG8_SCHED;
            PG8_LDA(At, 0, 1); PG8_STAGE(PG8_SB(0, 0), b2, voffB); PG8_STAGE(PG8_SB(0, 1), b2 + hstepB, voffB); PG8_STAGE(PG8_SA(0, 0), a2, voffA);
            PG8_WAIT_V(8); PG8_WAIT_L(0); PG8_BAR; PG8_MMA(1, 0, At, B0); PG8_MMA(1, 1, At, B1); PG8_BAR; PG8_SCHED;
            PG8_LDB(B0, 1, 0); PG8_LDB(B1, 1, 1); PG8_SCHED; PG8_LDA(At, 1, 0); PG8_STAGE(PG8_SA(0, 1), a2 + hstepA, voffA);
            PG8_WAIT_V(8); PG8_WAIT_L(0); PG8_BAR; PG8_MMA(0, 0, At, B0); PG8_MMA(0, 1, At, B1); PG8_BAR; PG8_SCHED;
            PG8_LDA(At, 1, 1); PG8_STAGE(PG8_SB(1, 0), b3, voffB); PG8_STAGE(PG8_SB(1, 1), b3 + hstepB, voffB); PG8_STAGE(PG8_SA(1, 0), a3, voffA);
            PG8_WAIT_V(8); PG8_WAIT_L(0); PG8_BAR; PG8_MMA(1, 0, At, B0); PG8_MMA(1, 1, At, B1); PG8_BAR; PG8_SCHED;
            } else {
            PG8_LDB(B0, 0, 0); PG8_SCHED; PG8_LDA(At, 0, 0); PG8_STAGE(PG8_SA(1, 1), a1 + hstepA, voffA);
            PG8_WAIT_L(8); PG8_BAR; PG8_WAIT_L(0); PG8_MMA(0, 0, At, B0); PG8_BAR; PG8_SCHED;
            PG8_LDB(B1, 0, 1); PG8_STAGE(PG8_SB(0, 0), b2, voffB);
            PG8_BAR; PG8_WAIT_L(0); PG8_MMA(0, 1, At, B1); PG8_BAR;
            PG8_LDA(At, 0, 1); PG8_STAGE(PG8_SA(0, 0), a2, voffA);
            PG8_BAR; PG8_WAIT_L(0); PG8_MMA(1, 0, At, B0); PG8_BAR; PG8_SCHED;
            PG8_STAGE(PG8_SB(0, 1), b2 + hstepB, voffB);
            PG8_WAIT_V(6); PG8_BAR; PG8_MMA(1, 1, At, B1); PG8_BAR;
            PG8_LDB(B0, 1, 0); PG8_SCHED; PG8_LDA(At, 1, 0); PG8_STAGE(PG8_SA(0, 1), a2 + hstepA, voffA);
            PG8_WAIT_L(8); PG8_BAR; PG8_WAIT_L(0); PG8_MMA(0, 0, At, B0); PG8_BAR; PG8_SCHED;
            PG8_LDB(B1, 1, 1); PG8_STAGE(PG8_SB(1, 0), b3, voffB);
            PG8_BAR; PG8_WAIT_L(0); PG8_MMA(0, 1, At, B1); PG8_BAR;
            PG8_LDA(At, 1, 1); PG8_STAGE(PG8_SA(1, 0), a3, voffA);
            PG8_BAR; PG8_WAIT_L(0); PG8_MMA(1, 0, At, B0); PG8_BAR; PG8_SCHED;
            PG8_STAGE(PG8_SB(1, 1), b3 + hstepB, voffB);
            PG8_WAIT_V(6); PG8_BAR; PG8_MMA(1, 1, At, B1); PG8_BAR;
            }
        }
        if constexpr (ALIGN_EPI) { if (wr == 0) PG8_BAR; }
        E(acc, cur, wr, wc, fr, fq);
        if (!has_next) break;
#pragma unroll
        for (int a = 0; a < 2; ++a)
#pragma unroll
            for (int b = 0; b < 2; ++b)
#pragma unroll
                for (int m = 0; m < 4; ++m)
#pragma unroll
                    for (int n = 0; n < 2; ++n) acc[a][b][m][n] = (f32x4){0.f, 0.f, 0.f, 0.f};
        cur = nxt; cA = nA; cB = nB; ++ui;
        if constexpr (ALIGN_EPI) { if (wr == 1) PG8_BAR; }
    }
    PG8_WAIT_V(0);
    if constexpr (!ALIGN_EPI) { if (wr == 0) PG8_BAR; }
    PG8_BAR;
#undef PG8_SA
#undef PG8_SB
#undef PG8_STAGE
#undef PG8_LDA
#undef PG8_LDB
#undef PG8_MMA
#undef PG8_WAIT_V
#undef PG8_WAIT_L
#undef PG8_BAR
#undef PG8_SCHED
}
}

using pg8::bf16_t; using pg8::f32x4; using pg8::f32x2; using pg8::u32x4; using pg8::u32x2; using pg8::bf16x8; using pg8::cvt_pk_bf16;
#define LAS __attribute__((address_space(3)))

__device__ __forceinline__ int batch_of(int r) { return r < MP ? (r >> 12) : 8 + ((r - MP) >> 14); }
__device__ __forceinline__ float wave_sum(float v) {
#pragma unroll
    for (int o = 1; o < 64; o <<= 1) v += __shfl_xor(v, o);
    return v;
}
__device__ __forceinline__ float bf_lo(unsigned w) { return __uint_as_float(w << 16); }
__device__ __forceinline__ float bf_hi(unsigned w) { return __uint_as_float(w & 0xffff0000u); }
__device__ __forceinline__ float row_rstd(const float* rss, int row, int fq) {
    const f32x4 p = *(const f32x4*)(rss + (size_t)row * 16 + 4 * fq);
    float s = (p[0] + p[1]) + (p[2] + p[3]);
    s += __shfl_xor(s, 16); s += __shfl_xor(s, 32);
    return rsqrtf(s * (1.0f / D) + EPS);
}

struct EpiUp {
    static constexpr bool PERM = true;
    bf16_t* H; const float* rss; const float* S; int rowbase;
    __device__ __forceinline__ void operator()(const f32x4 (&acc)[2][2][4][2], const pg8::Unit& u, int wr, int wc, int fr_, int fq_) const {
        int lane_ = threadIdx.x & 63; asm volatile("" : "+v"(lane_)); const int fr = lane_ & 15, fq = lane_ >> 4;
        const int lrow0 = u.pm * 256 + wr * 64 + fr;
        const int b = batch_of(rowbase + u.pm * 256);
        const float* Sb = S + (size_t)b * NUP + u.pn * 256 + wc * 32 + 8 * fq;
        f32x4 sv[2][2];
#pragma unroll
        for (int bj = 0; bj < 2; ++bj)
#pragma unroll
            for (int n = 0; n < 2; ++n) sv[bj][n] = *(const f32x4*)(Sb + bj * 128 + 4 * n);
        const int hcol = u.pn * 128 + wc * 32 + 8 * fq;
#pragma unroll
        for (int ai = 0; ai < 2; ++ai)
#pragma unroll
            for (int m = 0; m < 4; ++m) {
                const int lr = lrow0 + ai * 128 + m * 16;
                const float rs = row_rstd(rss, rowbase + lr, fq);
                const f32x4 g0 = acc[ai][0][m][0] * rs + sv[0][0], g1 = acc[ai][0][m][1] * rs + sv[0][1];
                const f32x4 u0 = acc[ai][1][m][0] * rs + sv[1][0], u1 = acc[ai][1][m][1] * rs + sv[1][1];
                f32x4 h0, h1;
#pragma unroll
                for (int j = 0; j < 4; ++j) { h0[j] = pg8::silu1(g0[j]) * u0[j]; h1[j] = pg8::silu1(g1[j]) * u1[j]; }
                u32x4 w; w.x = cvt_pk_bf16(h0[0], h0[1]); w.y = cvt_pk_bf16(h0[2], h0[3]); w.z = cvt_pk_bf16(h1[0], h1[1]); w.w = cvt_pk_bf16(h1[2], h1[3]);
                *(u32x4*)(H + (size_t)lr * FF + hcol) = w;
            }
    }
};

struct EpiRes {
    static constexpr bool PERM = false;
    const float* xp; const float* xs; int first;
    float* out; bf16_t* xg; float* rss; const float* gate; const float* gm; float coef; int rowbase;
    __device__ __forceinline__ void operator()(const f32x4 (&acc)[2][2][4][2], const pg8::Unit& u, int wr, int wc, int fr_, int fq_) const {
        int lane_ = threadIdx.x & 63; asm volatile("" : "+v"(lane_)); const int fr = lane_ & 15, fq = lane_ >> 4;
        const int grow0 = rowbase + u.pm * 256 + wr * 64 + fr;
        const int b = batch_of(rowbase + u.pm * 256);
        const int col0 = u.pn * 256 + wc * 32 + 4 * fq;
        const float* gp = gate + (size_t)b * NMOD + col0;
        f32x4 gv[2][2], mv[2][2];
#pragma unroll
        for (int bj = 0; bj < 2; ++bj)
#pragma unroll
            for (int n = 0; n < 2; ++n) { gv[bj][n] = *(const f32x4*)(gp + bj * 128 + n * 16) * coef;
                mv[bj][n] = gm ? *(const f32x4*)(gm + b * D + col0 + bj * 128 + n * 16) : (f32x4){0.f, 0.f, 0.f, 0.f}; }
#pragma unroll
        for (int ai = 0; ai < 2; ++ai)
#pragma unroll
            for (int m = 0; m < 4; ++m) {
                const int grow = grow0 + ai * 128 + m * 16;
                const float* rp = first ? (grow < MP ? xp + (size_t)grow * D : xs + (size_t)(grow - MP) * D) : out + (size_t)grow * D;
                float ss = 0.f;
#pragma unroll
                for (int bj = 0; bj < 2; ++bj)
#pragma unroll
                    for (int n = 0; n < 2; ++n) {
                        const int c = col0 + bj * 128 + n * 16;
                        const f32x4 xi = *(const f32x4*)(rp + c);
                        const f32x4 xo = xi + gv[bj][n] * acc[ai][bj][m][n];
                        *(f32x4*)(out + (size_t)grow * D + c) = xo;
                        ss += (xo[0] * xo[0] + xo[1] * xo[1]) + (xo[2] * xo[2] + xo[3] * xo[3]);
                        if (gm) { const f32x4 o = xo * mv[bj][n]; u32x2 w; w.x = cvt_pk_bf16(o[0], o[1]); w.y = cvt_pk_bf16(o[2], o[3]); *(u32x2*)(xg + (size_t)grow * D + c) = w; }
                    }
                ss += __shfl_xor(ss, 16); ss += __shfl_xor(ss, 32);
                if (fq == 0) rss[(size_t)grow * 16 + u.pn * 4 + wc] = ss;
                asm volatile("" ::: "memory");
            }
    }
};

struct EpiMixIn {
    static constexpr bool PERM = true;
    bf16_t* Z; const float* rss; const float* S; float* vst;
    __device__ __forceinline__ void operator()(const f32x4 (&acc)[2][2][4][2], const pg8::Unit& u, int wr, int wc, int fr_, int fq_) const {
        int lane_ = threadIdx.x & 63; asm volatile("" : "+v"(lane_)); const int fr = lane_ & 15, fq = lane_ >> 4;
        const int row0 = u.pm * 256 + wr * 64 + fr;
        const int b = batch_of(u.pm * 256);
        const float* Sb = S + (size_t)b * DIN + u.pn * 256 + wc * 32 + 8 * fq;
        f32x4 sv[2][2];
#pragma unroll
        for (int bj = 0; bj < 2; ++bj)
#pragma unroll
            for (int n = 0; n < 2; ++n) sv[bj][n] = *(const f32x4*)(Sb + bj * 128 + 4 * n);
        const int pn = u.pn;
        const int lc = wc * 32 + 8 * fq;
#pragma unroll
        for (int ai = 0; ai < 2; ++ai)
#pragma unroll
            for (int m = 0; m < 4; ++m) {
                const int row = row0 + ai * 128 + m * 16;
                const float rs = row_rstd(rss, row, fq);
                f32x4 v00 = acc[ai][0][m][0] * rs + sv[0][0], v01 = acc[ai][0][m][1] * rs + sv[0][1];
                f32x4 v10 = acc[ai][1][m][0] * rs + sv[1][0], v11 = acc[ai][1][m][1] * rs + sv[1][1];
                bf16_t* zr = Z + (size_t)row * ZW;
                if (pn >= 2 && pn < 6) {
                    const f32x4 o0 = v00 * v10, o1 = v01 * v11;
                    u32x4 w; w.x = cvt_pk_bf16(o0[0], o0[1]); w.y = cvt_pk_bf16(o0[2], o0[3]); w.z = cvt_pk_bf16(o1[0], o1[1]); w.w = cvt_pk_bf16(o1[2], o1[3]);
                    *(u32x4*)(zr + 1024 + (pn - 2) * 128 + lc) = w;
                } else {
                    int cbase = pn * 256;
                    if (pn >= 6) {
                        v00 = pg8::gelu4(v00); v01 = pg8::gelu4(v01); v10 = pg8::gelu4(v10); v11 = pg8::gelu4(v11);
                        cbase = pn < 8 ? 512 + (pn - 6) * 256 : 1536 + (pn - 8) * 256;
                    }
                    u32x4 w0, w1;
                    w0.x = cvt_pk_bf16(v00[0], v00[1]); w0.y = cvt_pk_bf16(v00[2], v00[3]); w0.z = cvt_pk_bf16(v01[0], v01[1]); w0.w = cvt_pk_bf16(v01[2], v01[3]);
                    w1.x = cvt_pk_bf16(v10[0], v10[1]); w1.y = cvt_pk_bf16(v10[2], v10[3]); w1.z = cvt_pk_bf16(v11[0], v11[1]); w1.w = cvt_pk_bf16(v11[2], v11[3]);
                    *(u32x4*)(zr + cbase + lc) = w0;
                    *(u32x4*)(zr + cbase + 128 + lc) = w1;
                    if (pn >= 8) {
                        const f32x4 s4 = (v00 + v01) + (v10 + v11);
                        const f32x4 q4 = (v00 * v00 + v01 * v01) + (v10 * v10 + v11 * v11);
                        float s1 = (s4[0] + s4[1]) + (s4[2] + s4[3]), s2 = (q4[0] + q4[1]) + (q4[2] + q4[3]);
                        s1 += __shfl_xor(s1, 16); s1 += __shfl_xor(s1, 32); s2 += __shfl_xor(s2, 16); s2 += __shfl_xor(s2, 32);
                        if (fq == 0) *(f32x2*)(vst + (size_t)row * 16 + ((pn - 8) * 4 + wc) * 2) = (f32x2){s1, s2};
                    }
                }
            }
    }
};

struct Args {
    const float* xp; const float* xs; const float* cp; const float* cs; const float* ada_w; const float* ada_b; const float* norm_g;
    const float* ffn_w1; const float* ffn_w2; const float* mix_w_in; const float* conv_w; const float* sg_norm_g; const float* sg_ws;
    const float* sg_bs; const float* grp_g; const float* mix_w_out; const float* final_g;
    float* out; unsigned char* ws; int ph_lo, ph_hi;
};

__device__ __forceinline__ unsigned f2bf(float f) { unsigned u = __float_as_uint(f); return (u + 0x7fffu + ((u >> 16) & 1u)) >> 16; }
__device__ __forceinline__ unsigned pk2(float lo, float hi) { return f2bf(lo) | (f2bf(hi) << 16); }

__device__ __forceinline__ int map_col(int mode, int s) {
    if (mode == 1) { const int bj = s >= FF ? 1 : 0, h = s - bj * FF; return 256 * (h >> 7) + 128 * bj + (h & 127); }
    if (mode == 2) { if (s >= 512 && s < 1024) { const int q = s - 512; return 512 + 256 * (q >> 7) + (q & 127); }
                     if (s >= 1024 && s < 1536) { const int q = s - 1024; return 512 + 256 * (q >> 7) + 128 + (q & 127); } }
    return s;
}
__device__ __forceinline__ void transpose_item(const float* W, int K, int N, bf16_t* WT, int mode, LAS float* scr, int item, int lane) {
    const int nblk = N / 32, kb = item / nblk, nb = item % nblk, k0 = 64 * kb, n0 = 32 * nb, dn0 = map_col(mode, n0);
#pragma unroll 8
    for (int i = 0; i < 32; ++i) { const int kk = 2 * i + (lane >> 5); scr[kk * 33 + (lane & 31)] = W[(size_t)(k0 + kk) * N + n0 + (lane & 31)]; }
    asm volatile("s_waitcnt lgkmcnt(0)" ::: "memory");
    const int c = lane & 7;
#pragma unroll
    for (int j = 0; j < 4; ++j) { const int n = (lane >> 3) + 8 * j; const LAS float* s = scr + (8 * c) * 33 + n;
        u32x4 o; o.x = pk2(s[0 * 33], s[1 * 33]); o.y = pk2(s[2 * 33], s[3 * 33]); o.z = pk2(s[4 * 33], s[5 * 33]); o.w = pk2(s[6 * 33], s[7 * 33]);
        *(u32x4*)(WT + (size_t)(dn0 + n) * K + k0 + 8 * c) = o; }
    asm volatile("s_waitcnt lgkmcnt(0)" ::: "memory");
}

__device__ __forceinline__ void phase_p0a(const Args& a, LAS unsigned char* lds, int bid, int G) {
    int tid = threadIdx.x; asm volatile("" : "+v"(tid)); const int lane = tid & 63, wave = tid >> 6;
    LAS float* sc = (LAS float*)lds;
    LAS float* scr = (LAS float*)(lds + 49152 + wave * 10240);
    float* mod = (float*)(a.ws + WS_MOD);
    if (bid < 288) {
        for (int i = tid; i < NBATCH * D; i += NTHREADS) { const int b = i >> 10, k = i & 1023; const float c = b < 8 ? a.cp[b * D + k] : a.cs[(b - 8) * D + k]; sc[i] = c / (1.0f + __expf(-c)); }
        __syncthreads();
        for (int it = bid; it < 288; it += G) {
            const int l = it / 144, n0 = (it % 144) * 64;
            const float* W = a.ada_w + (size_t)l * D * NMOD + n0 + lane;
            float acc[NBATCH];
#pragma unroll
            for (int b = 0; b < NBATCH; ++b) acc[b] = 0.f;
#pragma unroll 8
            for (int kk = 0; kk < 128; ++kk) { const int k = wave * 128 + kk; const float w = W[(size_t)k * NMOD];
#pragma unroll
                for (int b = 0; b < NBATCH; ++b) acc[b] += sc[b * D + k] * w; }
#pragma unroll
            for (int b = 0; b < NBATCH; ++b) scr[b * 64 + lane] = acc[b];
            __syncthreads();
            for (int i = tid; i < NBATCH * 64; i += NTHREADS) { const int b = i >> 6, c = i & 63; float s = 0.f;
#pragma unroll
                for (int w = 0; w < NWAVES; ++w) s += ((LAS float*)(lds + 49152 + w * 10240))[b * 64 + c];
                mod[((size_t)l * NBATCH + b) * NMOD + n0 + c] = s + a.ada_b[(size_t)l * NMOD + n0 + c]; }
            __syncthreads();
        }
    }
    const int gw = bid * NWAVES + wave, NGW = G * NWAVES;
    constexpr int I_W1 = (D / 64) * (NUP / 32), I_W2 = (FF / 64) * (D / 32), I_WIN = (D / 64) * (DIN / 32), I_WOUT = (D / 64) * (D / 32);
    constexpr int NITEMS = 4 * I_W1 + 4 * I_W2 + 2 * I_WIN + 2 * I_WOUT;
    for (int it = gw; it < NITEMS; it += NGW) {
        int r = it;
        if (r < 4 * I_W1) { const int mi = r / I_W1; transpose_item(a.ffn_w1 + (size_t)mi * D * NUP, D, NUP, (bf16_t*)(a.ws + WS_W1T) + (size_t)mi * NUP * D, 1, scr, r % I_W1, lane); continue; } r -= 4 * I_W1;
        if (r < 4 * I_W2) { const int mi = r / I_W2; transpose_item(a.ffn_w2 + (size_t)mi * FF * D, FF, D, (bf16_t*)(a.ws + WS_W2T) + (size_t)mi * D * FF, 0, scr, r % I_W2, lane); continue; } r -= 4 * I_W2;
        if (r < 2 * I_WIN) { const int mi = r / I_WIN; transpose_item(a.mix_w_in + (size_t)mi * D * DIN, D, DIN, (bf16_t*)(a.ws + WS_WINT) + (size_t)mi * DIN * D, 2, scr, r % I_WIN, lane); continue; } r -= 2 * I_WIN;
        { const int mi = r / I_WOUT; transpose_item(a.mix_w_out + (size_t)mi * D * D, D, D, (bf16_t*)(a.ws + WS_WOUTT) + (size_t)mi * D * D, 0, scr, r % I_WOUT, lane); }
    }
    { const f32x4* src = (const f32x4*)a.sg_ws; u32x2* dst = (u32x2*)(a.ws + WS_WSG);
      for (int i = bid * NTHREADS + tid; i < 2 * 8 * 128 * 128 / 4; i += G * NTHREADS) { const f32x4 v = src[i]; u32x2 w; w.x = pk2(v[0], v[1]); w.y = pk2(v[2], v[3]); dst[i] = w; } }
}

__device__ __forceinline__ void phase_p0b(const Args& a, LAS unsigned char* lds, int bid, int G) {
    int tid = threadIdx.x; asm volatile("" : "+v"(tid)); const int lane = tid & 63, wave = tid >> 6;
    const float* mod = (const float*)(a.ws + WS_MOD);
    float* gmt = (float*)(a.ws + WS_GM);
    for (int i = bid * NTHREADS + tid; i < 6 * NBATCH * D; i += G * NTHREADS) {
        const int d = i & 1023, b = (i >> 10) % NBATCH, lk = i / (NBATCH * D), l = lk / 3, k = lk % 3;
        gmt[i] = a.norm_g[(l * 3 + k) * D + d] * (1.0f + mod[((size_t)l * NBATCH + b) * NMOD + (3 * k + 1) * D + d]);
    }
    const int gw = bid * NWAVES + wave, NGW = G * NWAVES;
    LAS float* sh = (LAS float*)lds;
    for (int lk = 0; lk < 6; ++lk) {
        const int l = lk / 3, k = lk % 3;
        const int Nk = (k == 1) ? DIN : NUP;
        const bf16_t* WT = (k == 1) ? (const bf16_t*)(a.ws + WS_WINT) + (size_t)l * DIN * D : (const bf16_t*)(a.ws + WS_W1T) + (size_t)(l * 2 + (k == 2 ? 1 : 0)) * NUP * D;
        float* Sout = (float*)(a.ws + WS_SV) + (size_t)l * SV_LAYER + (k == 0 ? 0 : (k == 1 ? NBATCH * NUP : NBATCH * (NUP + DIN)));
        __syncthreads();
        for (int i = tid; i < NBATCH * D; i += NTHREADS) { const int b = i >> 10, d = i & 1023; sh[i] = mod[((size_t)l * NBATCH + b) * NMOD + (3 * k) * D + d]; }
        __syncthreads();
        for (int p = gw; p < Nk; p += NGW) {
            const u32x4 w0 = *(const u32x4*)(WT + (size_t)p * D + 8 * lane), w1 = *(const u32x4*)(WT + (size_t)p * D + 512 + 8 * lane);
            float wf[16];
#pragma unroll
            for (int j = 0; j < 4; ++j) { wf[2 * j] = bf_lo(w0[j]); wf[2 * j + 1] = bf_hi(w0[j]); wf[8 + 2 * j] = bf_lo(w1[j]); wf[8 + 2 * j + 1] = bf_hi(w1[j]); }
            float res = 0.f;
#pragma unroll
            for (int b = 0; b < NBATCH; ++b) {
                const LAS f32x4* s0 = (const LAS f32x4*)(sh + b * D + 8 * lane); const LAS f32x4* s1 = (const LAS f32x4*)(sh + b * D + 512 + 8 * lane);
                const f32x4 a0 = s0[0], a1 = s0[1], a2 = s1[0], a3 = s1[1];
                float s = 0.f;
#pragma unroll
                for (int j = 0; j < 4; ++j) s += a0[j] * wf[j] + a1[j] * wf[4 + j] + a2[j] * wf[8 + j] + a3[j] * wf[12 + j];
                s = wave_sum(s);
                if (lane == b) res = s;
            }
            if (lane < NBATCH) Sout[(size_t)lane * Nk + p] = res;
        }
    }
    const float* gm0 = nullptr; (void)gm0;
    bf16_t* xg = (bf16_t*)(a.ws + WS_XG); float* rss = (float*)(a.ws + WS_RSS);
    for (int r = gw; r < MTOT; r += NGW) {
        const int b = batch_of(r);
        const float* xr = r < MP ? a.xp + (size_t)r * D : a.xs + (size_t)(r - MP) * D;
        float ss = 0.f; f32x4 v[4];
#pragma unroll
        for (int j = 0; j < 4; ++j) { v[j] = *(const f32x4*)(xr + 4 * lane + 256 * j); ss += (v[j][0] * v[j][0] + v[j][1] * v[j][1]) + (v[j][2] * v[j][2] + v[j][3] * v[j][3]); }
        ss = wave_sum(ss);
        if (lane < 16) rss[(size_t)r * 16 + lane] = lane == 0 ? ss : 0.f;
#pragma unroll
        for (int j = 0; j < 4; ++j) { const int d = 4 * lane + 256 * j;
            const f32x4 g = *(const f32x4*)(a.norm_g + d); const f32x4 sc = *(const f32x4*)(mod + (size_t)b * NMOD + D + d);
            const f32x4 o = v[j] * (g * (sc + 1.0f));
            u32x2 w; w.x = cvt_pk_bf16(o[0], o[1]); w.y = cvt_pk_bf16(o[2], o[3]); *(u32x2*)(xg + (size_t)r * D + d) = w; }
    }
}

__device__ __forceinline__ void phase_final(const Args& a, int bid, int G) {
    int tid = threadIdx.x; asm volatile("" : "+v"(tid)); const int lane = tid & 63, wave = tid >> 6;
    const int gw = bid * NWAVES + wave, NGW = G * NWAVES;
    const float* rss = (const float*)(a.ws + WS_RSS);
    f32x4 fg[4];
#pragma unroll
    for (int j = 0; j < 4; ++j) fg[j] = *(const f32x4*)(a.final_g + 4 * lane + 256 * j);
    for (int r = gw; r < MTOT; r += NGW) {
        float s = rss[(size_t)r * 16 + (lane & 15)];
        s += __shfl_xor(s, 1); s += __shfl_xor(s, 2); s += __shfl_xor(s, 4); s += __shfl_xor(s, 8);
        const float rs = rsqrtf(s * (1.0f / D) + EPS);
        float* xr = a.out + (size_t)r * D;
#pragma unroll
        for (int j = 0; j < 4; ++j) { f32x4 v = *(const f32x4*)(xr + 4 * lane + 256 * j); v = v * rs * fg[j]; *(f32x4*)(xr + 4 * lane + 256 * j) = v; }
    }
}

__device__ __forceinline__ bool seq_start(int t) { return t < MP ? (t & 4095) == 0 : (t & 16383) == 0; }
__device__ __forceinline__ void unpack8(const u32x4 w, float (&f)[8]) {
#pragma unroll
    for (int j = 0; j < 4; ++j) { f[2 * j] = bf_lo(w[j]); f[2 * j + 1] = bf_hi(w[j]); }
}
constexpr int VT_LD = 136;
__device__ __forceinline__ void phase_mixer(const Args& a, LAS unsigned char* lds, int l, int bid, int G) {
    int tid = threadIdx.x; asm volatile("" : "+v"(tid));
    const int lane = tid & 63, wave = __builtin_amdgcn_readfirstlane(tid >> 6), fr = lane & 15, fq = lane >> 4;
    bf16_t* Z = (bf16_t*)(a.ws + WS_ZH);
    const float* vst = (const float*)(a.ws + WS_VST);
    const float* convw = a.conv_w + (size_t)l * 3 * 512;
    const float* sgn = a.sg_norm_g + (size_t)l * 512;
    const bf16_t* wsg = (const bf16_t*)(a.ws + WS_WSG) + (size_t)l * 8 * 128 * 128;
    const float* sgb = a.sg_bs + (size_t)l * 8 * 128;
    const float* gg = a.grp_g + (size_t)l * 1024;
    LAS f32x2* st = (LAS f32x2*)lds;
    LAS bf16_t* vT = (LAS bf16_t*)(lds + 1024);
    for (int ch = bid; ch < MTOT / 128; ch += G) {
        const int r0 = ch * 128;
        if (tid < 128) {
            const f32x4* p = (const f32x4*)(vst + (size_t)(r0 + tid) * 16); float s1 = 0.f, s2 = 0.f;
#pragma unroll
            for (int i = 0; i < 4; ++i) { const f32x4 v = p[i]; s1 += v[0] + v[2]; s2 += v[1] + v[3]; }
            const float mean = s1 * (1.0f / 512.0f); const float var = fmaxf(s2 * (1.0f / 512.0f) - mean * mean, 0.f);
            st[tid] = (f32x2){mean, rsqrtf(var + EPS)};
        }
        {
            const int t0 = r0 + 16 * wave, c0 = 8 * lane;
            float w0[8], w1[8], w2[8], g8[8];
#pragma unroll
            for (int j = 0; j < 8; ++j) { w0[j] = convw[c0 + j]; w1[j] = convw[512 + c0 + j]; w2[j] = convw[1024 + c0 + j]; g8[j] = gg[c0 + j]; }
            float prev[8], cur[8], nxt[8];
            { u32x4 w = (u32x4){0u, 0u, 0u, 0u}; if (!seq_start(t0)) w = *(const u32x4*)(Z + (size_t)(t0 - 1) * ZW + 1024 + c0); unpack8(w, prev); }
            { const u32x4 w = *(const u32x4*)(Z + (size_t)t0 * ZW + 1024 + c0); unpack8(w, cur); }
#pragma unroll 4
            for (int i = 0; i < 16; ++i) {
                const int t = t0 + i;
                { u32x4 w = (u32x4){0u, 0u, 0u, 0u}; if (!(t + 1 >= MTOT || seq_start(t + 1))) w = *(const u32x4*)(Z + (size_t)(t + 1) * ZW + 1024 + c0); unpack8(w, nxt); }
                float bg[8]; { const u32x4 w = *(const u32x4*)(Z + (size_t)t * ZW + c0); unpack8(w, bg); }
                float y[8]; float ss = 0.f;
#pragma unroll
                for (int j = 0; j < 8; ++j) { y[j] = bg[j] * (w0[j] * prev[j] + w1[j] * cur[j] + w2[j] * nxt[j]); ss += y[j] * y[j]; }
                ss = wave_sum(ss);
                const float rs = rsqrtf(ss * (1.0f / 512.0f) + EPS);
                u32x4 o;
                o.x = cvt_pk_bf16(y[0] * rs * g8[0], y[1] * rs * g8[1]); o.y = cvt_pk_bf16(y[2] * rs * g8[2], y[3] * rs * g8[3]);
                o.z = cvt_pk_bf16(y[4] * rs * g8[4], y[5] * rs * g8[5]); o.w = cvt_pk_bf16(y[6] * rs * g8[6], y[7] * rs * g8[7]);
                *(u32x4*)(Z + (size_t)t * ZW + c0) = o;
#pragma unroll
                for (int j = 0; j < 8; ++j) { prev[j] = cur[j]; cur[j] = nxt[j]; }
            }
        }
        __syncthreads();
        f32x4 acc[8][4];
        float ss = 0.f;
        const int prow = 16 * wave + fr;
#pragma unroll
        for (int h = 0; h < 8; ++h) {
            LAS bf16_t* vb = vT + (h & 1) * 64 * VT_LD;
#pragma unroll
            for (int i = 0; i < 2; ++i) {
                const int q = (tid >> 3) + 64 * i, dc = tid & 7;
                const u32x4 w = *(const u32x4*)(Z + (size_t)(r0 + q) * ZW + 1536 + h * 64 + dc * 8);
                float f[8]; unpack8(w, f);
                const f32x2 ms = st[q];
                const f32x4 ga = *(const f32x4*)(sgn + h * 64 + dc * 8), gb = *(const f32x4*)(sgn + h * 64 + dc * 8 + 4);
#pragma unroll
                for (int j = 0; j < 8; ++j) { const float gj = j < 4 ? ga[j] : gb[j - 4]; const float vn = (f[j] - ms.x) * ms.y * gj; vb[(dc * 8 + j) * VT_LD + q] = (bf16_t)f2bf(vn); }
            }
            bf16x8 wf[4];
#pragma unroll
            for (int ks = 0; ks < 4; ++ks) wf[ks] = *(const bf16x8*)(wsg + ((size_t)(h * 128 + prow)) * 128 + fq * 8 + 32 * ks);
            __syncthreads();
#pragma unroll
            for (int nd = 0; nd < 4; ++nd) {
                f32x4 c = (f32x4){0.f, 0.f, 0.f, 0.f};
#pragma unroll
                for (int ks = 0; ks < 4; ++ks) {
                    const bf16x8 vf = *(const LAS bf16x8*)(vb + (16 * nd + fr) * VT_LD + fq * 8 + 32 * ks);
                    c = __builtin_amdgcn_mfma_f32_16x16x32_bf16(vf, wf[ks], c, 0, 0, 0);
                }
                const float bias = sgb[h * 128 + prow];
                const u32x2 uw = *(const u32x2*)(Z + (size_t)(r0 + prow) * ZW + 512 + h * 64 + 16 * nd + 4 * fq);
                f32x4 y; y[0] = bf_lo(uw.x) * (c[0] + bias); y[1] = bf_hi(uw.x) * (c[1] + bias); y[2] = bf_lo(uw.y) * (c[2] + bias); y[3] = bf_hi(uw.y) * (c[3] + bias);
                ss += (y[0] * y[0] + y[1] * y[1]) + (y[2] * y[2] + y[3] * y[3]);
                acc[h][nd] = y;
            }
        }
        ss += __shfl_xor(ss, 16); ss += __shfl_xor(ss, 32);
        const float rs = rsqrtf(ss * (1.0f / 512.0f) + EPS);
#pragma unroll
        for (int h = 0; h < 8; ++h)
#pragma unroll
            for (int nd = 0; nd < 4; ++nd) {
                const int c = h * 64 + 16 * nd + 4 * fq;
                const f32x4 g = *(const f32x4*)(gg + 512 + c);
                const f32x4 o = acc[h][nd] * rs * g;
                u32x2 w; w.x = cvt_pk_bf16(o[0], o[1]); w.y = cvt_pk_bf16(o[2], o[3]);
                *(u32x2*)(Z + (size_t)(r0 + prow) * ZW + 512 + c) = w;
            }
        __syncthreads();
    }
}

__global__ void __launch_bounds__(NTHREADS, 2) fwd_megakernel(Args a) {
    extern __shared__ __attribute__((aligned(16))) unsigned char lds_raw[];
    LAS unsigned char* lds = (LAS unsigned char*)lds_raw;
    const int G = gridDim.x, bid = blockIdx.x;
    unsigned char* ws = a.ws;
    for (int ph = a.ph_lo; ph < a.ph_hi; ++ph) {
        if (ph == 0) phase_p0a(a, lds, bid, G);
        else if (ph == 1) phase_p0b(a, lds, bid, G);
        else if (ph == NPHASES - 1) phase_final(a, bid, G);
        else {
            const int q = ph - 2, l = q / 11, s = q % 11;
            const float* mod_l = (const float*)(ws + WS_MOD) + (size_t)l * NBATCH * NMOD;
            const float* gmt = (const float*)(ws + WS_GM);
            const float* svl = (const float*)(ws + WS_SV) + (size_t)l * SV_LAYER;
            float* rss = (float*)(ws + WS_RSS);
            bf16_t* xg = (bf16_t*)(ws + WS_XG);
            bf16_t* zh = (bf16_t*)(ws + WS_ZH);
            if (s == 5) phase_mixer(a, lds, l, bid, G);
            else if (s == 4) {
                pg8::Gemm g{xg, (const bf16_t*)(ws + WS_WINT) + (size_t)l * DIN * D, MTOT, DIN, D, D};
                pg8::StaticOrder S; S.init(MTOT, DIN, G, bid);
                EpiMixIn E{zh, rss, svl + NBATCH * NUP, (float*)(ws + WS_VST)};
                pg8::gemm_phase<EpiMixIn, pg8::StaticOrder, true, true>(lds, g, S, E);
            } else if (s == 6) {
                pg8::Gemm g{zh, (const bf16_t*)(ws + WS_WOUTT) + (size_t)l * D * D, MTOT, D, D, ZW};
                pg8::StaticOrder S; S.init(MTOT, D, G, bid);
                EpiRes E{a.xp, a.xs, 0, a.out, xg, rss, mod_l + 5 * D, gmt + (size_t)(l * 3 + 2) * NBATCH * D, 1.0f, 0};
                pg8::gemm_phase<EpiRes, pg8::StaticOrder, true, true>(lds, g, S, E);
            } else {
                const int f = s >= 7 ? 1 : 0, s2 = f ? s - 7 : s, half = s2 >> 1, rowbase = half * MP;
                if ((s2 & 1) == 0) {
                    pg8::Gemm g{xg + (size_t)rowbase * D, (const bf16_t*)(ws + WS_W1T) + (size_t)(l * 2 + f) * NUP * D, MP, NUP, D, D};
                    pg8::StaticOrder S; S.init(MP, NUP, G, bid);
                    EpiUp E{zh, rss, svl + (f ? NBATCH * (NUP + DIN) : 0), rowbase};
                    pg8::gemm_phase<EpiUp, pg8::StaticOrder, true, true>(lds, g, S, E);
                } else {
                    pg8::Gemm g{zh, (const bf16_t*)(ws + WS_W2T) + (size_t)(l * 2 + f) * D * FF, MP, D, FF, FF};
                    pg8::StaticOrder S; S.init(MP, D, G, bid);
                    const float* gmn = f == 0 ? gmt + (size_t)(l * 3 + 1) * NBATCH * D : (l == 0 ? gmt + (size_t)3 * NBATCH * D : nullptr);
                    EpiRes E{a.xp, a.xs, (l == 0 && f == 0) ? 1 : 0, a.out, xg, rss, mod_l + (f ? 8 : 2) * D, gmn, 0.5f, rowbase};
                    pg8::gemm_phase<EpiRes, pg8::StaticOrder, true, true>(lds, g, S, E);
                }
            }
        }
        if (ph + 1 < a.ph_hi) cg::this_grid().sync();
    }
}

extern "C" void kernel_launch(void* const* d_in, const int* in_sizes, int n_in, void* d_out, int out_size, void* d_ws, size_t ws_size, hipStream_t stream) {
    static int grid = 0;
    if (grid == 0) {
        if (n_in != 17 || out_size != MTOT * D || ws_size < WS_END) { fprintf(stderr, "kernel_launch: unexpected shapes (n_in %d out %d ws %zu)\n", n_in, out_size, ws_size); grid = -1; return; }
        int dev = 0, cus = 0, per_cu = 0;
        hipGetDevice(&dev);
        hipDeviceGetAttribute(&cus, hipDeviceAttributeMultiprocessorCount, dev);
        if (hipFuncSetAttribute((const void*)fwd_megakernel, hipFuncAttributeMaxDynamicSharedMemorySize, LDS_BYTES) != hipSuccess) { fprintf(stderr, "kernel_launch: hipFuncSetAttribute failed\n"); grid = -1; return; }
        if (hipOccupancyMaxActiveBlocksPerMultiprocessor(&per_cu, (const void*)fwd_megakernel, NTHREADS, LDS_BYTES) != hipSuccess || per_cu < 1) { fprintf(stderr, "kernel_launch: occupancy query says %d\n", per_cu); per_cu = 1; }
        (void)hipGetLastError();
        grid = cus * per_cu;
        fprintf(stderr, "kernel_launch: grid %d (cus %d x %d)\n", grid, cus, per_cu);
    }
    if (grid < 0) return;
    Args a{};
    a.xp = (const float*)d_in[0]; a.xs = (const float*)d_in[1]; a.cp = (const float*)d_in[2]; a.cs = (const float*)d_in[3];
    a.ada_w = (const float*)d_in[4]; a.ada_b = (const float*)d_in[5]; a.norm_g = (const float*)d_in[6]; a.ffn_w1 = (const float*)d_in[7];
    a.ffn_w2 = (const float*)d_in[8]; a.mix_w_in = (const float*)d_in[9]; a.conv_w = (const float*)d_in[10]; a.sg_norm_g = (const float*)d_in[11];
    a.sg_ws = (const float*)d_in[12]; a.sg_bs = (const float*)d_in[13]; a.grp_g = (const float*)d_in[14]; a.mix_w_out = (const float*)d_in[15];
    a.final_g = (const float*)d_in[16];
    a.out = (float*)d_out; a.ws = (unsigned char*)d_ws;
#if MK_ONE_LAUNCH
    a.ph_lo = 0; a.ph_hi = NPHASES;
    void* args[] = {&a};
    hipError_t e = hipLaunchCooperativeKernel((const void*)fwd_megakernel, dim3(grid), dim3(NTHREADS), args, LDS_BYTES, stream);
    if (e != hipSuccess) fprintf(stderr, "cooperative launch failed: %s (grid %d)\n", hipGetErrorString(e), grid);
#else
    for (int ph = 0; ph < NPHASES; ++ph) {
        a.ph_lo = ph; a.ph_hi = ph + 1;
        hipLaunchKernelGGL(fwd_megakernel, dim3(grid), dim3(NTHREADS), LDS_BYTES, stream, a);
    }
#endif
}
```

```cpp
#include <hip/hip_runtime.h>
#include <hip/hip_cooperative_groups.h>
#include <cstdio>
#include <cstdint>
namespace cg = cooperative_groups;

#ifndef MK_PROBE
#define MK_PROBE 0
#endif
#ifndef MK_ONE_LAUNCH
#define MK_ONE_LAUNCH 1
#endif

constexpr int D = 1024, FF = 2816, NUP = 2 * FF, DIN = 2560, ZW = 2048;
constexpr int MTOT = 65536, MP = 32768;
constexpr int NBATCH = 10, NMOD = 9 * D;
constexpr float EPS = 1e-6f;
constexpr int NWAVES = 8, NTHREADS = 512;
constexpr int NPHASES = 25;

constexpr size_t MiB = 1u << 20;
constexpr size_t WS_MOD = 1 * MiB;
constexpr size_t WS_GM = 2 * MiB;
constexpr size_t WS_SV = 3 * MiB;
constexpr size_t WS_RSS = 5 * MiB;
constexpr size_t WS_VST = 9 * MiB;
constexpr size_t WS_WSG = 13 * MiB;
constexpr size_t WS_W1T = 14 * MiB;
constexpr size_t WS_W2T = 58 * MiB;
constexpr size_t WS_WINT = 80 * MiB;
constexpr size_t WS_WOUTT = 90 * MiB;
constexpr size_t WS_XG = 94 * MiB;
constexpr size_t WS_ZH = 222 * MiB;
constexpr size_t WS_END = 478 * MiB;
constexpr int SV_LAYER = NBATCH * (NUP + DIN + NUP);

constexpr int LDS_BYTES = 147456;

namespace pg8 {
#define PG8_LAS __attribute__((address_space(3)))
typedef unsigned short bf16_t;
typedef short bf16x8 __attribute__((ext_vector_type(8)));
typedef float f32x4 __attribute__((ext_vector_type(4)));
typedef float f32x2 __attribute__((ext_vector_type(2)));
typedef unsigned u32x4 __attribute__((ext_vector_type(4)));
typedef unsigned u32x2 __attribute__((ext_vector_type(2)));
constexpr int BM = 256, BK = 64, HALF = 128, HTB = HALF * BK * 2, STAGE_BYTES = 8 * HTB, NXCD = 8, WGM = 8;

__host__ __device__ __forceinline__ int lds_byte(int r, int c) { const int st = (r >> 4) * 2 + (c >> 5), rr = r & 15, cc = c & 31, ob = rr * 64 + cc * 2; return st * 1024 + (ob ^ (((ob >> 9) & 1) << 5)); }
__host__ __device__ __forceinline__ void stage_rc(int b, int& R, int& C) { const int st = b / 1024, sb = b % 1024, swz = sb ^ (((sb >> 9) & 1) << 5); R = (st >> 1) * 16 + swz / 64; C = (st & 1) * 32 + (swz % 64) / 2; }
__host__ __device__ __forceinline__ int perm32(int rho) { const int n = rho >> 4, i = rho & 15; return 8 * (i >> 2) + 4 * n + (i & 3); }

struct Unit { int pm, pn; };
struct Gemm { const bf16_t* A; const bf16_t* Bt; int M, N, K, lda; };

struct StaticOrder {
    int nM, nN, nwg, G, c;
    __host__ __device__ void init(int M, int N, int G_, int c_) { nM = M / BM; nN = N / BM; nwg = nM * nN; G = G_; c = c_; }
    __host__ __device__ bool next(int i, Unit& u) const {
        const long L = (long)i * G + c; if (L >= nwg) return false;
        int wgid = (int)L; { const int q = nwg / NXCD, r = nwg % NXCD, xcd = wgid % NXCD, off = wgid / NXCD; wgid = (xcd < r ? xcd * (q + 1) : r * (q + 1) + (xcd - r) * q) + off; }
        const int nig = WGM * nN, gid = wgid / nig, fm = gid * WGM, gsz = (nM - fm) < WGM ? (nM - fm) : WGM;
        u.pm = fm + ((wgid % nig) % gsz); u.pn = (wgid % nig) / gsz; return true;
    }
};

__device__ __forceinline__ unsigned cvt_pk_bf16(float lo, float hi) { unsigned r; asm volatile("v_cvt_pk_bf16_f32 %0, %1, %2" : "=v"(r) : "v"(lo), "v"(hi)); return r; }
__device__ __forceinline__ f32x2 gelu_pk(f32x2 v) {
    const f32x2 av = __builtin_elementwise_abs(v), d = av * 0.2316418882f + 1.0f;
    f32x2 t; t.x = __builtin_amdgcn_rcpf(d.x); t.y = __builtin_amdgcn_rcpf(d.y);
    f32x2 q = t * 0.5307027145f + (-0.7265760135f); q = q * t + 0.7107068705f; q = q * t + (-0.142248368f); q = q * t + 0.127414796f; q = q * t;
    const f32x2 s = (v * v) * (-0.72134752044f);
    f32x2 e; e.x = __builtin_amdgcn_exp2f(s.x); e.y = __builtin_amdgcn_exp2f(s.y);
    const f32x2 m = v * (q * e), r = v - m;
    f32x2 o; o.x = v.x < 0.f ? m.x : r.x; o.y = v.y < 0.f ? m.y : r.y; return o;
}
__device__ __forceinline__ f32x4 gelu4(f32x4 v) { const f32x2 a = gelu_pk((f32x2){v[0], v[1]}), b = gelu_pk((f32x2){v[2], v[3]}); return (f32x4){a.x, a.y, b.x, b.y}; }
__device__ __forceinline__ float silu1(float g) { return g * __builtin_amdgcn_rcpf(1.0f + __builtin_amdgcn_exp2f(-1.4426950409f * g)); }

template <class Epi, class Sched, bool ALIGN_EPI, bool SP2>
__device__ __forceinline__ void gemm_phase(PG8_LAS unsigned char* lds, const Gemm g, const Sched& S, const Epi& E) {
    int tid = threadIdx.x; asm volatile("" : "+v"(tid));
    const int wid = __builtin_amdgcn_readfirstlane(tid >> 6), lane = tid & 63, wr = wid >> 2, wc = wid & 3, fr = lane & 15, fq = lane >> 4;
    const int K = g.K, nt = K / BK, lda = g.lda;
    unsigned voffA[2], voffB[2];
#pragma unroll
    for (int i = 0; i < 2; ++i) { int R, C; stage_rc(tid * 16 + i * 8192, R, C); const int Rb = Epi::PERM ? ((R & ~31) + perm32(R & 31)) : R;
        voffA[i] = (unsigned)(R * lda + C) * 2u; voffB[i] = (unsigned)(Rb * K + C) * 2u; }
    const size_t kstep = (size_t)(BK * 2);
    const size_t hstepA = (size_t)HALF * lda * 2, hstepB = (size_t)HALF * K * 2;
    const size_t tstepA = 2 * hstepA, tstepB = 2 * hstepB;
    const unsigned ldsw = (unsigned)wid * 1024u;
    const int aoff = lds_byte(wr * 64 + fr, fq * 8), boff = lds_byte(wc * 32 + fr, fq * 8);
#define PG8_SA(b, h) (((b) * 2 + (h)) * HTB)
#define PG8_SB(b, h) ((4 + (b) * 2 + (h)) * HTB)
#define PG8_STAGE(bufoff, gbase, voff) do { _Pragma("unroll") for (int _i = 0; _i < 2; ++_i) \
        __builtin_amdgcn_global_load_lds((const unsigned*)((const char*)(gbase) + (voff)[_i]), (PG8_LAS unsigned*)(lds + (bufoff) + ldsw + _i * 8192), 16, 0, 0); } while (0)
#define PG8_LDA(dst, b, h) do { _Pragma("unroll") for (int m = 0; m < 4; ++m) _Pragma("unroll") for (int k = 0; k < 2; ++k) dst[m][k] = *(const PG8_LAS bf16x8*)(lds + PG8_SA(b, h) + aoff + m * 2048 + k * 1024); } while (0)
#define PG8_LDB(dst, b, h) do { _Pragma("unroll") for (int n = 0; n < 2; ++n) _Pragma("unroll") for (int k = 0; k < 2; ++k) dst[n][k] = *(const PG8_LAS bf16x8*)(lds + PG8_SB(b, h) + boff + n * 2048 + k * 1024); } while (0)
#define PG8_MMA(ai, bj, At, Bt) do { __builtin_amdgcn_s_setprio(1); _Pragma("unroll") for (int m = 0; m < 4; ++m) _Pragma("unroll") for (int n = 0; n < 2; ++n) _Pragma("unroll") for (int k = 0; k < 2; ++k) \
        acc[ai][bj][m][n] = __builtin_amdgcn_mfma_f32_16x16x32_bf16(Bt[n][k], At[m][k], acc[ai][bj][m][n], 0, 0, 0); __builtin_amdgcn_s_setprio(0); } while (0)
#define PG8_WAIT_V(n) asm volatile("s_waitcnt vmcnt(" #n ")" ::: "memory")
#define PG8_WAIT_L(n) asm volatile("s_waitcnt lgkmcnt(" #n ")" ::: "memory")
#define PG8_BAR __builtin_amdgcn_s_barrier()
#define PG8_SCHED __builtin_amdgcn_sched_barrier(0)
    Unit cur, nxt; int ui = 0;
    if (!S.next(0, cur)) return;
    f32x4 acc[2][2][4][2];
#pragma unroll
    for (int a = 0; a < 2; ++a)
#pragma unroll
        for (int b = 0; b < 2; ++b)
#pragma unroll
            for (int m = 0; m < 4; ++m)
#pragma unroll
                for (int n = 0; n < 2; ++n) acc[a][b][m][n] = (f32x4){0.f, 0.f, 0.f, 0.f};
    bf16x8 At[4][2], B0[2][2], B1[2][2];
    const char* cA = (const char*)g.A + (size_t)cur.pm * tstepA; const char* cB = (const char*)g.Bt + (size_t)cur.pn * tstepB;
    if constexpr (SP2) {
        PG8_STAGE(PG8_SB(0, 0), cB, voffB); PG8_STAGE(PG8_SB(0, 1), cB + hstepB, voffB); PG8_STAGE(PG8_SA(0, 0), cA, voffA); PG8_STAGE(PG8_SA(0, 1), cA + hstepA, voffA);
        if (wr == 1) PG8_BAR;
        PG8_WAIT_V(2); PG8_BAR;
        PG8_STAGE(PG8_SB(1, 0), cB + kstep, voffB); PG8_STAGE(PG8_SA(1, 0), cA + kstep, voffA); PG8_STAGE(PG8_SB(1, 1), cB + hstepB + kstep, voffB);
        PG8_WAIT_V(6); PG8_BAR;
    } else {
        PG8_STAGE(PG8_SB(0, 0), cB, voffB); PG8_STAGE(PG8_SA(0, 0), cA, voffA); PG8_STAGE(PG8_SB(0, 1), cB + hstepB, voffB); PG8_STAGE(PG8_SA(0, 1), cA + hstepA, voffA);
        if (wr == 1) PG8_BAR;
        PG8_WAIT_V(4); PG8_BAR;
        PG8_STAGE(PG8_SB(1, 0), cB + kstep, voffB); PG8_STAGE(PG8_SA(1, 0), cA + kstep, voffA); PG8_STAGE(PG8_SB(1, 1), cB + hstepB + kstep, voffB);
        PG8_WAIT_V(6); PG8_BAR;
    }
    for (;;) {
        const bool has_next = S.next(ui + 1, nxt);
        const char* nA = has_next ? (const char*)g.A + (size_t)nxt.pm * tstepA : cA; const char* nB = has_next ? (const char*)g.Bt + (size_t)nxt.pn * tstepB : cB;
        for (int t = 0; t < nt; t += 2) {
            const bool last = (t == nt - 2);
            const char* a1 = cA + (size_t)(t + 1) * kstep;
            const char* a2 = last ? nA : cA + (size_t)(t + 2) * kstep; const char* b2 = last ? nB : cB + (size_t)(t + 2) * kstep;
            const char* a3 = a2 + kstep; const char* b3 = b2 + kstep;
            if constexpr (SP2) {
            PG8_LDB(B0, 0, 0); PG8_LDB(B1, 0, 1); PG8_SCHED; PG8_LDA(At, 0, 0); PG8_STAGE(PG8_SA(1, 1), a1 + hstepA, voffA);
            PG8_WAIT_V(8); PG8_WAIT_L(0); PG8_BAR; PG8_MMA(0, 0, At, B0); PG8_MMA(0, 1, At, B1); PG8_BAR; PG8_SCHED;
            PG8_LDA(At, 0, 1); PG8_STAGE(PG8_SB(0, 0), b2, voffB); PG8_STAGE(PG8_SB(0, 1), b2 + hstepB, voffB); PG8_STAGE(PG8_SA(0, 0), a2, voffA);
            PG8_WAIT_V(8); PG8_WAIT_L(0); PG8_BAR; PG8_MMA(1, 0, At, B0); PG8_MMA(1, 1, At, B1); PG8_BAR; PG8_SCHED;
            PG8_LDB(B0, 1, 0); PG8_LDB(B1, 1, 1); PG8_SCHED; PG8_LDA(At, 1, 0); PG8_STAGE(PG8_SA(0, 1), a2 + hstepA, voffA);
            PG8_WAIT_V(8); PG8_WAIT_L(0); PG8_BAR; PG8_MMA(0, 0, At, B0); PG8_MMA(0, 1, At, B1); PG8_BAR; PG8_SCHED;
            PG8_LDA(At, 1, 1); PG8_STAGE(PG8_SB(1, 0), b3, voffB); PG8_STAGE(PG8_SB(1, 1), b3 + hstepB, voffB); PG8_STAGE(PG8_SA(1, 0), a3, voffA);
            PG8_WAIT_V(8); PG8_WAIT_L(0); PG8_BAR; PG8_MMA(1, 0, At, B0); PG8_MMA(1, 1, At, B1); PG8_BAR; PG8_SCHED;
            } else {
            PG8_LDB(B0, 0, 0); PG8_SCHED; PG8_LDA(At, 0, 0); PG8_STAGE(PG8_SA(1, 1), a1 + hstepA, voffA);
            PG8_WAIT_L(8); PG8_BAR; PG8_WAIT_L(0); PG8_MMA(0, 0, At, B0); PG8_BAR; PG8_SCHED;
            PG8_LDB(B1, 0, 1); PG8_STAGE(PG8_SB(0, 0), b2, voffB);
            PG8_BAR; PG8_WAIT_L(0); PG8_MMA(0, 1, At, B1); PG8_BAR;
            PG8_LDA(At, 0, 1); PG8_STAGE(PG8_SA(0, 0), a2, voffA);
            PG8_BAR; PG8_WAIT_L(0); PG8_MMA(1, 0, At, B0); PG8_BAR; PG8_SCHED;
            PG8_STAGE(PG8_SB(0, 1), b2 + hstepB, voffB);
            PG8_WAIT_V(6); PG8_BAR; PG8_MMA(1, 1, At, B1); PG8_BAR;
            PG8_LDB(B0, 1, 0); PG8_SCHED; PG8_LDA(At, 1, 0); PG8_STAGE(PG8_SA(0, 1), a2 + hstepA, voffA);
            PG8_WAIT_L(8); PG8_BAR; PG8_WAIT_L(0); PG8_MMA(0, 0, At, B0); PG8_BAR; PG8_SCHED;
            PG8_LDB(B1, 1, 1); PG8_STAGE(PG8_SB(1, 0), b3, voffB);
            PG8_BAR; PG8_WAIT_L(0); PG8_MMA(0, 1, At, B1); PG8_BAR;
            PG8_LDA(At, 1, 1); PG8_STAGE(PG8_SA(1, 0), a3, voffA);
            PG8_BAR; PG8_WAIT_L(0); PG8_MMA(1, 0, At, B0); PG8_BAR; PG8_SCHED;
            PG8_STAGE(PG8_SB(1, 1), b3 + hstepB, voffB);
            PG8_WAIT_V(6); PG8_BAR; PG8_MMA(1, 1, At, B1); PG8_BAR;
            }
        }
        if constexpr (ALIGN_EPI) { if (wr == 0) PG8_BAR; }
        E(acc, cur, wr, wc, fr, fq);
        if (!has_next) break;
#pragma unroll
        for (int a = 0; a < 2; ++a)
#pragma unroll
            for (int b = 0; b < 2; ++b)
#pragma unroll
                for (int m = 0; m < 4; ++m)
#pragma unroll
                    for (int n = 0; n < 2; ++n) acc[a][b][m][n] = (f32x4){0.f, 0.f, 0.f, 0.f};
        cur = nxt; cA = nA; cB = nB; ++ui;
        if constexpr (ALIGN_EPI) { if (wr == 1) PG8_BAR; }
    }
    PG8_WAIT_V(0);
    if constexpr (!ALIGN_EPI) { if (wr == 0) PG8_BAR; }
    PG8_BAR;
#undef PG8_SA
#undef PG8_SB
#undef PG8_STAGE
#undef PG8_LDA
#undef PG8_LDB
#undef PG8_MMA
#undef PG8_WAIT_V
#undef PG8_WAIT_L
#undef PG8_BAR
#undef PG8_SCHED
}
}

using pg8::bf16_t; using pg8::f32x4; using pg8::f32x2; using pg8::u32x4; using pg8::u32x2; using pg8::bf16x8; using pg8::cvt_pk_bf16;
#define LAS __attribute__((address_space(3)))

__device__ __forceinline__ int batch_of(int r) { return r < MP ? (r >> 12) : 8 + ((r - MP) >> 14); }
__device__ __forceinline__ float wave_sum(float v) {
#pragma unroll
    for (int o = 1; o < 64; o <<= 1) v += __shfl_xor(v, o);
    return v;
}
__device__ __forceinline__ float bf_lo(unsigned w) { return __uint_as_float(w << 16); }
__device__ __forceinline__ float bf_hi(unsigned w) { return __uint_as_float(w & 0xffff0000u); }
__device__ __forceinline__ float row_rstd(const float* rss, int row, int fq) {
    const f32x4 p = *(const f32x4*)(rss + (size_t)row * 16 + 4 * fq);
    float s = (p[0] + p[1]) + (p[2] + p[3]);
    s += __shfl_xor(s, 16); s += __shfl_xor(s, 32);
    return rsqrtf(s * (1.0f / D) + EPS);
}

struct EpiUp {
    static constexpr bool PERM = true;
    bf16_t* H; const float* rss; const float* S; int rowbase;
    __device__ __forceinline__ void operator()(const f32x4 (&acc)[2][2][4][2], const pg8::Unit& u, int wr, int wc, int fr_, int fq_) const {
        int lane_ = threadIdx.x & 63; asm volatile("" : "+v"(lane_)); const int fr = lane_ & 15, fq = lane_ >> 4;
        const int lrow0 = u.pm * 256 + wr * 64 + fr;
        const int b = batch_of(rowbase + u.pm * 256);
        const float* Sb = S + (size_t)b * NUP + u.pn * 256 + wc * 32 + 8 * fq;
        f32x4 sv[2][2];
#pragma unroll
        for (int bj = 0; bj < 2; ++bj)
#pragma unroll
            for (int n = 0; n < 2; ++n) sv[bj][n] = *(const f32x4*)(Sb + bj * 128 + 4 * n);
        const int hcol = u.pn * 128 + wc * 32 + 8 * fq;
#pragma unroll
        for (int ai = 0; ai < 2; ++ai)
#pragma unroll
            for (int m = 0; m < 4; ++m) {
                const int lr = lrow0 + ai * 128 + m * 16;
                const float rs = row_rstd(rss, rowbase + lr, fq);
                const f32x4 g0 = acc[ai][0][m][0] * rs + sv[0][0], g1 = acc[ai][0][m][1] * rs + sv[0][1];
                const f32x4 u0 = acc[ai][1][m][0] * rs + sv[1][0], u1 = acc[ai][1][m][1] * rs + sv[1][1];
                f32x4 h0, h1;
#pragma unroll
                for (int j = 0; j < 4; ++j) { h0[j] = pg8::silu1(g0[j]) * u0[j]; h1[j] = pg8::silu1(g1[j]) * u1[j]; }
                u32x4 w; w.x = cvt_pk_bf16(h0[0], h0[1]); w.y = cvt_pk_bf16(h0[2], h0[3]); w.z = cvt_pk_bf16(h1[0], h1[1]); w.w = cvt_pk_bf16(h1[2], h1[3]);
                *(u32x4*)(H + (size_t)lr * FF + hcol) = w;
            }
    }
};

struct EpiRes {
    static constexpr bool PERM = false;
    const float* xp; const float* xs; int first;
    float* out; bf16_t* xg; float* rss; const float* gate; const float* gm; float coef; int rowbase; int dostore;
    __device__ __forceinline__ void operator()(const f32x4 (&acc)[2][2][4][2], const pg8::Unit& u, int wr, int wc, int fr_, int fq_) const {
        int lane_ = threadIdx.x & 63; asm volatile("" : "+v"(lane_)); const int fr = lane_ & 15, fq = lane_ >> 4;
        const int grow0 = rowbase + u.pm * 256 + wr * 64 + fr;
        const int b = batch_of(rowbase + u.pm * 256);
        const int col0 = u.pn * 256 + wc * 32 + 4 * fq;
        const float* gp = gate + (size_t)b * NMOD + col0;
        f32x4 gv[2][2], mv[2][2];
#pragma unroll
        for (int bj = 0; bj < 2; ++bj)
#pragma unroll
            for (int n = 0; n < 2; ++n) { gv[bj][n] = *(const f32x4*)(gp + bj * 128 + n * 16) * coef;
                mv[bj][n] = gm ? *(const f32x4*)(gm + b * D + col0 + bj * 128 + n * 16) : (f32x4){0.f, 0.f, 0.f, 0.f}; }
#pragma unroll
        for (int ai = 0; ai < 2; ++ai)
#pragma unroll
            for (int m = 0; m < 4; ++m) {
                const int grow = grow0 + ai * 128 + m * 16;
                const float* rp = first ? (grow < MP ? xp + (size_t)grow * D : xs + (size_t)(grow - MP) * D) : out + (size_t)grow * D;
                float ss = 0.f;
#pragma unroll
                for (int bj = 0; bj < 2; ++bj)
#pragma unroll
                    for (int n = 0; n < 2; ++n) {
                        const int c = col0 + bj * 128 + n * 16;
                        const f32x4 xi = *(const f32x4*)(rp + c);
                        const f32x4 xo = xi + gv[bj][n] * acc[ai][bj][m][n];
                        if (dostore) *(f32x4*)(out + (size_t)grow * D + c) = xo;
                        ss += (xo[0] * xo[0] + xo[1] * xo[1]) + (xo[2] * xo[2] + xo[3] * xo[3]);
                        if (gm && dostore) { const f32x4 o = xo * mv[bj][n]; u32x2 w; w.x = cvt_pk_bf16(o[0], o[1]); w.y = cvt_pk_bf16(o[2], o[3]); *(u32x2*)(xg + (size_t)grow * D + c) = w; }
                    }
                ss += __shfl_xor(ss, 16); ss += __shfl_xor(ss, 32);
                if (fq == 0 && dostore) rss[(size_t)grow * 16 + u.pn * 4 + wc] = ss;
                asm volatile("" ::: "memory");
            }
    }
};

struct EpiMixIn {
    static constexpr bool PERM = true;
    bf16_t* Z; const float* rss; const float* S; float* vst;
    __device__ __forceinline__ void operator()(const f32x4 (&acc)[2][2][4][2], const pg8::Unit& u, int wr, int wc, int fr_, int fq_) const {
        int lane_ = threadIdx.x & 63; asm volatile("" : "+v"(lane_)); const int fr = lane_ & 15, fq = lane_ >> 4;
        const int row0 = u.pm * 256 + wr * 64 + fr;
        const int b = batch_of(u.pm * 256);
        const float* Sb = S + (size_t)b * DIN + u.pn * 256 + wc * 32 + 8 * fq;
        f32x4 sv[2][2];
#pragma unroll
        for (int bj = 0; bj < 2; ++bj)
#pragma unroll
            for (int n = 0; n < 2; ++n) sv[bj][n] = *(const f32x4*)(Sb + bj * 128 + 4 * n);
        const int pn = u.pn;
        const int lc = wc * 32 + 8 * fq;
#pragma unroll
        for (int ai = 0; ai < 2; ++ai)
#pragma unroll
            for (int m = 0; m < 4; ++m) {
                const int row = row0 + ai * 128 + m * 16;
                const float rs = row_rstd(rss, row, fq);
                f32x4 v00 = acc[ai][0][m][0] * rs + sv[0][0], v01 = acc[ai][0][m][1] * rs + sv[0][1];
                f32x4 v10 = acc[ai][1][m][0] * rs + sv[1][0], v11 = acc[ai][1][m][1] * rs + sv[1][1];
                bf16_t* zr = Z + (size_t)row * ZW;
                if (pn >= 2 && pn < 6) {
                    const f32x4 o0 = v00 * v10, o1 = v01 * v11;
                    u32x4 w; w.x = cvt_pk_bf16(o0[0], o0[1]); w.y = cvt_pk_bf16(o0[2], o0[3]); w.z = cvt_pk_bf16(o1[0], o1[1]); w.w = cvt_pk_bf16(o1[2], o1[3]);
                    *(u32x4*)(zr + 1024 + (pn - 2) * 128 + lc) = w;
                } else {
                    int cbase = pn * 256;
                    if (pn >= 6) {
                        v00 = pg8::gelu4(v00); v01 = pg8::gelu4(v01); v10 = pg8::gelu4(v10); v11 = pg8::gelu4(v11);
                        cbase = pn < 8 ? 512 + (pn - 6) * 256 : 1536 + (pn - 8) * 256;
                    }
                    u32x4 w0, w1;
                    w0.x = cvt_pk_bf16(v00[0], v00[1]); w0.y = cvt_pk_bf16(v00[2], v00[3]); w0.z = cvt_pk_bf16(v01[0], v01[1]); w0.w = cvt_pk_bf16(v01[2], v01[3]);
                    w1.x = cvt_pk_bf16(v10[0], v10[1]); w1.y = cvt_pk_bf16(v10[2], v10[3]); w1.z = cvt_pk_bf16(v11[0], v11[1]); w1.w = cvt_pk_bf16(v11[2], v11[3]);
                    *(u32x4*)(zr + cbase + lc) = w0;
                    *(u32x4*)(zr + cbase + 128 + lc) = w1;
                    if (pn >= 8) {
                        const f32x4 s4 = (v00 + v01) + (v10 + v11);
                        const f32x4 q4 = (v00 * v00 + v01 * v01) + (v10 * v10 + v11 * v11);
                        float s1 = (s4[0] + s4[1]) + (s4[2] + s4[3]), s2 = (q4[0] + q4[1]) + (q4[2] + q4[3]);
                        s1 += __shfl_xor(s1, 16); s1 += __shfl_xor(s1, 32); s2 += __shfl_xor(s2, 16); s2 += __shfl_xor(s2, 32);
                        if (fq == 0) *(f32x2*)(vst + (size_t)row * 16 + ((pn - 8) * 4 + wc) * 2) = (f32x2){s1, s2};
                    }
                }
            }
    }
};

struct Args {
    const float* xp; const float* xs; const float* cp; const float* cs; const float* ada_w; const float* ada_b; const float* norm_g;
    const float* ffn_w1; const float* ffn_w2; const float* mix_w_in; const float* conv_w; const float* sg_norm_g; const float* sg_ws;
    const float* sg_bs; const float* grp_g; const float* mix_w_out; const float* final_g;
    float* out; unsigned char* ws; int ph_lo, ph_hi;
};

__device__ __forceinline__ unsigned f2bf(float f) { unsigned u = __float_as_uint(f); return (u + 0x7fffu + ((u >> 16) & 1u)) >> 16; }
__device__ __forceinline__ unsigned pk2(float lo, float hi) { return f2bf(lo) | (f2bf(hi) << 16); }

__device__ __forceinline__ int map_col(int mode, int s) {
    if (mode == 1) { const int bj = s >= FF ? 1 : 0, h = s - bj * FF; return 256 * (h >> 7) + 128 * bj + (h & 127); }
    if (mode == 2) { if (s >= 512 && s < 1024) { const int q = s - 512; return 512 + 256 * (q >> 7) + (q & 127); }
                     if (s >= 1024 && s < 1536) { const int q = s - 1024; return 512 + 256 * (q >> 7) + 128 + (q & 127); } }
    return s;
}
__device__ __forceinline__ void transpose_item(const float* W, int K, int N, bf16_t* WT, int mode, LAS float* scr, int item, int lane) {
    const int nblk = N / 32, kb = item / nblk, nb = item % nblk, k0 = 64 * kb, n0 = 32 * nb, dn0 = map_col(mode, n0);
#pragma unroll 8
    for (int i = 0; i < 32; ++i) { const int kk = 2 * i + (lane >> 5); scr[kk * 33 + (lane & 31)] = W[(size_t)(k0 + kk) * N + n0 + (lane & 31)]; }
    asm volatile("s_waitcnt lgkmcnt(0)" ::: "memory");
    const int c = lane & 7;
#pragma unroll
    for (int j = 0; j < 4; ++j) { const int n = (lane >> 3) + 8 * j; const LAS float* s = scr + (8 * c) * 33 + n;
        u32x4 o; o.x = pk2(s[0 * 33], s[1 * 33]); o.y = pk2(s[2 * 33], s[3 * 33]); o.z = pk2(s[4 * 33], s[5 * 33]); o.w = pk2(s[6 * 33], s[7 * 33]);
        *(u32x4*)(WT + (size_t)(dn0 + n) * K + k0 + 8 * c) = o; }
    asm volatile("s_waitcnt lgkmcnt(0)" ::: "memory");
}

__device__ __forceinline__ void phase_p0a(const Args& a, LAS unsigned char* lds, int bid, int G) {
    int tid = threadIdx.x; asm volatile("" : "+v"(tid)); const int lane = tid & 63, wave = tid >> 6;
    LAS float* sc = (LAS float*)lds;
    LAS float* scr = (LAS float*)(lds + 49152 + wave * 10240);
    float* mod = (float*)(a.ws + WS_MOD);
    if (bid < 288) {
        for (int i = tid; i < NBATCH * D; i += NTHREADS) { const int b = i >> 10, k = i & 1023; const float c = b < 8 ? a.cp[b * D + k] : a.cs[(b - 8) * D + k]; sc[i] = c / (1.0f + __expf(-c)); }
        __syncthreads();
        for (int it = bid; it < 288; it += G) {
            const int l = it / 144, n0 = (it % 144) * 64;
            const float* W = a.ada_w + (size_t)l * D * NMOD + n0 + lane;
            float acc[NBATCH];
#pragma unroll
            for (int b = 0; b < NBATCH; ++b) acc[b] = 0.f;
#pragma unroll 8
            for (int kk = 0; kk < 128; ++kk) { const int k = wave * 128 + kk; const float w = W[(size_t)k * NMOD];
#pragma unroll
                for (int b = 0; b < NBATCH; ++b) acc[b] += sc[b * D + k] * w; }
#pragma unroll
            for (int b = 0; b < NBATCH; ++b) scr[b * 64 + lane] = acc[b];
            __syncthreads();
            for (int i = tid; i < NBATCH * 64; i += NTHREADS) { const int b = i >> 6, c = i & 63; float s = 0.f;
#pragma unroll
                for (int w = 0; w < NWAVES; ++w) s += ((LAS float*)(lds + 49152 + w * 10240))[b * 64 + c];
                mod[((size_t)l * NBATCH + b) * NMOD + n0 + c] = s + a.ada_b[(size_t)l * NMOD + n0 + c]; }
            __syncthreads();
        }
    }
    const int gw = bid * NWAVES + wave, NGW = G * NWAVES;
    constexpr int I_W1 = (D / 64) * (NUP / 32), I_W2 = (FF / 64) * (D / 32), I_WIN = (D / 64) * (DIN / 32), I_WOUT = (D / 64) * (D / 32);
    constexpr int NITEMS = 4 * I_W1 + 4 * I_W2 + 2 * I_WIN + 2 * I_WOUT;
    for (int it = gw; it < NITEMS; it += NGW) {
        int r = it;
        if (r < 4 * I_W1) { const int mi = r / I_W1; transpose_item(a.ffn_w1 + (size_t)mi * D * NUP, D, NUP, (bf16_t*)(a.ws + WS_W1T) + (size_t)mi * NUP * D, 1, scr, r % I_W1, lane); continue; } r -= 4 * I_W1;
        if (r < 4 * I_W2) { const int mi = r / I_W2; transpose_item(a.ffn_w2 + (size_t)mi * FF * D, FF, D, (bf16_t*)(a.ws + WS_W2T) + (size_t)mi * D * FF, 0, scr, r % I_W2, lane); continue; } r -= 4 * I_W2;
        if (r < 2 * I_WIN) { const int mi = r / I_WIN; transpose_item(a.mix_w_in + (size_t)mi * D * DIN, D, DIN, (bf16_t*)(a.ws + WS_WINT) + (size_t)mi * DIN * D, 2, scr, r % I_WIN, lane); continue; } r -= 2 * I_WIN;
        { const int mi = r / I_WOUT; transpose_item(a.mix_w_out + (size_t)mi * D * D, D, D, (bf16_t*)(a.ws + WS_WOUTT) + (size_t)mi * D * D, 0, scr, r % I_WOUT, lane); }
    }
    { const f32x4* src = (const f32x4*)a.sg_ws; u32x2* dst = (u32x2*)(a.ws + WS_WSG);
      for (int i = bid * NTHREADS + tid; i < 2 * 8 * 128 * 128 / 4; i += G * NTHREADS) { const f32x4 v = src[i]; u32x2 w; w.x = pk2(v[0], v[1]); w.y = pk2(v[2], v[3]); dst[i] = w; } }
}

__device__ __forceinline__ void phase_p0b(const Args& a, LAS unsigned char* lds, int bid, int G) {
    int tid = threadIdx.x; asm volatile("" : "+v"(tid)); const int lane = tid & 63, wave = tid >> 6;
    const float* mod = (const float*)(a.ws + WS_MOD);
    float* gmt = (float*)(a.ws + WS_GM);
    for (int i = bid * NTHREADS + tid; i < 6 * NBATCH * D; i += G * NTHREADS) {
        const int d = i & 1023, b = (i >> 10) % NBATCH, lk = i / (NBATCH * D), l = lk / 3, k = lk % 3;
        gmt[i] = a.norm_g[(l * 3 + k) * D + d] * (1.0f + mod[((size_t)l * NBATCH + b) * NMOD + (3 * k + 1) * D + d]);
    }
    const int gw = bid * NWAVES + wave, NGW = G * NWAVES;
    LAS float* sh = (LAS float*)lds;
    for (int lk = 0; lk < 6; ++lk) {
        const int l = lk / 3, k = lk % 3;
        const int Nk = (k == 1) ? DIN : NUP;
        const bf16_t* WT = (k == 1) ? (const bf16_t*)(a.ws + WS_WINT) + (size_t)l * DIN * D : (const bf16_t*)(a.ws + WS_W1T) + (size_t)(l * 2 + (k == 2 ? 1 : 0)) * NUP * D;
        float* Sout = (float*)(a.ws + WS_SV) + (size_t)l * SV_LAYER + (k == 0 ? 0 : (k == 1 ? NBATCH * NUP : NBATCH * (NUP + DIN)));
        __syncthreads();
        for (int i = tid; i < NBATCH * D; i += NTHREADS) { const int b = i >> 10, d = i & 1023; sh[i] = mod[((size_t)l * NBATCH + b) * NMOD + (3 * k) * D + d]; }
        __syncthreads();
        for (int p = gw; p < Nk; p += NGW) {
            const u32x4 w0 = *(const u32x4*)(WT + (size_t)p * D + 8 * lane), w1 = *(const u32x4*)(WT + (size_t)p * D + 512 + 8 * lane);
            float wf[16];
#pragma unroll
            for (int j = 0; j < 4; ++j) { wf[2 * j] = bf_lo(w0[j]); wf[2 * j + 1] = bf_hi(w0[j]); wf[8 + 2 * j] = bf_lo(w1[j]); wf[8 + 2 * j + 1] = bf_hi(w1[j]); }
            float res = 0.f;
#pragma unroll
            for (int b = 0; b < NBATCH; ++b) {
                const LAS f32x4* s0 = (const LAS f32x4*)(sh + b * D + 8 * lane); const LAS f32x4* s1 = (const LAS f32x4*)(sh + b * D + 512 + 8 * lane);
                const f32x4 a0 = s0[0], a1 = s0[1], a2 = s1[0], a3 = s1[1];
                float s = 0.f;
#pragma unroll
                for (int j = 0; j < 4; ++j) s += a0[j] * wf[j] + a1[j] * wf[4 + j] + a2[j] * wf[8 + j] + a3[j] * wf[12 + j];
                s = wave_sum(s);
                if (lane == b) res = s;
            }
            if (lane < NBATCH) Sout[(size_t)lane * Nk + p] = res;
        }
    }
    const float* gm0 = nullptr; (void)gm0;
    bf16_t* xg = (bf16_t*)(a.ws + WS_XG); float* rss = (float*)(a.ws + WS_RSS);
    for (int r = gw; r < MTOT; r += NGW) {
        const int b = batch_of(r);
        const float* xr = r < MP ? a.xp + (size_t)r * D : a.xs + (size_t)(r - MP) * D;
        float ss = 0.f; f32x4 v[4];
#pragma unroll
        for (int j = 0; j < 4; ++j) { v[j] = *(const f32x4*)(xr + 4 * lane + 256 * j); ss += (v[j][0] * v[j][0] + v[j][1] * v[j][1]) + (v[j][2] * v[j][2] + v[j][3] * v[j][3]); }
        ss = wave_sum(ss);
        if (lane < 16) rss[(size_t)r * 16 + lane] = lane == 0 ? ss : 0.f;
#pragma unroll
        for (int j = 0; j < 4; ++j) { const int d = 4 * lane + 256 * j;
            const f32x4 g = *(const f32x4*)(a.norm_g + d); const f32x4 sc = *(const f32x4*)(mod + (size_t)b * NMOD + D + d);
            const f32x4 o = v[j] * (g * (sc + 1.0f));
            u32x2 w; w.x = cvt_pk_bf16(o[0], o[1]); w.y = cvt_pk_bf16(o[2], o[3]); *(u32x2*)(xg + (size_t)r * D + d) = w; }
    }
}

__device__ __forceinline__ void phase_final(const Args& a, int bid, int G) {
    int tid = threadIdx.x; asm volatile("" : "+v"(tid)); const int lane = tid & 63, wave = tid >> 6;
    const int gw = bid * NWAVES + wave, NGW = G * NWAVES;
    const float* rss = (const float*)(a.ws + WS_RSS);
    f32x4 fg[4];
#pragma unroll
    for (int j = 0; j < 4; ++j) fg[j] = *(const f32x4*)(a.final_g + 4 * lane + 256 * j);
    for (int r = gw; r < MTOT; r += NGW) {
        float s = rss[(size_t)r * 16 + (lane & 15)];
        s += __shfl_xor(s, 1); s += __shfl_xor(s, 2); s += __shfl_xor(s, 4); s += __shfl_xor(s, 8);
        const float rs = rsqrtf(s * (1.0f / D) + EPS);
        float* xr = a.out + (size_t)r * D;
#pragma unroll
        for (int j = 0; j < 4; ++j) { f32x4 v = *(const f32x4*)(xr + 4 * lane + 256 * j); v = v * rs * fg[j]; *(f32x4*)(xr + 4 * lane + 256 * j) = v; }
    }
}

__device__ __forceinline__ bool seq_start(int t) { return t < MP ? (t & 4095) == 0 : (t & 16383) == 0; }
__device__ __forceinline__ void unpack8(const u32x4 w, float (&f)[8]) {
#pragma unroll
    for (int j = 0; j < 4; ++j) { f[2 * j] = bf_lo(w[j]); f[2 * j + 1] = bf_hi(w[j]); }
}
constexpr int VT_LD = 136;
__device__ __forceinline__ void phase_mixer(const Args& a, LAS unsigned char* lds, int l, int bid, int G, int dostore) {
    int tid = threadIdx.x; asm volatile("" : "+v"(tid));
    const int lane = tid & 63, wave = __builtin_amdgcn_readfirstlane(tid >> 6), fr = lane & 15, fq = lane >> 4;
    bf16_t* Z = (bf16_t*)(a.ws + WS_ZH);
    const float* vst = (const float*)(a.ws + WS_VST);
    const float* convw = a.conv_w + (size_t)l * 3 * 512;
    const float* sgn = a.sg_norm_g + (size_t)l * 512;
    const bf16_t* wsg = (const bf16_t*)(a.ws + WS_WSG) + (size_t)l * 8 * 128 * 128;
    const float* sgb = a.sg_bs + (size_t)l * 8 * 128;
    const float* gg = a.grp_g + (size_t)l * 1024;
    LAS f32x2* st = (LAS f32x2*)lds;
    LAS bf16_t* vT = (LAS bf16_t*)(lds + 1024);
    for (int ch = bid; ch < MTOT / 128; ch += G) {
        const int r0 = ch * 128;
        if (tid < 128) {
            const f32x4* p = (const f32x4*)(vst + (size_t)(r0 + tid) * 16); float s1 = 0.f, s2 = 0.f;
#pragma unroll
            for (int i = 0; i < 4; ++i) { const f32x4 v = p[i]; s1 += v[0] + v[2]; s2 += v[1] + v[3]; }
            const float mean = s1 * (1.0f / 512.0f); const float var = fmaxf(s2 * (1.0f / 512.0f) - mean * mean, 0.f);
            st[tid] = (f32x2){mean, rsqrtf(var + EPS)};
        }
        {
            const int t0 = r0 + 16 * wave, c0 = 8 * lane;
            float w0[8], w1[8], w2[8], g8[8];
#pragma unroll
            for (int j = 0; j < 8; ++j) { w0[j] = convw[c0 + j]; w1[j] = convw[512 + c0 + j]; w2[j] = convw[1024 + c0 + j]; g8[j] = gg[c0 + j]; }
            float prev[8], cur[8], nxt[8];
            { u32x4 w = (u32x4){0u, 0u, 0u, 0u}; if (!seq_start(t0)) w = *(const u32x4*)(Z + (size_t)(t0 - 1) * ZW + 1024 + c0); unpack8(w, prev); }
            { const u32x4 w = *(const u32x4*)(Z + (size_t)t0 * ZW + 1024 + c0); unpack8(w, cur); }
#pragma unroll 4
            for (int i = 0; i < 16; ++i) {
                const int t = t0 + i;
                { u32x4 w = (u32x4){0u, 0u, 0u, 0u}; if (!(t + 1 >= MTOT || seq_start(t + 1))) w = *(const u32x4*)(Z + (size_t)(t + 1) * ZW + 1024 + c0); unpack8(w, nxt); }
                float bg[8]; { const u32x4 w = *(const u32x4*)(Z + (size_t)t * ZW + c0); unpack8(w, bg); }
                float y[8]; float ss = 0.f;
#pragma unroll
                for (int j = 0; j < 8; ++j) { y[j] = bg[j] * (w0[j] * prev[j] + w1[j] * cur[j] + w2[j] * nxt[j]); ss += y[j] * y[j]; }
                ss = wave_sum(ss);
                const float rs = rsqrtf(ss * (1.0f / 512.0f) + EPS);
                u32x4 o;
                o.x = cvt_pk_bf16(y[0] * rs * g8[0], y[1] * rs * g8[1]); o.y = cvt_pk_bf16(y[2] * rs * g8[2], y[3] * rs * g8[3]);
                o.z = cvt_pk_bf16(y[4] * rs * g8[4], y[5] * rs * g8[5]); o.w = cvt_pk_bf16(y[6] * rs * g8[6], y[7] * rs * g8[7]);
                if (dostore) *(u32x4*)(Z + (size_t)t * ZW + c0) = o;
#pragma unroll
                for (int j = 0; j < 8; ++j) { prev[j] = cur[j]; cur[j] = nxt[j]; }
            }
        }
        __syncthreads();
        f32x4 acc[8][4];
        float ss = 0.f;
        const int prow = 16 * wave + fr;
#pragma unroll
        for (int h = 0; h < 8; ++h) {
            LAS bf16_t* vb = vT + (h & 1) * 64 * VT_LD;
#pragma unroll
            for (int i = 0; i < 2; ++i) {
                const int q = (tid >> 3) + 64 * i, dc = tid & 7;
                const u32x4 w = *(const u32x4*)(Z + (size_t)(r0 + q) * ZW + 1536 + h * 64 + dc * 8);
                float f[8]; unpack8(w, f);
                const f32x2 ms = st[q];
                const f32x4 ga = *(const f32x4*)(sgn + h * 64 + dc * 8), gb = *(const f32x4*)(sgn + h * 64 + dc * 8 + 4);
#pragma unroll
                for (int j = 0; j < 8; ++j) { const float gj = j < 4 ? ga[j] : gb[j - 4]; const float vn = (f[j] - ms.x) * ms.y * gj; vb[(dc * 8 + j) * VT_LD + q] = (bf16_t)f2bf(vn); }
            }
            bf16x8 wf[4];
#pragma unroll
            for (int ks = 0; ks < 4; ++ks) wf[ks] = *(const bf16x8*)(wsg + ((size_t)(h * 128 + prow)) * 128 + fq * 8 + 32 * ks);
            __syncthreads();
#pragma unroll
            for (int nd = 0; nd < 4; ++nd) {
                f32x4 c = (f32x4){0.f, 0.f, 0.f, 0.f};
#pragma unroll
                for (int ks = 0; ks < 4; ++ks) {
                    const bf16x8 vf = *(const LAS bf16x8*)(vb + (16 * nd + fr) * VT_LD + fq * 8 + 32 * ks);
                    c = __builtin_amdgcn_mfma_f32_16x16x32_bf16(vf, wf[ks], c, 0, 0, 0);
                }
                const float bias = sgb[h * 128 + prow];
                const u32x2 uw = *(const u32x2*)(Z + (size_t)(r0 + prow) * ZW + 512 + h * 64 + 16 * nd + 4 * fq);
                f32x4 y; y[0] = bf_lo(uw.x) * (c[0] + bias); y[1] = bf_hi(uw.x) * (c[1] + bias); y[2] = bf_lo(uw.y) * (c[2] + bias); y[3] = bf_hi(uw.y) * (c[3] + bias);
                ss += (y[0] * y[0] + y[1] * y[1]) + (y[2] * y[2] + y[3] * y[3]);
                acc[h][nd] = y;
            }
        }
        ss += __shfl_xor(ss, 16); ss += __shfl_xor(ss, 32);
        const float rs = rsqrtf(ss * (1.0f / 512.0f) + EPS);
#pragma unroll
        for (int h = 0; h < 8; ++h)
#pragma unroll
            for (int nd = 0; nd < 4; ++nd) {
                const int c = h * 64 + 16 * nd + 4 * fq;
                const f32x4 g = *(const f32x4*)(gg + 512 + c);
                const f32x4 o = acc[h][nd] * rs * g;
                u32x2 w; w.x = cvt_pk_bf16(o[0], o[1]); w.y = cvt_pk_bf16(o[2], o[3]);
                if (dostore) *(u32x2*)(Z + (size_t)(r0 + prow) * ZW + 512 + c) = w;
            }
        __syncthreads();
    }
}


#define XB_TMO      128
#define XB_XCNT(j)  (256  + 64 * (j))
#define XB_XSUB(j)  (1280 + 64 * (j))
#define XB_XGEN(j)  (2304 + 64 * (j))
#define XB_TOP      3328
#define XB_TOPGEN   3392
#define XCD_BAR_WORDS 3456
#define XB_SPIN_CAP (1u << 20)
__device__ __forceinline__ unsigned xb_ld(unsigned* p)              { return __hip_atomic_load(p, __ATOMIC_RELAXED, __HIP_MEMORY_SCOPE_AGENT); }
__device__ __forceinline__ unsigned xb_add(unsigned* p, unsigned v) { return __hip_atomic_fetch_add(p, v, __ATOMIC_RELAXED, __HIP_MEMORY_SCOPE_AGENT); }
__device__ __forceinline__ unsigned xb_xcc_id() { return (unsigned)__builtin_amdgcn_s_getreg((3 << 11) | 20) & 0xFu; }
#define XB_SPIN(cond, bar) do { unsigned _sp = 0; while (cond) { __builtin_amdgcn_s_sleep(1); \
    if ((++_sp & 255u) == 0u) { if (xb_ld(&(bar)[XB_TMO])) break; if (_sp > XB_SPIN_CAP) { atomicAdd(&(bar)[XB_TMO], 1u); break; } } } } while (0)
struct XcdBarrier { unsigned* bar; unsigned x; volatile LAS unsigned* st; };
__device__ __forceinline__ XcdBarrier xcd_barrier_post(unsigned* bar, volatile LAS unsigned* st) {
    XcdBarrier b; b.bar = bar; b.x = xb_xcc_id(); b.st = st;
    if (threadIdx.x == 0) (void)xb_add(&bar[XB_XCNT(b.x)], 1u);
    return b;
}
__device__ __forceinline__ void xcd_barrier_complete(unsigned* bar, unsigned x, unsigned& nloc, unsigned& nx) {
    const unsigned G = gridDim.x * gridDim.y * gridDim.z;
    unsigned sum, cnt, mine, sp = 0u;
    for (;;) {
        sum = 0u; cnt = 0u; mine = 0u;
#pragma unroll
        for (unsigned j = 0; j < 16; ++j) { const unsigned c = xb_ld(&bar[XB_XCNT(j)]); sum += c; cnt += (c > 0u) ? 1u : 0u; mine = (j == x) ? c : mine; }
        if (sum == G) break;
        __builtin_amdgcn_s_sleep(1);
        if ((++sp & 255u) == 0u) { if (xb_ld(&bar[XB_TMO])) break; if (sp > XB_SPIN_CAP) { atomicAdd(&bar[XB_TMO], 1u); break; } }
    }
    nloc = mine > 0u ? mine : 1u; nx = cnt > 0u ? cnt : 1u;
}
__device__ __forceinline__ void xcd_barrier(const XcdBarrier& b) {
    asm volatile("s_waitcnt vmcnt(0)" ::: "memory");
    __syncthreads();
    if (threadIdx.x == 0) {
        unsigned* bar = b.bar;
        __builtin_amdgcn_s_waitcnt(0);
        unsigned nloc = b.st[0], nx = b.st[1];
        if (nloc == 0u) { xcd_barrier_complete(bar, b.x, nloc, nx); b.st[0] = nloc; b.st[1] = nx; }
        const unsigned old = xb_add(&bar[XB_XSUB(b.x)], 1u);
        const unsigned gen = old / nloc;
        if (old + 1u == (gen + 1u) * nloc) {
            __builtin_amdgcn_fence(__ATOMIC_RELEASE, "agent");
            asm volatile("s_waitcnt vmcnt(0)" ::: "memory");
            const unsigned og = xb_add(&bar[XB_TOP], 1u);
            const unsigned tg = og / nx;
            if (og + 1u == (tg + 1u) * nx) xb_add(&bar[XB_TOPGEN], 1u);
            else XB_SPIN(xb_ld(&bar[XB_TOPGEN]) == tg, bar);
            __builtin_amdgcn_fence(__ATOMIC_ACQUIRE, "agent");
            xb_add(&bar[XB_XGEN(b.x)], 1u);
            asm volatile("s_waitcnt vmcnt(0)" ::: "memory");
        } else {
            XB_SPIN(xb_ld(&bar[XB_XGEN(b.x)]) == gen, bar);
            __builtin_amdgcn_fence(__ATOMIC_ACQUIRE, "agent");
            asm volatile("s_waitcnt vmcnt(0)" ::: "memory");
        }
    }
    __syncthreads();
}

__global__ void __launch_bounds__(NTHREADS, 2) fwd_megakernel(Args a) {
    extern __shared__ __attribute__((aligned(16))) unsigned char lds_raw[];
    LAS unsigned char* lds = (LAS unsigned char*)lds_raw;
    const int G = gridDim.x, bid = blockIdx.x;
    unsigned char* ws = a.ws;
    volatile LAS unsigned* bst = (volatile LAS unsigned*)(lds + 131072 + 512);
    if (threadIdx.x < 2) bst[threadIdx.x] = 0u;
    __syncthreads();
    XcdBarrier xbar; xbar.bar = (unsigned*)ws; xbar.x = 0; xbar.st = bst;
    if (a.ph_hi - a.ph_lo > 1) xbar = xcd_barrier_post((unsigned*)ws, bst);
#define GRID_SYNC(first) do { if (first) cg::this_grid().sync(); else xcd_barrier(xbar); } while (0)
    for (int ph = a.ph_lo; ph < a.ph_hi; ++ph) {
        int nrep = 1;
#if MK_PROBE == 1
        if (ph <= 1) nrep = 2;
#elif MK_PROBE == 2
        if (ph >= 2 && ph < NPHASES - 1) { const int s_ = (ph - 2) % 11; if (s_ == 0 || s_ == 2 || s_ == 7 || s_ == 9) nrep = 2; }
#elif MK_PROBE == 5
        if (ph >= 2 && ph < NPHASES - 1) { const int s_ = (ph - 2) % 11; if (s_ == 5) nrep = 2; }
#elif MK_PROBE == 6
        if (ph >= 2 && ph < NPHASES - 1) { const int s_ = (ph - 2) % 11; if (s_ == 1 || s_ == 3 || s_ == 6 || s_ == 8 || s_ == 10) nrep = 2; }
#elif MK_PROBE == 4
        if (ph >= 2 && ph < NPHASES - 1) { const int s_ = (ph - 2) % 11; if (s_ == 4) nrep = 2; }
#endif
        asm volatile("" : "+s"(nrep));
        for (int rep = 0; rep < nrep; ++rep) {
        int dostore = (rep + 1 == nrep) ? 1 : 0; dostore = __builtin_amdgcn_readfirstlane(dostore);
        if (ph == 0) phase_p0a(a, lds, bid, G);
        else if (ph == 1) phase_p0b(a, lds, bid, G);
        else if (ph == NPHASES - 1) phase_final(a, bid, G);
        else {
            const int q = ph - 2, l = q / 11, s = q % 11;
            const float* mod_l = (const float*)(ws + WS_MOD) + (size_t)l * NBATCH * NMOD;
            const float* gmt = (const float*)(ws + WS_GM);
            const float* svl = (const float*)(ws + WS_SV) + (size_t)l * SV_LAYER;
            float* rss = (float*)(ws + WS_RSS);
            bf16_t* xg = (bf16_t*)(ws + WS_XG);
            bf16_t* zh = (bf16_t*)(ws + WS_ZH);
            if (s == 5) phase_mixer(a, lds, l, bid, G, dostore);
            else if (s == 4) {
                pg8::Gemm g{xg, (const bf16_t*)(ws + WS_WINT) + (size_t)l * DIN * D, MTOT, DIN, D, D};
                pg8::StaticOrder S; S.init(MTOT, DIN, G, bid);
                EpiMixIn E{zh, rss, svl + NBATCH * NUP, (float*)(ws + WS_VST)};
                pg8::gemm_phase<EpiMixIn, pg8::StaticOrder, true, true>(lds, g, S, E);
            } else if (s == 6) {
                pg8::Gemm g{zh, (const bf16_t*)(ws + WS_WOUTT) + (size_t)l * D * D, MTOT, D, D, ZW};
                pg8::StaticOrder S; S.init(MTOT, D, G, bid);
                EpiRes E{a.xp, a.xs, 0, a.out, xg, rss, mod_l + 5 * D, gmt + (size_t)(l * 3 + 2) * NBATCH * D, 1.0f, 0, dostore};
                pg8::gemm_phase<EpiRes, pg8::StaticOrder, true, true>(lds, g, S, E);
            } else {
                const int f = s >= 7 ? 1 : 0, s2 = f ? s - 7 : s, half = s2 >> 1, rowbase = half * MP;
                if ((s2 & 1) == 0) {
                    pg8::Gemm g{xg + (size_t)rowbase * D, (const bf16_t*)(ws + WS_W1T) + (size_t)(l * 2 + f) * NUP * D, MP, NUP, D, D};
                    pg8::StaticOrder S; S.init(MP, NUP, G, bid);
                    EpiUp E{zh, rss, svl + (f ? NBATCH * (NUP + DIN) : 0), rowbase};
                    pg8::gemm_phase<EpiUp, pg8::StaticOrder, true, true>(lds, g, S, E);
                } else {
                    pg8::Gemm g{zh, (const bf16_t*)(ws + WS_W2T) + (size_t)(l * 2 + f) * D * FF, MP, D, FF, FF};
                    pg8::StaticOrder S; S.init(MP, D, G, bid);
                    const float* gmn = f == 0 ? gmt + (size_t)(l * 3 + 1) * NBATCH * D : (l == 0 ? gmt + (size_t)3 * NBATCH * D : nullptr);
                    EpiRes E{a.xp, a.xs, (l == 0 && f == 0) ? 1 : 0, a.out, xg, rss, mod_l + (f ? 8 : 2) * D, gmn, 0.5f, rowbase, dostore};
                    pg8::gemm_phase<EpiRes, pg8::StaticOrder, true, true>(lds, g, S, E);
                }
            }
        }
        if (rep + 1 < nrep) GRID_SYNC(0);
        }
        if (ph + 1 < a.ph_hi) GRID_SYNC(ph == a.ph_lo);
#if MK_PROBE == 3
        if (ph + 1 < a.ph_hi) GRID_SYNC(0);
#endif
    }
}

extern "C" void kernel_launch(void* const* d_in, const int* in_sizes, int n_in, void* d_out, int out_size, void* d_ws, size_t ws_size, hipStream_t stream) {
    static int grid = 0;
    if (grid == 0) {
        if (n_in != 17 || out_size != MTOT * D || ws_size < WS_END) { fprintf(stderr, "kernel_launch: unexpected shapes (n_in %d out %d ws %zu)\n", n_in, out_size, ws_size); grid = -1; return; }
        int dev = 0, cus = 0, per_cu = 0;
        hipGetDevice(&dev);
        hipDeviceGetAttribute(&cus, hipDeviceAttributeMultiprocessorCount, dev);
        if (hipFuncSetAttribute((const void*)fwd_megakernel, hipFuncAttributeMaxDynamicSharedMemorySize, LDS_BYTES) != hipSuccess) { fprintf(stderr, "kernel_launch: hipFuncSetAttribute failed\n"); grid = -1; return; }
        if (hipOccupancyMaxActiveBlocksPerMultiprocessor(&per_cu, (const void*)fwd_megakernel, NTHREADS, LDS_BYTES) != hipSuccess || per_cu < 1) { fprintf(stderr, "kernel_launch: occupancy query says %d\n", per_cu); per_cu = 1; }
        (void)hipGetLastError();
        grid = cus * per_cu;
        fprintf(stderr, "kernel_launch: grid %d (cus %d x %d)\n", grid, cus, per_cu);
    }
    if (grid < 0) return;
    Args a{};
    a.xp = (const float*)d_in[0]; a.xs = (const float*)d_in[1]; a.cp = (const float*)d_in[2]; a.cs = (const float*)d_in[3];
    a.ada_w = (const float*)d_in[4]; a.ada_b = (const float*)d_in[5]; a.norm_g = (const float*)d_in[6]; a.ffn_w1 = (const float*)d_in[7];
    a.ffn_w2 = (const float*)d_in[8]; a.mix_w_in = (const float*)d_in[9]; a.conv_w = (const float*)d_in[10]; a.sg_norm_g = (const float*)d_in[11];
    a.sg_ws = (const float*)d_in[12]; a.sg_bs = (const float*)d_in[13]; a.grp_g = (const float*)d_in[14]; a.mix_w_out = (const float*)d_in[15];
    a.final_g = (const float*)d_in[16];
    a.out = (float*)d_out; a.ws = (unsigned char*)d_ws;
#if MK_ONE_LAUNCH
    a.ph_lo = 0; a.ph_hi = NPHASES;
    if (hipMemsetAsync(d_ws, 0, XCD_BAR_WORDS * 4, stream) != hipSuccess) { fprintf(stderr, "kernel_launch: memset failed\n"); return; }
    void* args[] = {&a};
    hipError_t e = hipLaunchCooperativeKernel((const void*)fwd_megakernel, dim3(grid), dim3(NTHREADS), args, LDS_BYTES, stream);
    if (e != hipSuccess) fprintf(stderr, "cooperative launch failed: %s (grid %d)\n", hipGetErrorString(e), grid);
#else
    for (int ph = 0; ph < NPHASES; ++ph) {
        a.ph_lo = ph; a.ph_hi = ph + 1;
        hipLaunchKernelGGL(fwd_megakernel, dim3(grid), dim3(NTHREADS), LDS_BYTES, stream, a);
    }
#endif
}
```

```cpp
#include <hip/hip_runtime.h>
#include <hip/hip_cooperative_groups.h>
#include <cstdio>
#include <cstdint>
namespace cg = cooperative_groups;

#ifndef MK_PROBE
#define MK_PROBE 0
#endif
#ifndef MK_ONE_LAUNCH
#define MK_ONE_LAUNCH 1
#endif

constexpr int D = 1024, FF = 2816, NUP = 2 * FF, DIN = 2560, ZW = 2048;
constexpr int MTOT = 65536, MP = 32768;
constexpr int NBATCH = 10, NMOD = 9 * D;
constexpr float EPS = 1e-6f;
constexpr int NWAVES = 8, NTHREADS = 512;
constexpr int NPHASES = 25;

constexpr size_t MiB = 1u << 20;
constexpr size_t WS_MOD = 1 * MiB;
constexpr size_t WS_GM = 2 * MiB;
constexpr size_t WS_SV = 3 * MiB;
constexpr size_t WS_RSS = 5 * MiB;
constexpr size_t WS_VST = 9 * MiB;
constexpr size_t WS_WSG = 13 * MiB;
constexpr size_t WS_W1T = 14 * MiB;
constexpr size_t WS_W2T = 58 * MiB;
constexpr size_t WS_WINT = 80 * MiB;
constexpr size_t WS_WOUTT = 90 * MiB;
constexpr size_t WS_XG = 94 * MiB;
constexpr size_t WS_ZH = 222 * MiB;
constexpr size_t WS_END = 478 * MiB;
constexpr int SV_LAYER = NBATCH * (NUP + DIN + NUP);

constexpr int LDS_BYTES = 147456;

namespace pg8 {
#define PG8_LAS __attribute__((address_space(3)))
typedef unsigned short bf16_t;
typedef short bf16x8 __attribute__((ext_vector_type(8)));
typedef float f32x4 __attribute__((ext_vector_type(4)));
typedef float f32x2 __attribute__((ext_vector_type(2)));
typedef unsigned u32x4 __attribute__((ext_vector_type(4)));
typedef unsigned u32x2 __attribute__((ext_vector_type(2)));
constexpr int BM = 256, BK = 64, HALF = 128, HTB = HALF * BK * 2, STAGE_BYTES = 8 * HTB, NXCD = 8, WGM = 8;

__host__ __device__ __forceinline__ int lds_byte(int r, int c) { const int st = (r >> 4) * 2 + (c >> 5), rr = r & 15, cc = c & 31, ob = rr * 64 + cc * 2; return st * 1024 + (ob ^ (((ob >> 9) & 1) << 5)); }
__host__ __device__ __forceinline__ void stage_rc(int b, int& R, int& C) { const int st = b / 1024, sb = b % 1024, swz = sb ^ (((sb >> 9) & 1) << 5); R = (st >> 1) * 16 + swz / 64; C = (st & 1) * 32 + (swz % 64) / 2; }
__host__ __device__ __forceinline__ int perm32(int rho) { const int n = rho >> 4, i = rho & 15; return 8 * (i >> 2) + 4 * n + (i & 3); }

struct Unit { int pm, pn; };
struct Gemm { const bf16_t* A; const bf16_t* Bt; int M, N, K, lda; };

struct StaticOrder {
    int nM, nN, nwg, G, c;
    __host__ __device__ void init(int M, int N, int G_, int c_) { nM = M / BM; nN = N / BM; nwg = nM * nN; G = G_; c = c_; }
    __host__ __device__ bool next(int i, Unit& u) const {
        const long L = (long)i * G + c; if (L >= nwg) return false;
        int wgid = (int)L; { const int q = nwg / NXCD, r = nwg % NXCD, xcd = wgid % NXCD, off = wgid / NXCD; wgid = (xcd < r ? xcd * (q + 1) : r * (q + 1) + (xcd - r) * q) + off; }
        const int nig = WGM * nN, gid = wgid / nig, fm = gid * WGM, gsz = (nM - fm) < WGM ? (nM - fm) : WGM;
        u.pm = fm + ((wgid % nig) % gsz); u.pn = (wgid % nig) / gsz; return true;
    }
};

__device__ __forceinline__ unsigned cvt_pk_bf16(float lo, float hi) { unsigned r; asm volatile("v_cvt_pk_bf16_f32 %0, %1, %2" : "=v"(r) : "v"(lo), "v"(hi)); return r; }
__device__ __forceinline__ f32x2 gelu_pk(f32x2 v) {
    const f32x2 av = __builtin_elementwise_abs(v), d = av * 0.2316418882f + 1.0f;
    f32x2 t; t.x = __builtin_amdgcn_rcpf(d.x); t.y = __builtin_amdgcn_rcpf(d.y);
    f32x2 q = t * 0.5307027145f + (-0.7265760135f); q = q * t + 0.7107068705f; q = q * t + (-0.142248368f); q = q * t + 0.127414796f; q = q * t;
    const f32x2 s = (v * v) * (-0.72134752044f);
    f32x2 e; e.x = __builtin_amdgcn_exp2f(s.x); e.y = __builtin_amdgcn_exp2f(s.y);
    const f32x2 m = v * (q * e), r = v - m;
    f32x2 o; o.x = v.x < 0.f ? m.x : r.x; o.y = v.y < 0.f ? m.y : r.y; return o;
}
__device__ __forceinline__ f32x4 gelu4(f32x4 v) { const f32x2 a = gelu_pk((f32x2){v[0], v[1]}), b = gelu_pk((f32x2){v[2], v[3]}); return (f32x4){a.x, a.y, b.x, b.y}; }
__device__ __forceinline__ float silu1(float g) { return g * __builtin_amdgcn_rcpf(1.0f + __builtin_amdgcn_exp2f(-1.4426950409f * g)); }
__device__ __forceinline__ f32x2 silu_mul_pk(f32x2 g, f32x2 u) {
    const f32x2 t = g * (-1.4426950409f);
    f32x2 e; e.x = __builtin_amdgcn_exp2f(t.x); e.y = __builtin_amdgcn_exp2f(t.y);
    const f32x2 d = e + 1.0f;
    f32x2 r; r.x = __builtin_amdgcn_rcpf(d.x); r.y = __builtin_amdgcn_rcpf(d.y);
    return (g * u) * r;
}

__device__ __forceinline__ int lane_id_v() { int l; asm volatile("v_mbcnt_lo_u32_b32 %0, -1, 0\n\tv_mbcnt_hi_u32_b32 %0, -1, %0" : "=v"(l)); return l; }
template <class Epi, class Sched, bool ALIGN_EPI, bool SP2>
__device__ __forceinline__ void gemm_phase(PG8_LAS unsigned char* lds, const Gemm g, const Sched& S, const Epi& E, int wid) {
    const int lane = lane_id_v(), tid = wid * 64 + lane;
    const int wr = wid >> 2, wc = wid & 3, fr = lane & 15, fq = lane >> 4;
    const int K = g.K, nt = K / BK, lda = g.lda;
    unsigned voffA[2], voffB[2];
#pragma unroll
    for (int i = 0; i < 2; ++i) { int R, C; stage_rc(tid * 16 + i * 8192, R, C); const int Rb = Epi::PERM ? ((R & ~31) + perm32(R & 31)) : R;
        voffA[i] = (unsigned)(R * lda + C) * 2u; voffB[i] = (unsigned)(Rb * K + C) * 2u; }
    const size_t kstep = (size_t)(BK * 2);
    const size_t hstepA = (size_t)HALF * lda * 2, hstepB = (size_t)HALF * K * 2;
    const size_t tstepA = 2 * hstepA, tstepB = 2 * hstepB;
    const unsigned ldsw = (unsigned)wid * 1024u;
    const int aoff = lds_byte(wr * 64 + fr, fq * 8), boff = lds_byte(wc * 32 + fr, fq * 8);
#define PG8_SA(b, h) (((b) * 2 + (h)) * HTB)
#define PG8_SB(b, h) ((4 + (b) * 2 + (h)) * HTB)
#define PG8_STAGE(bufoff, gbase, voff) do { _Pragma("unroll") for (int _i = 0; _i < 2; ++_i) \
        __builtin_amdgcn_global_load_lds((const unsigned*)((const char*)(gbase) + (voff)[_i]), (PG8_LAS unsigned*)(lds + (bufoff) + ldsw + _i * 8192), 16, 0, 0); } while (0)
#define PG8_LDA(dst, b, h) do { _Pragma("unroll") for (int m = 0; m < 4; ++m) _Pragma("unroll") for (int k = 0; k < 2; ++k) dst[m][k] = *(const PG8_LAS bf16x8*)(lds + PG8_SA(b, h) + aoff + m * 2048 + k * 1024); } while (0)
#define PG8_LDB(dst, b, h) do { _Pragma("unroll") for (int n = 0; n < 2; ++n) _Pragma("unroll") for (int k = 0; k < 2; ++k) dst[n][k] = *(const PG8_LAS bf16x8*)(lds + PG8_SB(b, h) + boff + n * 2048 + k * 1024); } while (0)
#define PG8_MMA(ai, bj, At, Bt) do { __builtin_amdgcn_s_setprio(1); _Pragma("unroll") for (int m = 0; m < 4; ++m) _Pragma("unroll") for (int n = 0; n < 2; ++n) _Pragma("unroll") for (int k = 0; k < 2; ++k) \
        acc[ai][bj][m][n] = __builtin_amdgcn_mfma_f32_16x16x32_bf16(Bt[n][k], At[m][k], acc[ai][bj][m][n], 0, 0, 0); __builtin_amdgcn_s_setprio(0); } while (0)
#define PG8_WAIT_V(n) asm volatile("s_waitcnt vmcnt(" #n ")" ::: "memory")
#define PG8_WAIT_L(n) asm volatile("s_waitcnt lgkmcnt(" #n ")" ::: "memory")
#define PG8_BAR __builtin_amdgcn_s_barrier()
#define PG8_SCHED __builtin_amdgcn_sched_barrier(0)
    Unit cur, nxt; int ui = 0;
    if (!S.next(0, cur)) return;
    f32x4 acc[2][2][4][2];
#pragma unroll
    for (int a = 0; a < 2; ++a)
#pragma unroll
        for (int b = 0; b < 2; ++b)
#pragma unroll
            for (int m = 0; m < 4; ++m)
#pragma unroll
                for (int n = 0; n < 2; ++n) acc[a][b][m][n] = (f32x4){0.f, 0.f, 0.f, 0.f};
    bf16x8 At[4][2], B0[2][2], B1[2][2];
    const char* cA = (const char*)g.A + (size_t)cur.pm * tstepA; const char* cB = (const char*)g.Bt + (size_t)cur.pn * tstepB;
    if constexpr (SP2) {
        PG8_STAGE(PG8_SB(0, 0), cB, voffB); PG8_STAGE(PG8_SB(0, 1), cB + hstepB, voffB); PG8_STAGE(PG8_SA(0, 0), cA, voffA); PG8_STAGE(PG8_SA(0, 1), cA + hstepA, voffA);
        if (wr == 1) PG8_BAR;
        PG8_WAIT_V(2); PG8_BAR;
        PG8_STAGE(PG8_SB(1, 0), cB + kstep, voffB); PG8_STAGE(PG8_SA(1, 0), cA + kstep, voffA); PG8_STAGE(PG8_SB(1, 1), cB + hstepB + kstep, voffB);
        PG8_WAIT_V(6); PG8_BAR;
    } else {
        PG8_STAGE(PG8_SB(0, 0), cB, voffB); PG8_STAGE(PG8_SA(0, 0), cA, voffA); PG8_STAGE(PG8_SB(0, 1), cB + hstepB, voffB); PG8_STAGE(PG8_SA(0, 1), cA + hstepA, voffA);
        if (wr == 1) PG8_BAR;
        PG8_WAIT_V(4); PG8_BAR;
        PG8_STAGE(PG8_SB(1, 0), cB + kstep, voffB); PG8_STAGE(PG8_SA(1, 0), cA + kstep, voffA); PG8_STAGE(PG8_SB(1, 1), cB + hstepB + kstep, voffB);
        PG8_WAIT_V(6); PG8_BAR;
    }
    for (;;) {
        const bool has_next = S.next(ui + 1, nxt);
        const char* nA = has_next ? (const char*)g.A + (size_t)nxt.pm * tstepA : cA; const char* nB = has_next ? (const char*)g.Bt + (size_t)nxt.pn * tstepB : cB;
        for (int t = 0; t < nt; t += 2) {
            const bool last = (t == nt - 2);
            const char* a1 = cA + (size_t)(t + 1) * kstep;
            const char* a2 = last ? nA : cA + (size_t)(t + 2) * kstep; const char* b2 = last ? nB : cB + (size_t)(t + 2) * kstep;
            const char* a3 = a2 + kstep; const char* b3 = b2 + kstep;
            if constexpr (SP2) {
            PG8_LDB(B0, 0, 0); PG8_LDB(B1, 0, 1); PG8_SCHED; PG8_LDA(At, 0, 0); PG8_STAGE(PG8_SA(1, 1), a1 + hstepA, voffA);
            PG8_WAIT_V(8); PG8_WAIT_L(0); PG8_BAR; PG8_MMA(0, 0, At, B0); PG8_MMA(0, 1, At, B1); PG8_BAR; PG8_SCHED;
            PG8_LDA(At, 0, 1); PG8_STAGE(PG8_SB(0, 0), b2, voffB); PG8_STAGE(PG8_SB(0, 1), b2 + hstepB, voffB); PG8_STAGE(PG8_SA(0, 0), a2, voffA);
            PG8_WAIT_V(8); PG8_WAIT_L(0); PG8_BAR; PG8_MMA(1, 0, At, B0); PG8_MMA(1, 1, At, B1); PG8_BAR; PG8_SCHED;
            PG8_LDB(B0, 1, 0); PG8_LDB(B1, 1, 1); PG8_SCHED; PG8_LDA(At, 1, 0); PG8_STAGE(PG8_SA(0, 1), a2 + hstepA, voffA);
            PG8_WAIT_V(8); PG8_WAIT_L(0); PG8_BAR; PG8_MMA(0, 0, At, B0); PG8_MMA(0, 1, At, B1); PG8_BAR; PG8_SCHED;
            PG8_LDA(At, 1, 1); PG8_STAGE(PG8_SB(1, 0), b3, voffB); PG8_STAGE(PG8_SB(1, 1), b3 + hstepB, voffB); PG8_STAGE(PG8_SA(1, 0), a3, voffA);
            PG8_WAIT_V(8); PG8_WAIT_L(0); PG8_BAR; PG8_MMA(1, 0, At, B0); PG8_MMA(1, 1, At, B1); PG8_BAR; PG8_SCHED;
            } else {
            PG8_LDB(B0, 0, 0); PG8_SCHED; PG8_LDA(At, 0, 0); PG8_STAGE(PG8_SA(1, 1), a1 + hstepA, voffA);
            PG8_WAIT_L(8); PG8_BAR; PG8_WAIT_L(0); PG8_MMA(0, 0, At, B0); PG8_BAR; PG8_SCHED;
            PG8_LDB(B1, 0, 1); PG8_STAGE(PG8_SB(0, 0), b2, voffB);
            PG8_BAR; PG8_WAIT_L(0); PG8_MMA(0, 1, At, B1); PG8_BAR;
            PG8_LDA(At, 0, 1); PG8_STAGE(PG8_SA(0, 0), a2, voffA);
            PG8_BAR; PG8_WAIT_L(0); PG8_MMA(1, 0, At, B0); PG8_BAR; PG8_SCHED;
            PG8_STAGE(PG8_SB(0, 1), b2 + hstepB, voffB);
            PG8_WAIT_V(6); PG8_BAR; PG8_MMA(1, 1, At, B1); PG8_BAR;
            PG8_LDB(B0, 1, 0); PG8_SCHED; PG8_LDA(At, 1, 0); PG8_STAGE(PG8_SA(0, 1), a2 + hstepA, voffA);
            PG8_WAIT_L(8); PG8_BAR; PG8_WAIT_L(0); PG8_MMA(0, 0, At, B0); PG8_BAR; PG8_SCHED;
            PG8_LDB(B1, 1, 1); PG8_STAGE(PG8_SB(1, 0), b3, voffB);
            PG8_BAR; PG8_WAIT_L(0); PG8_MMA(0, 1, At, B1); PG8_BAR;
            PG8_LDA(At, 1, 1); PG8_STAGE(PG8_SA(1, 0), a3, voffA);
            PG8_BAR; PG8_WAIT_L(0); PG8_MMA(1, 0, At, B0); PG8_BAR; PG8_SCHED;
            PG8_STAGE(PG8_SB(1, 1), b3 + hstepB, voffB);
            PG8_WAIT_V(6); PG8_BAR; PG8_MMA(1, 1, At, B1); PG8_BAR;
            }
        }
        if constexpr (ALIGN_EPI) { if (wr == 0) PG8_BAR; }
        E(acc, cur, wr, wc, fr, fq);
        if (!has_next) break;
#pragma unroll
        for (int a = 0; a < 2; ++a)
#pragma unroll
            for (int b = 0; b < 2; ++b)
#pragma unroll
                for (int m = 0; m < 4; ++m)
#pragma unroll
                    for (int n = 0; n < 2; ++n) acc[a][b][m][n] = (f32x4){0.f, 0.f, 0.f, 0.f};
        cur = nxt; cA = nA; cB = nB; ++ui;
        if constexpr (ALIGN_EPI) { if (wr == 1) PG8_BAR; }
    }
    PG8_WAIT_V(0);
    if constexpr (!ALIGN_EPI) { if (wr == 0) PG8_BAR; }
    PG8_BAR;
#undef PG8_SA
#undef PG8_SB
#undef PG8_STAGE
#undef PG8_LDA
#undef PG8_LDB
#undef PG8_MMA
#undef PG8_WAIT_V
#undef PG8_WAIT_L
#undef PG8_BAR
#undef PG8_SCHED
}
}

using pg8::bf16_t; using pg8::f32x4; using pg8::f32x2; using pg8::u32x4; using pg8::u32x2; using pg8::bf16x8; using pg8::cvt_pk_bf16;
#define LAS __attribute__((address_space(3)))

__device__ __forceinline__ int batch_of(int r) { return r < MP ? (r >> 12) : 8 + ((r - MP) >> 14); }
__device__ __forceinline__ float wave_sum(float v) {
#pragma unroll
    for (int o = 1; o < 64; o <<= 1) v += __shfl_xor(v, o);
    return v;
}
__device__ __forceinline__ float bf_lo(unsigned w) { return __uint_as_float(w << 16); }
__device__ __forceinline__ float bf_hi(unsigned w) { return __uint_as_float(w & 0xffff0000u); }
__device__ __forceinline__ float row_rstd(const float* rss, int row, int fq) {
    const f32x4 p = *(const f32x4*)(rss + (size_t)row * 16 + 4 * fq);
    float s = (p[0] + p[1]) + (p[2] + p[3]);
    s += __shfl_xor(s, 16); s += __shfl_xor(s, 32);
    return rsqrtf(s * (1.0f / D) + EPS);
}

__device__ __forceinline__ void rows_rstd8(const float* rss, int row0, int fq, float (&rs)[8]) {
    f32x4 pr[8];
#pragma unroll
    for (int i = 0; i < 8; ++i) pr[i] = *(const f32x4*)(rss + (size_t)(row0 + (i >> 2) * 128 + (i & 3) * 16) * 16 + 4 * fq);
#pragma unroll
    for (int i = 0; i < 8; ++i) { float t = (pr[i][0] + pr[i][1]) + (pr[i][2] + pr[i][3]); t += __shfl_xor(t, 16); t += __shfl_xor(t, 32); rs[i] = rsqrtf(t * (1.0f / D) + EPS); }
}
struct EpiUp {
    static constexpr bool PERM = true;
    bf16_t* H; const float* rss; const float* S; int rowbase;
    __device__ __forceinline__ void operator()(const f32x4 (&acc)[2][2][4][2], const pg8::Unit& u, int wr, int wc, int fr_, int fq_) const {
        const int lane_ = pg8::lane_id_v(); const int fr = lane_ & 15, fq = lane_ >> 4;
        const int lrow0 = u.pm * 256 + wr * 64 + fr;
        const int b = batch_of(rowbase + u.pm * 256);
        const float* Sb = S + (size_t)b * NUP + u.pn * 256 + wc * 32 + 8 * fq;
        f32x4 sv[2][2];
#pragma unroll
        for (int bj = 0; bj < 2; ++bj)
#pragma unroll
            for (int n = 0; n < 2; ++n) sv[bj][n] = *(const f32x4*)(Sb + bj * 128 + 4 * n);
        float rs8[8]; rows_rstd8(rss, rowbase + lrow0, fq, rs8);
        const int hcol = u.pn * 128 + wc * 32 + 8 * fq;
#pragma unroll
        for (int ai = 0; ai < 2; ++ai)
#pragma unroll
            for (int m = 0; m < 4; ++m) {
                const int lr = lrow0 + ai * 128 + m * 16;
                const float rs = rs8[ai * 4 + m];
                const f32x4 g0 = acc[ai][0][m][0] * rs + sv[0][0], g1 = acc[ai][0][m][1] * rs + sv[0][1];
                const f32x4 u0 = acc[ai][1][m][0] * rs + sv[1][0], u1 = acc[ai][1][m][1] * rs + sv[1][1];
                const f32x2 ha = pg8::silu_mul_pk((f32x2){g0[0], g0[1]}, (f32x2){u0[0], u0[1]}), hb = pg8::silu_mul_pk((f32x2){g0[2], g0[3]}, (f32x2){u0[2], u0[3]});
                const f32x2 hc = pg8::silu_mul_pk((f32x2){g1[0], g1[1]}, (f32x2){u1[0], u1[1]}), hd = pg8::silu_mul_pk((f32x2){g1[2], g1[3]}, (f32x2){u1[2], u1[3]});
                u32x4 w; w.x = cvt_pk_bf16(ha.x, ha.y); w.y = cvt_pk_bf16(hb.x, hb.y); w.z = cvt_pk_bf16(hc.x, hc.y); w.w = cvt_pk_bf16(hd.x, hd.y);
                *(u32x4*)(H + (size_t)lr * FF + hcol) = w;
            }
    }
};

#ifndef RES_DEPTH
#define RES_DEPTH 3
#endif
struct EpiRes {
    static constexpr bool PERM = false;
    const float* xp; const float* xs; int first;
    float* out; bf16_t* xg; float* rss; const float* gate; const float* gm; float coef; int rowbase; int dostore;
    __device__ __forceinline__ void operator()(const f32x4 (&acc)[2][2][4][2], const pg8::Unit& u, int wr, int wc, int fr_, int fq_) const {
        const int lane_ = pg8::lane_id_v(); const int fr = lane_ & 15, fq = lane_ >> 4;
        const int grow0 = rowbase + u.pm * 256 + wr * 64 + fr;
        const int b = batch_of(rowbase + u.pm * 256);
        const int col0 = u.pn * 256 + wc * 32 + 4 * fq;
        const float* rp0 = (first ? (grow0 < MP ? xp + (size_t)grow0 * D : xs + (size_t)(grow0 - MP) * D) : out + (size_t)grow0 * D) + col0;
        f32x4 xi[RES_DEPTH][4];
#pragma unroll
        for (int r = 0; r < RES_DEPTH; ++r)
#pragma unroll
            for (int q = 0; q < 4; ++q) xi[r][q] = *(const f32x4*)(rp0 + (size_t)((r >> 2) * 128 + (r & 3) * 16) * D + (q >> 1) * 128 + (q & 1) * 16);
        const float* gp = gate + (size_t)b * NMOD + col0;
        f32x4 gv[2][2], mv[2][2];
#pragma unroll
        for (int bj = 0; bj < 2; ++bj)
#pragma unroll
            for (int n = 0; n < 2; ++n) { gv[bj][n] = *(const f32x4*)(gp + bj * 128 + n * 16) * coef;
                mv[bj][n] = gm ? *(const f32x4*)(gm + b * D + col0 + bj * 128 + n * 16) : (f32x4){0.f, 0.f, 0.f, 0.f}; }
#pragma unroll
        for (int r = 0; r < 8; ++r) {
            const int ai = r >> 2, m = r & 3;
            const int grow = grow0 + ai * 128 + m * 16;
            f32x4 xo[4];
#pragma unroll
            for (int q = 0; q < 4; ++q) xo[q] = xi[r % RES_DEPTH][q] + gv[q >> 1][q & 1] * acc[ai][q >> 1][m][q & 1];
            if (r + RES_DEPTH < 8) {
                const int r2 = r + RES_DEPTH;
#pragma unroll
                for (int q = 0; q < 4; ++q) xi[r % RES_DEPTH][q] = *(const f32x4*)(rp0 + (size_t)((r2 >> 2) * 128 + (r2 & 3) * 16) * D + (q >> 1) * 128 + (q & 1) * 16);
            }
            float ss = 0.f;
#pragma unroll
            for (int q = 0; q < 4; ++q) {
                const int c = col0 + (q >> 1) * 128 + (q & 1) * 16;
                if (dostore) *(f32x4*)(out + (size_t)grow * D + c) = xo[q];
                ss += (xo[q][0] * xo[q][0] + xo[q][1] * xo[q][1]) + (xo[q][2] * xo[q][2] + xo[q][3] * xo[q][3]);
                if (gm && dostore) { const f32x4 o = xo[q] * mv[q >> 1][q & 1]; u32x2 w; w.x = cvt_pk_bf16(o[0], o[1]); w.y = cvt_pk_bf16(o[2], o[3]); *(u32x2*)(xg + (size_t)grow * D + c) = w; }
            }
            ss += __shfl_xor(ss, 16); ss += __shfl_xor(ss, 32);
            if (fq == 0 && dostore) rss[(size_t)grow * 16 + u.pn * 4 + wc] = ss;
        }
    }
};

struct EpiMixIn {
    static constexpr bool PERM = true;
    bf16_t* Z; const float* rss; const float* S; float* vst;
    __device__ __forceinline__ void operator()(const f32x4 (&acc)[2][2][4][2], const pg8::Unit& u, int wr, int wc, int fr_, int fq_) const {
        const int lane_ = pg8::lane_id_v(); const int fr = lane_ & 15, fq = lane_ >> 4;
        const int row0 = u.pm * 256 + wr * 64 + fr;
        const int b = batch_of(u.pm * 256);
        const float* Sb = S + (size_t)b * DIN + u.pn * 256 + wc * 32 + 8 * fq;
        f32x4 sv[2][2];
#pragma unroll
        for (int bj = 0; bj < 2; ++bj)
#pragma unroll
            for (int n = 0; n < 2; ++n) sv[bj][n] = *(const f32x4*)(Sb + bj * 128 + 4 * n);
        float rs8[8]; rows_rstd8(rss, row0, fq, rs8);
        const int pn = u.pn;
        const int lc = wc * 32 + 8 * fq;
#pragma unroll
        for (int ai = 0; ai < 2; ++ai)
#pragma unroll
            for (int m = 0; m < 4; ++m) {
                const int row = row0 + ai * 128 + m * 16;
                const float rs = rs8[ai * 4 + m];
                f32x4 v00 = acc[ai][0][m][0] * rs + sv[0][0], v01 = acc[ai][0][m][1] * rs + sv[0][1];
                f32x4 v10 = acc[ai][1][m][0] * rs + sv[1][0], v11 = acc[ai][1][m][1] * rs + sv[1][1];
                bf16_t* zr = Z + (size_t)row * ZW;
                if (pn >= 2 && pn < 6) {
                    const f32x4 o0 = v00 * v10, o1 = v01 * v11;
                    u32x4 w; w.x = cvt_pk_bf16(o0[0], o0[1]); w.y = cvt_pk_bf16(o0[2], o0[3]); w.z = cvt_pk_bf16(o1[0], o1[1]); w.w = cvt_pk_bf16(o1[2], o1[3]);
                    *(u32x4*)(zr + 1024 + (pn - 2) * 128 + lc) = w;
                } else {
                    int cbase = pn * 256;
                    if (pn >= 6) {
                        v00 = pg8::gelu4(v00); v01 = pg8::gelu4(v01); v10 = pg8::gelu4(v10); v11 = pg8::gelu4(v11);
                        cbase = pn < 8 ? 512 + (pn - 6) * 256 : 1536 + (pn - 8) * 256;
                    }
                    u32x4 w0, w1;
                    w0.x = cvt_pk_bf16(v00[0], v00[1]); w0.y = cvt_pk_bf16(v00[2], v00[3]); w0.z = cvt_pk_bf16(v01[0], v01[1]); w0.w = cvt_pk_bf16(v01[2], v01[3]);
                    w1.x = cvt_pk_bf16(v10[0], v10[1]); w1.y = cvt_pk_bf16(v10[2], v10[3]); w1.z = cvt_pk_bf16(v11[0], v11[1]); w1.w = cvt_pk_bf16(v11[2], v11[3]);
                    *(u32x4*)(zr + cbase + lc) = w0;
                    *(u32x4*)(zr + cbase + 128 + lc) = w1;
                    if (pn >= 8) {
                        const f32x4 s4 = (v00 + v01) + (v10 + v11);
                        const f32x4 q4 = (v00 * v00 + v01 * v01) + (v10 * v10 + v11 * v11);
                        float s1 = (s4[0] + s4[1]) + (s4[2] + s4[3]), s2 = (q4[0] + q4[1]) + (q4[2] + q4[3]);
                        s1 += __shfl_xor(s1, 16); s1 += __shfl_xor(s1, 32); s2 += __shfl_xor(s2, 16); s2 += __shfl_xor(s2, 32);
                        if (fq == 0) *(f32x2*)(vst + (size_t)row * 16 + ((pn - 8) * 4 + wc) * 2) = (f32x2){s1, s2};
                    }
                }
            }
    }
};

struct Args {
    const float* xp; const float* xs; const float* cp; const float* cs; const float* ada_w; const float* ada_b; const float* norm_g;
    const float* ffn_w1; const float* ffn_w2; const float* mix_w_in; const float* conv_w; const float* sg_norm_g; const float* sg_ws;
    const float* sg_bs; const float* grp_g; const float* mix_w_out; const float* final_g;
    float* out; unsigned char* ws; int ph_lo, ph_hi;
};

__device__ __forceinline__ unsigned f2bf(float f) { unsigned u = __float_as_uint(f); return (u + 0x7fffu + ((u >> 16) & 1u)) >> 16; }
__device__ __forceinline__ unsigned pk2(float lo, float hi) { return f2bf(lo) | (f2bf(hi) << 16); }

__device__ __forceinline__ int map_col(int mode, int s) {
    if (mode == 1) { const int bj = s >= FF ? 1 : 0, h = s - bj * FF; return 256 * (h >> 7) + 128 * bj + (h & 127); }
    if (mode == 2) { if (s >= 512 && s < 1024) { const int q = s - 512; return 512 + 256 * (q >> 7) + (q & 127); }
                     if (s >= 1024 && s < 1536) { const int q = s - 1024; return 512 + 256 * (q >> 7) + 128 + (q & 127); } }
    return s;
}
__device__ __forceinline__ void transpose_item(const float* W, int K, int N, bf16_t* WT, int mode, LAS float* scr, int item, int lane) {
    const int nblk = N / 32, kb = item / nblk, nb = item % nblk, k0 = 64 * kb, n0 = 32 * nb, dn0 = map_col(mode, n0);
#pragma unroll 8
    for (int i = 0; i < 32; ++i) { const int kk = 2 * i + (lane >> 5); scr[kk * 33 + (lane & 31)] = W[(size_t)(k0 + kk) * N + n0 + (lane & 31)]; }
    asm volatile("s_waitcnt lgkmcnt(0)" ::: "memory");
    const int c = lane & 7;
#pragma unroll
    for (int j = 0; j < 4; ++j) { const int n = (lane >> 3) + 8 * j; const LAS float* s = scr + (8 * c) * 33 + n;
        u32x4 o; o.x = pk2(s[0 * 33], s[1 * 33]); o.y = pk2(s[2 * 33], s[3 * 33]); o.z = pk2(s[4 * 33], s[5 * 33]); o.w = pk2(s[6 * 33], s[7 * 33]);
        *(u32x4*)(WT + (size_t)(dn0 + n) * K + k0 + 8 * c) = o; }
    asm volatile("s_waitcnt lgkmcnt(0)" ::: "memory");
}

__device__ __forceinline__ void phase_p0a(const Args& a, LAS unsigned char* lds, int bid, int G, int wave) {
    const int lane = pg8::lane_id_v(), tid = wave * 64 + lane;
    LAS float* sc = (LAS float*)lds;
    LAS float* scr = (LAS float*)(lds + 49152 + wave * 10240);
    float* mod = (float*)(a.ws + WS_MOD);
    if (bid < 288) {
        for (int i = tid; i < NBATCH * D; i += NTHREADS) { const int b = i >> 10, k = i & 1023; const float c = b < 8 ? a.cp[b * D + k] : a.cs[(b - 8) * D + k]; sc[i] = c / (1.0f + __expf(-c)); }
        __syncthreads();
        for (int it = bid; it < 288; it += G) {
            const int l = it / 144, n0 = (it % 144) * 64;
            const float* W = a.ada_w + (size_t)l * D * NMOD + n0 + lane;
            float acc[NBATCH];
#pragma unroll
            for (int b = 0; b < NBATCH; ++b) acc[b] = 0.f;
#pragma unroll 8
            for (int kk = 0; kk < 128; ++kk) { const int k = wave * 128 + kk; const float w = W[(size_t)k * NMOD];
#pragma unroll
                for (int b = 0; b < NBATCH; ++b) acc[b] += sc[b * D + k] * w; }
#pragma unroll
            for (int b = 0; b < NBATCH; ++b) scr[b * 64 + lane] = acc[b];
            __syncthreads();
            for (int i = tid; i < NBATCH * 64; i += NTHREADS) { const int b = i >> 6, c = i & 63; float s = 0.f;
#pragma unroll
                for (int w = 0; w < NWAVES; ++w) s += ((LAS float*)(lds + 49152 + w * 10240))[b * 64 + c];
                mod[((size_t)l * NBATCH + b) * NMOD + n0 + c] = s + a.ada_b[(size_t)l * NMOD + n0 + c]; }
            __syncthreads();
        }
    }
    const int gw = bid * NWAVES + wave, NGW = G * NWAVES;
    constexpr int I_W1 = (D / 64) * (NUP / 32), I_W2 = (FF / 64) * (D / 32), I_WIN = (D / 64) * (DIN / 32), I_WOUT = (D / 64) * (D / 32);
    constexpr int NITEMS = 4 * I_W1 + 4 * I_W2 + 2 * I_WIN + 2 * I_WOUT;
    for (int it = gw; it < NITEMS; it += NGW) {
        int r = it;
        if (r < 4 * I_W1) { const int mi = r / I_W1; transpose_item(a.ffn_w1 + (size_t)mi * D * NUP, D, NUP, (bf16_t*)(a.ws + WS_W1T) + (size_t)mi * NUP * D, 1, scr, r % I_W1, lane); continue; } r -= 4 * I_W1;
        if (r < 4 * I_W2) { const int mi = r / I_W2; transpose_item(a.ffn_w2 + (size_t)mi * FF * D, FF, D, (bf16_t*)(a.ws + WS_W2T) + (size_t)mi * D * FF, 0, scr, r % I_W2, lane); continue; } r -= 4 * I_W2;
        if (r < 2 * I_WIN) { const int mi = r / I_WIN; transpose_item(a.mix_w_in + (size_t)mi * D * DIN, D, DIN, (bf16_t*)(a.ws + WS_WINT) + (size_t)mi * DIN * D, 2, scr, r % I_WIN, lane); continue; } r -= 2 * I_WIN;
        { const int mi = r / I_WOUT; transpose_item(a.mix_w_out + (size_t)mi * D * D, D, D, (bf16_t*)(a.ws + WS_WOUTT) + (size_t)mi * D * D, 0, scr, r % I_WOUT, lane); }
    }
    { const f32x4* src = (const f32x4*)a.sg_ws; u32x2* dst = (u32x2*)(a.ws + WS_WSG);
      for (int i = bid * NTHREADS + tid; i < 2 * 8 * 128 * 128 / 4; i += G * NTHREADS) { const f32x4 v = src[i]; u32x2 w; w.x = pk2(v[0], v[1]); w.y = pk2(v[2], v[3]); dst[i] = w; } }
}

__device__ __forceinline__ void phase_p0b(const Args& a, LAS unsigned char* lds, int bid, int G, int wave) {
    const int lane = pg8::lane_id_v(), tid = wave * 64 + lane;
    const float* mod = (const float*)(a.ws + WS_MOD);
    float* gmt = (float*)(a.ws + WS_GM);
    for (int i = bid * NTHREADS + tid; i < 6 * NBATCH * D; i += G * NTHREADS) {
        const int d = i & 1023, b = (i >> 10) % NBATCH, lk = i / (NBATCH * D), l = lk / 3, k = lk % 3;
        gmt[i] = a.norm_g[(l * 3 + k) * D + d] * (1.0f + mod[((size_t)l * NBATCH + b) * NMOD + (3 * k + 1) * D + d]);
    }
    const int gw = bid * NWAVES + wave, NGW = G * NWAVES;
    LAS float* sh = (LAS float*)lds;
    for (int lk = 0; lk < 6; ++lk) {
        const int l = lk / 3, k = lk % 3;
        const int Nk = (k == 1) ? DIN : NUP;
        const bf16_t* WT = (k == 1) ? (const bf16_t*)(a.ws + WS_WINT) + (size_t)l * DIN * D : (const bf16_t*)(a.ws + WS_W1T) + (size_t)(l * 2 + (k == 2 ? 1 : 0)) * NUP * D;
        float* Sout = (float*)(a.ws + WS_SV) + (size_t)l * SV_LAYER + (k == 0 ? 0 : (k == 1 ? NBATCH * NUP : NBATCH * (NUP + DIN)));
        __syncthreads();
        for (int i = tid; i < NBATCH * D; i += NTHREADS) { const int b = i >> 10, d = i & 1023; sh[i] = mod[((size_t)l * NBATCH + b) * NMOD + (3 * k) * D + d]; }
        __syncthreads();
        for (int p = gw; p < Nk; p += NGW) {
            const u32x4 w0 = *(const u32x4*)(WT + (size_t)p * D + 8 * lane), w1 = *(const u32x4*)(WT + (size_t)p * D + 512 + 8 * lane);
            float wf[16];
#pragma unroll
            for (int j = 0; j < 4; ++j) { wf[2 * j] = bf_lo(w0[j]); wf[2 * j + 1] = bf_hi(w0[j]); wf[8 + 2 * j] = bf_lo(w1[j]); wf[8 + 2 * j + 1] = bf_hi(w1[j]); }
            float res = 0.f;
#pragma unroll
            for (int b = 0; b < NBATCH; ++b) {
                const LAS f32x4* s0 = (const LAS f32x4*)(sh + b * D + 8 * lane); const LAS f32x4* s1 = (const LAS f32x4*)(sh + b * D + 512 + 8 * lane);
                const f32x4 a0 = s0[0], a1 = s0[1], a2 = s1[0], a3 = s1[1];
                float s = 0.f;
#pragma unroll
                for (int j = 0; j < 4; ++j) s += a0[j] * wf[j] + a1[j] * wf[4 + j] + a2[j] * wf[8 + j] + a3[j] * wf[12 + j];
                s = wave_sum(s);
                if (lane == b) res = s;
            }
            if (lane < NBATCH) Sout[(size_t)lane * Nk + p] = res;
        }
    }
    const float* gm0 = nullptr; (void)gm0;
    bf16_t* xg = (bf16_t*)(a.ws + WS_XG); float* rss = (float*)(a.ws + WS_RSS);
    for (int r = gw; r < MTOT; r += NGW) {
        const int b = batch_of(r);
        const float* xr = r < MP ? a.xp + (size_t)r * D : a.xs + (size_t)(r - MP) * D;
        float ss = 0.f; f32x4 v[4];
#pragma unroll
        for (int j = 0; j < 4; ++j) { v[j] = *(const f32x4*)(xr + 4 * lane + 256 * j); ss += (v[j][0] * v[j][0] + v[j][1] * v[j][1]) + (v[j][2] * v[j][2] + v[j][3] * v[j][3]); }
        ss = wave_sum(ss);
        if (lane < 16) rss[(size_t)r * 16 + lane] = lane == 0 ? ss : 0.f;
#pragma unroll
        for (int j = 0; j < 4; ++j) { const int d = 4 * lane + 256 * j;
            const f32x4 g = *(const f32x4*)(a.norm_g + d); const f32x4 sc = *(const f32x4*)(mod + (size_t)b * NMOD + D + d);
            const f32x4 o = v[j] * (g * (sc + 1.0f));
            u32x2 w; w.x = cvt_pk_bf16(o[0], o[1]); w.y = cvt_pk_bf16(o[2], o[3]); *(u32x2*)(xg + (size_t)r * D + d) = w; }
    }
}

__device__ __forceinline__ void phase_final(const Args& a, int bid, int G, int wave) {
    const int lane = pg8::lane_id_v();
    const int gw = bid * NWAVES + wave, NGW = G * NWAVES;
    const float* rss = (const float*)(a.ws + WS_RSS);
    f32x4 fg[4];
#pragma unroll
    for (int j = 0; j < 4; ++j) fg[j] = *(const f32x4*)(a.final_g + 4 * lane + 256 * j);
    for (int r = gw; r < MTOT; r += NGW) {
        float s = rss[(size_t)r * 16 + (lane & 15)];
        s += __shfl_xor(s, 1); s += __shfl_xor(s, 2); s += __shfl_xor(s, 4); s += __shfl_xor(s, 8);
        const float rs = rsqrtf(s * (1.0f / D) + EPS);
        float* xr = a.out + (size_t)r * D;
#pragma unroll
        for (int j = 0; j < 4; ++j) { f32x4 v = *(const f32x4*)(xr + 4 * lane + 256 * j); v = v * rs * fg[j]; *(f32x4*)(xr + 4 * lane + 256 * j) = v; }
    }
}

__device__ __forceinline__ bool seq_start(int t) { return t < MP ? (t & 4095) == 0 : (t & 16383) == 0; }
__device__ __forceinline__ void unpack8(const u32x4 w, float (&f)[8]) {
#pragma unroll
    for (int j = 0; j < 4; ++j) { f[2 * j] = bf_lo(w[j]); f[2 * j + 1] = bf_hi(w[j]); }
}
constexpr int VT_LD = 136;
__device__ __forceinline__ void phase_mixer(const Args& a, LAS unsigned char* lds, int l, int bid, int G, int dostore, int wave) {
    const int lane = pg8::lane_id_v(), tid = wave * 64 + lane, fr = lane & 15, fq = lane >> 4;
    bf16_t* Z = (bf16_t*)(a.ws + WS_ZH);
    const float* vst = (const float*)(a.ws + WS_VST);
    const float* convw = a.conv_w + (size_t)l * 3 * 512;
    const float* sgn = a.sg_norm_g + (size_t)l * 512;
    const bf16_t* wsg = (const bf16_t*)(a.ws + WS_WSG) + (size_t)l * 8 * 128 * 128;
    const float* sgb = a.sg_bs + (size_t)l * 8 * 128;
    const float* gg = a.grp_g + (size_t)l * 1024;
    LAS f32x2* st = (LAS f32x2*)lds;
    LAS bf16_t* vT = (LAS bf16_t*)(lds + 1024);
    for (int ch = bid; ch < MTOT / 128; ch += G) {
        const int r0 = ch * 128;
        if (tid < 128) {
            const f32x4* p = (const f32x4*)(vst + (size_t)(r0 + tid) * 16); float s1 = 0.f, s2 = 0.f;
#pragma unroll
            for (int i = 0; i < 4; ++i) { const f32x4 v = p[i]; s1 += v[0] + v[2]; s2 += v[1] + v[3]; }
            const float mean = s1 * (1.0f / 512.0f); const float var = fmaxf(s2 * (1.0f / 512.0f) - mean * mean, 0.f);
            st[tid] = (f32x2){mean, rsqrtf(var + EPS)};
        }
        {
            const int t0 = r0 + 16 * wave, c0 = 8 * lane;
            float w0[8], w1[8], w2[8], g8[8];
#pragma unroll
            for (int j = 0; j < 8; ++j) { w0[j] = convw[c0 + j]; w1[j] = convw[512 + c0 + j]; w2[j] = convw[1024 + c0 + j]; g8[j] = gg[c0 + j]; }
            float prev[8], cur[8], nxt[8];
            { u32x4 w = (u32x4){0u, 0u, 0u, 0u}; if (!seq_start(t0)) w = *(const u32x4*)(Z + (size_t)(t0 - 1) * ZW + 1024 + c0); unpack8(w, prev); }
            { const u32x4 w = *(const u32x4*)(Z + (size_t)t0 * ZW + 1024 + c0); unpack8(w, cur); }
#pragma unroll 4
            for (int i = 0; i < 16; ++i) {
                const int t = t0 + i;
                { u32x4 w = (u32x4){0u, 0u, 0u, 0u}; if (!(t + 1 >= MTOT || seq_start(t + 1))) w = *(const u32x4*)(Z + (size_t)(t + 1) * ZW + 1024 + c0); unpack8(w, nxt); }
                float bg[8]; { const u32x4 w = *(const u32x4*)(Z + (size_t)t * ZW + c0); unpack8(w, bg); }
                float y[8]; float ss = 0.f;
#pragma unroll
                for (int j = 0; j < 8; ++j) { y[j] = bg[j] * (w0[j] * prev[j] + w1[j] * cur[j] + w2[j] * nxt[j]); ss += y[j] * y[j]; }
                ss = wave_sum(ss);
                const float rs = rsqrtf(ss * (1.0f / 512.0f) + EPS);
                u32x4 o;
                o.x = cvt_pk_bf16(y[0] * rs * g8[0], y[1] * rs * g8[1]); o.y = cvt_pk_bf16(y[2] * rs * g8[2], y[3] * rs * g8[3]);
                o.z = cvt_pk_bf16(y[4] * rs * g8[4], y[5] * rs * g8[5]); o.w = cvt_pk_bf16(y[6] * rs * g8[6], y[7] * rs * g8[7]);
                if (dostore) *(u32x4*)(Z + (size_t)t * ZW + c0) = o;
#pragma unroll
                for (int j = 0; j < 8; ++j) { prev[j] = cur[j]; cur[j] = nxt[j]; }
            }
        }
        __syncthreads();
        f32x4 acc[8][4];
        float ss = 0.f;
        const int prow = 16 * wave + fr;
#pragma unroll
        for (int h = 0; h < 8; ++h) {
            LAS bf16_t* vb = vT + (h & 1) * 64 * VT_LD;
#pragma unroll
            for (int i = 0; i < 2; ++i) {
                const int q = (tid >> 3) + 64 * i, dc = tid & 7;
                const u32x4 w = *(const u32x4*)(Z + (size_t)(r0 + q) * ZW + 1536 + h * 64 + dc * 8);
                float f[8]; unpack8(w, f);
                const f32x2 ms = st[q];
                const f32x4 ga = *(const f32x4*)(sgn + h * 64 + dc * 8), gb = *(const f32x4*)(sgn + h * 64 + dc * 8 + 4);
#pragma unroll
                for (int j = 0; j < 8; ++j) { const float gj = j < 4 ? ga[j] : gb[j - 4]; const float vn = (f[j] - ms.x) * ms.y * gj; vb[(dc * 8 + j) * VT_LD + q] = (bf16_t)f2bf(vn); }
            }
            bf16x8 wf[4];
#pragma unroll
            for (int ks = 0; ks < 4; ++ks) wf[ks] = *(const bf16x8*)(wsg + ((size_t)(h * 128 + prow)) * 128 + fq * 8 + 32 * ks);
            __syncthreads();
#pragma unroll
            for (int nd = 0; nd < 4; ++nd) {
                f32x4 c = (f32x4){0.f, 0.f, 0.f, 0.f};
#pragma unroll
                for (int ks = 0; ks < 4; ++ks) {
                    const bf16x8 vf = *(const LAS bf16x8*)(vb + (16 * nd + fr) * VT_LD + fq * 8 + 32 * ks);
                    c = __builtin_amdgcn_mfma_f32_16x16x32_bf16(vf, wf[ks], c, 0, 0, 0);
                }
                const float bias = sgb[h * 128 + prow];
                const u32x2 uw = *(const u32x2*)(Z + (size_t)(r0 + prow) * ZW + 512 + h * 64 + 16 * nd + 4 * fq);
                f32x4 y; y[0] = bf_lo(uw.x) * (c[0] + bias); y[1] = bf_hi(uw.x) * (c[1] + bias); y[2] = bf_lo(uw.y) * (c[2] + bias); y[3] = bf_hi(uw.y) * (c[3] + bias);
                ss += (y[0] * y[0] + y[1] * y[1]) + (y[2] * y[2] + y[3] * y[3]);
                acc[h][nd] = y;
            }
        }
        ss += __shfl_xor(ss, 16); ss += __shfl_xor(ss, 32);
        const float rs = rsqrtf(ss * (1.0f / 512.0f) + EPS);
#pragma unroll
        for (int h = 0; h < 8; ++h)
#pragma unroll
            for (int nd = 0; nd < 4; ++nd) {
                const int c = h * 64 + 16 * nd + 4 * fq;
                const f32x4 g = *(const f32x4*)(gg + 512 + c);
                const f32x4 o = acc[h][nd] * rs * g;
                u32x2 w; w.x = cvt_pk_bf16(o[0], o[1]); w.y = cvt_pk_bf16(o[2], o[3]);
                if (dostore) *(u32x2*)(Z + (size_t)(r0 + prow) * ZW + 512 + c) = w;
            }
        __syncthreads();
    }
}


#define XB_TMO      128
#define XB_XCNT(j)  (256  + 64 * (j))
#define XB_XSUB(j)  (1280 + 64 * (j))
#define XB_XGEN(j)  (2304 + 64 * (j))
#define XB_TOP      3328
#define XB_TOPGEN   3392
#define XCD_BAR_WORDS 3456
#define XB_SPIN_CAP (1u << 20)
__device__ __forceinline__ unsigned xb_ld(unsigned* p)              { return __hip_atomic_load(p, __ATOMIC_RELAXED, __HIP_MEMORY_SCOPE_AGENT); }
__device__ __forceinline__ unsigned xb_add(unsigned* p, unsigned v) { return __hip_atomic_fetch_add(p, v, __ATOMIC_RELAXED, __HIP_MEMORY_SCOPE_AGENT); }
__device__ __forceinline__ unsigned xb_xcc_id() { return (unsigned)__builtin_amdgcn_s_getreg((3 << 11) | 20) & 0xFu; }
#define XB_SPIN(cond, bar) do { unsigned _sp = 0; while (cond) { __builtin_amdgcn_s_sleep(1); \
    if ((++_sp & 255u) == 0u) { if (xb_ld(&(bar)[XB_TMO])) break; if (_sp > XB_SPIN_CAP) { atomicAdd(&(bar)[XB_TMO], 1u); break; } } } } while (0)
struct XcdBarrier { unsigned* bar; unsigned x; volatile LAS unsigned* st; };
__device__ __forceinline__ XcdBarrier xcd_barrier_post(unsigned* bar, volatile LAS unsigned* st, int wave) {
    XcdBarrier b; b.bar = bar; b.x = xb_xcc_id(); b.st = st;
    if (wave == 0 && pg8::lane_id_v() == 0) (void)xb_add(&bar[XB_XCNT(b.x)], 1u);
    return b;
}
__device__ __forceinline__ void xcd_barrier_complete(unsigned* bar, unsigned x, unsigned& nloc, unsigned& nx) {
    const unsigned G = gridDim.x * gridDim.y * gridDim.z;
    unsigned sum, cnt, mine, sp = 0u;
    for (;;) {
        sum = 0u; cnt = 0u; mine = 0u;
#pragma unroll
        for (unsigned j = 0; j < 16; ++j) { const unsigned c = xb_ld(&bar[XB_XCNT(j)]); sum += c; cnt += (c > 0u) ? 1u : 0u; mine = (j == x) ? c : mine; }
        if (sum == G) break;
        __builtin_amdgcn_s_sleep(1);
        if ((++sp & 255u) == 0u) { if (xb_ld(&bar[XB_TMO])) break; if (sp > XB_SPIN_CAP) { atomicAdd(&bar[XB_TMO], 1u); break; } }
    }
    nloc = mine > 0u ? mine : 1u; nx = cnt > 0u ? cnt : 1u;
}
__device__ __forceinline__ void xcd_barrier(const XcdBarrier& b, int wave) {
    asm volatile("s_waitcnt vmcnt(0)" ::: "memory");
    __syncthreads();
    if (wave == 0 && pg8::lane_id_v() == 0) {
        unsigned* bar = b.bar;
        __builtin_amdgcn_s_waitcnt(0);
        unsigned nloc = b.st[0], nx = b.st[1];
        if (nloc == 0u) { xcd_barrier_complete(bar, b.x, nloc, nx); b.st[0] = nloc; b.st[1] = nx; }
        const unsigned old = xb_add(&bar[XB_XSUB(b.x)], 1u);
        const unsigned gen = old / nloc;
        if (old + 1u == (gen + 1u) * nloc) {
            __builtin_amdgcn_fence(__ATOMIC_RELEASE, "agent");
            asm volatile("s_waitcnt vmcnt(0)" ::: "memory");
            const unsigned og = xb_add(&bar[XB_TOP], 1u);
            const unsigned tg = og / nx;
            if (og + 1u == (tg + 1u) * nx) xb_add(&bar[XB_TOPGEN], 1u);
            else XB_SPIN(xb_ld(&bar[XB_TOPGEN]) == tg, bar);
            __builtin_amdgcn_fence(__ATOMIC_ACQUIRE, "agent");
            xb_add(&bar[XB_XGEN(b.x)], 1u);
            asm volatile("s_waitcnt vmcnt(0)" ::: "memory");
        } else {
            XB_SPIN(xb_ld(&bar[XB_XGEN(b.x)]) == gen, bar);
            __builtin_amdgcn_fence(__ATOMIC_ACQUIRE, "agent");
            asm volatile("s_waitcnt vmcnt(0)" ::: "memory");
        }
    }
    __syncthreads();
}

__global__ void __launch_bounds__(NTHREADS, 2) fwd_megakernel(Args a) {
    extern __shared__ __attribute__((aligned(16))) unsigned char lds_raw[];
    LAS unsigned char* lds = (LAS unsigned char*)lds_raw;
    const int G = gridDim.x, bid = blockIdx.x;
    unsigned char* ws = a.ws;
    volatile LAS unsigned* bst = (volatile LAS unsigned*)(lds + 131072 + 512);
    if (threadIdx.x < 2) bst[threadIdx.x] = 0u;
    __syncthreads();
    XcdBarrier xbar; xbar.bar = (unsigned*)ws; xbar.x = 0; xbar.st = bst;
    const int wave = __builtin_amdgcn_readfirstlane(threadIdx.x >> 6);
    if (a.ph_hi - a.ph_lo > 1) xbar = xcd_barrier_post((unsigned*)ws, bst, wave);
    int ph0 = a.ph_lo;
    if (ph0 == 0 && a.ph_hi > 1) { phase_p0a(a, lds, bid, G, wave); cg::this_grid().sync(); ph0 = 1; }
#define GRID_SYNC(first) do { xcd_barrier(xbar, wave); } while (0)
    for (int ph = ph0; ph < a.ph_hi; ++ph) {
        int nrep = 1;
#if MK_PROBE == 1
        if (ph <= 1) nrep = 2;
#elif MK_PROBE == 2
        if (ph >= 2 && ph < NPHASES - 1) { const int s_ = (ph - 2) % 11; if (s_ == 0 || s_ == 2 || s_ == 7 || s_ == 9) nrep = 2; }
#elif MK_PROBE == 5
        if (ph >= 2 && ph < NPHASES - 1) { const int s_ = (ph - 2) % 11; if (s_ == 5) nrep = 2; }
#elif MK_PROBE == 6
        if (ph >= 2 && ph < NPHASES - 1) { const int s_ = (ph - 2) % 11; if (s_ == 1 || s_ == 3 || s_ == 6 || s_ == 8 || s_ == 10) nrep = 2; }
#elif MK_PROBE == 4
        if (ph >= 2 && ph < NPHASES - 1) { const int s_ = (ph - 2) % 11; if (s_ == 4) nrep = 2; }
#endif
        asm volatile("" : "+s"(nrep));
        for (int rep = 0; rep < nrep; ++rep) {
        int dostore = (rep + 1 == nrep) ? 1 : 0; dostore = __builtin_amdgcn_readfirstlane(dostore);
        if (ph == 0) phase_p0a(a, lds, bid, G, wave);
        else if (ph == 1) phase_p0b(a, lds, bid, G, wave);
        else if (ph == NPHASES - 1) phase_final(a, bid, G, wave);
        else {
            const int q = ph - 2, l = q / 11, s = q % 11;
            const float* mod_l = (const float*)(ws + WS_MOD) + (size_t)l * NBATCH * NMOD;
            const float* gmt = (const float*)(ws + WS_GM);
            const float* svl = (const float*)(ws + WS_SV) + (size_t)l * SV_LAYER;
            float* rss = (float*)(ws + WS_RSS);
            bf16_t* xg = (bf16_t*)(ws + WS_XG);
            bf16_t* zh = (bf16_t*)(ws + WS_ZH);
            if (s == 5) phase_mixer(a, lds, l, bid, G, dostore, wave);
            else if (s == 4) {
                pg8::Gemm g{xg, (const bf16_t*)(ws + WS_WINT) + (size_t)l * DIN * D, MTOT, DIN, D, D};
                pg8::StaticOrder S; S.init(MTOT, DIN, G, bid);
                EpiMixIn E{zh, rss, svl + NBATCH * NUP, (float*)(ws + WS_VST)};
                pg8::gemm_phase<EpiMixIn, pg8::StaticOrder, true, true>(lds, g, S, E, wave);
            } else if (s == 6) {
                pg8::Gemm g{zh, (const bf16_t*)(ws + WS_WOUTT) + (size_t)l * D * D, MTOT, D, D, ZW};
                pg8::StaticOrder S; S.init(MTOT, D, G, bid);
                EpiRes E{a.xp, a.xs, 0, a.out, xg, rss, mod_l + 5 * D, gmt + (size_t)(l * 3 + 2) * NBATCH * D, 1.0f, 0, dostore};
                pg8::gemm_phase<EpiRes, pg8::StaticOrder, true, true>(lds, g, S, E, wave);
            } else {
                const int f = s >= 7 ? 1 : 0, s2 = f ? s - 7 : s, half = s2 >> 1, rowbase = half * MP;
                if ((s2 & 1) == 0) {
                    pg8::Gemm g{xg + (size_t)rowbase * D, (const bf16_t*)(ws + WS_W1T) + (size_t)(l * 2 + f) * NUP * D, MP, NUP, D, D};
                    pg8::StaticOrder S; S.init(MP, NUP, G, bid);
                    EpiUp E{zh, rss, svl + (f ? NBATCH * (NUP + DIN) : 0), rowbase};
                    pg8::gemm_phase<EpiUp, pg8::StaticOrder, true, true>(lds, g, S, E, wave);
                } else {
                    pg8::Gemm g{zh, (const bf16_t*)(ws + WS_W2T) + (size_t)(l * 2 + f) * D * FF, MP, D, FF, FF};
                    pg8::StaticOrder S; S.init(MP, D, G, bid);
                    const float* gmn = f == 0 ? gmt + (size_t)(l * 3 + 1) * NBATCH * D : (l == 0 ? gmt + (size_t)3 * NBATCH * D : nullptr);
                    EpiRes E{a.xp, a.xs, (l == 0 && f == 0) ? 1 : 0, a.out, xg, rss, mod_l + (f ? 8 : 2) * D, gmn, 0.5f, rowbase, dostore};
                    pg8::gemm_phase<EpiRes, pg8::StaticOrder, true, true>(lds, g, S, E, wave);
                }
            }
        }
        if (rep + 1 < nrep) GRID_SYNC(0);
        }
        if (ph + 1 < a.ph_hi) GRID_SYNC(ph == a.ph_lo);
#if MK_PROBE == 3
        if (ph + 1 < a.ph_hi) GRID_SYNC(0);
#endif
    }
}

extern "C" void kernel_launch(void* const* d_in, const int* in_sizes, int n_in, void* d_out, int out_size, void* d_ws, size_t ws_size, hipStream_t stream) {
    static int grid = 0;
    if (grid == 0) {
        if (n_in != 17 || out_size != MTOT * D || ws_size < WS_END) { fprintf(stderr, "kernel_launch: unexpected shapes (n_in %d out %d ws %zu)\n", n_in, out_size, ws_size); grid = -1; return; }
        int dev = 0, cus = 0, per_cu = 0;
        hipGetDevice(&dev);
        hipDeviceGetAttribute(&cus, hipDeviceAttributeMultiprocessorCount, dev);
        if (hipFuncSetAttribute((const void*)fwd_megakernel, hipFuncAttributeMaxDynamicSharedMemorySize, LDS_BYTES) != hipSuccess) { fprintf(stderr, "kernel_launch: hipFuncSetAttribute failed\n"); grid = -1; return; }
        if (hipOccupancyMaxActiveBlocksPerMultiprocessor(&per_cu, (const void*)fwd_megakernel, NTHREADS, LDS_BYTES) != hipSuccess || per_cu < 1) { fprintf(stderr, "kernel_launch: occupancy query says %d\n", per_cu); per_cu = 1; }
        (void)hipGetLastError();
        grid = cus * per_cu;
        fprintf(stderr, "kernel_launch: grid %d (cus %d x %d)\n", grid, cus, per_cu);
    }
    if (grid < 0) return;
    Args a{};
    a.xp = (const float*)d_in[0]; a.xs = (const float*)d_in[1]; a.cp = (const float*)d_in[2]; a.cs = (const float*)d_in[3];
    a.ada_w = (const float*)d_in[4]; a.ada_b = (const float*)d_in[5]; a.norm_g = (const float*)d_in[6]; a.ffn_w1 = (const float*)d_in[7];
    a.ffn_w2 = (const float*)d_in[8]; a.mix_w_in = (const float*)d_in[9]; a.conv_w = (const float*)d_in[10]; a.sg_norm_g = (const float*)d_in[11];
    a.sg_ws = (const float*)d_in[12]; a.sg_bs = (const float*)d_in[13]; a.grp_g = (const float*)d_in[14]; a.mix_w_out = (const float*)d_in[15];
    a.final_g = (const float*)d_in[16];
    a.out = (float*)d_out; a.ws = (unsigned char*)d_ws;
#if MK_ONE_LAUNCH
    a.ph_lo = 0; a.ph_hi = NPHASES;
    if (hipMemsetAsync(d_ws, 0, XCD_BAR_WORDS * 4, stream) != hipSuccess) { fprintf(stderr, "kernel_launch: memset failed\n"); return; }
    void* args[] = {&a};
    hipError_t e = hipLaunchCooperativeKernel((const void*)fwd_megakernel, dim3(grid), dim3(NTHREADS), args, LDS_BYTES, stream);
    if (e != hipSuccess) fprintf(stderr, "cooperative launch failed: %s (grid %d)\n", hipGetErrorString(e), grid);
#else
    for (int ph = 0; ph < NPHASES; ++ph) {
        a.ph_lo = ph; a.ph_hi = ph + 1;
        hipLaunchKernelGGL(fwd_megakernel, dim3(grid), dim3(NTHREADS), LDS_BYTES, stream, a);
    }
#endif
}
```

```cpp
#include <hip/hip_runtime.h>
#include <hip/hip_cooperative_groups.h>
#include <cstdio>
#include <cstdint>
namespace cg = cooperative_groups;

#ifndef MK_PROBE
#define MK_PROBE 0
#endif
#ifndef MK_ONE_LAUNCH
#define MK_ONE_LAUNCH 1
#endif

constexpr int D = 1024, FF = 2816, NUP = 2 * FF, DIN = 2560, ZW = 2048;
constexpr int MTOT = 65536, MP = 32768;
constexpr int NBATCH = 10, NMOD = 9 * D;
constexpr float EPS = 1e-6f;
constexpr int NWAVES = 8, NTHREADS = 512;
constexpr int NPHASES = 25;

constexpr size_t MiB = 1u << 20;
constexpr size_t WS_MOD = 1 * MiB;
constexpr size_t WS_GM = 2 * MiB;
constexpr size_t WS_SV = 3 * MiB;
constexpr size_t WS_RSS = 5 * MiB;
constexpr size_t WS_VST = 9 * MiB;
constexpr size_t WS_WSG = 13 * MiB;
constexpr size_t WS_W1T = 14 * MiB;
constexpr size_t WS_W2T = 58 * MiB;
constexpr size_t WS_WINT = 80 * MiB;
constexpr size_t WS_WOUTT = 90 * MiB;
constexpr size_t WS_XG = 94 * MiB;
constexpr size_t WS_ZH = 222 * MiB;
constexpr size_t WS_END = 478 * MiB;
constexpr int SV_LAYER = NBATCH * (NUP + DIN + NUP);

constexpr int LDS_BYTES = 147456;

namespace pg8 {
#define PG8_LAS __attribute__((address_space(3)))
typedef unsigned short bf16_t;
typedef short bf16x8 __attribute__((ext_vector_type(8)));
typedef float f32x4 __attribute__((ext_vector_type(4)));
typedef float f32x2 __attribute__((ext_vector_type(2)));
typedef unsigned u32x4 __attribute__((ext_vector_type(4)));
typedef unsigned u32x2 __attribute__((ext_vector_type(2)));
constexpr int BM = 256, BK = 64, HALF = 128, HTB = HALF * BK * 2, STAGE_BYTES = 8 * HTB, NXCD = 8, WGM = 8;

__host__ __device__ __forceinline__ int lds_byte(int r, int c) { const int st = (r >> 4) * 2 + (c >> 5), rr = r & 15, cc = c & 31, ob = rr * 64 + cc * 2; return st * 1024 + (ob ^ (((ob >> 9) & 1) << 5)); }
__host__ __device__ __forceinline__ void stage_rc(int b, int& R, int& C) { const int st = b / 1024, sb = b % 1024, swz = sb ^ (((sb >> 9) & 1) << 5); R = (st >> 1) * 16 + swz / 64; C = (st & 1) * 32 + (swz % 64) / 2; }
__host__ __device__ __forceinline__ int perm32(int rho) { const int n = rho >> 4, i = rho & 15; return 8 * (i >> 2) + 4 * n + (i & 3); }

struct Unit { int pm, pn; };
struct Gemm { const bf16_t* A; const bf16_t* Bt; int M, N, K, lda; };

struct StaticOrder {
    int nM, nN, nwg, G, c;
    __host__ __device__ void init(int M, int N, int G_, int c_) { nM = M / BM; nN = N / BM; nwg = nM * nN; G = G_; c = c_; }
    __host__ __device__ bool next(int i, Unit& u) const {
        const long L = (long)i * G + c; if (L >= nwg) return false;
        int wgid = (int)L; { const int q = nwg / NXCD, r = nwg % NXCD, xcd = wgid % NXCD, off = wgid / NXCD; wgid = (xcd < r ? xcd * (q + 1) : r * (q + 1) + (xcd - r) * q) + off; }
        const int nig = WGM * nN, gid = wgid / nig, fm = gid * WGM, gsz = (nM - fm) < WGM ? (nM - fm) : WGM;
        u.pm = fm + ((wgid % nig) % gsz); u.pn = (wgid % nig) / gsz; return true;
    }
};

__device__ __forceinline__ unsigned cvt_pk_bf16(float lo, float hi) { unsigned r; asm volatile("v_cvt_pk_bf16_f32 %0, %1, %2" : "=v"(r) : "v"(lo), "v"(hi)); return r; }
__device__ __forceinline__ f32x2 gelu_pk(f32x2 v) {
    const f32x2 av = __builtin_elementwise_abs(v), d = av * 0.2316418882f + 1.0f;
    f32x2 t; t.x = __builtin_amdgcn_rcpf(d.x); t.y = __builtin_amdgcn_rcpf(d.y);
    f32x2 q = t * 0.5307027145f + (-0.7265760135f); q = q * t + 0.7107068705f; q = q * t + (-0.142248368f); q = q * t + 0.127414796f; q = q * t;
    const f32x2 s = (v * v) * (-0.72134752044f);
    f32x2 e; e.x = __builtin_amdgcn_exp2f(s.x); e.y = __builtin_amdgcn_exp2f(s.y);
    const f32x2 m = v * (q * e), r = v - m;
    f32x2 o; o.x = v.x < 0.f ? m.x : r.x; o.y = v.y < 0.f ? m.y : r.y; return o;
}
__device__ __forceinline__ f32x4 gelu4(f32x4 v) { const f32x2 a = gelu_pk((f32x2){v[0], v[1]}), b = gelu_pk((f32x2){v[2], v[3]}); return (f32x4){a.x, a.y, b.x, b.y}; }
__device__ __forceinline__ float silu1(float g) { return g * __builtin_amdgcn_rcpf(1.0f + __builtin_amdgcn_exp2f(-1.4426950409f * g)); }
__device__ __forceinline__ f32x2 silu_mul_pk(f32x2 g, f32x2 u) {
    const f32x2 t = g * (-1.4426950409f);
    f32x2 e; e.x = __builtin_amdgcn_exp2f(t.x); e.y = __builtin_amdgcn_exp2f(t.y);
    const f32x2 d = e + 1.0f;
    f32x2 r; r.x = __builtin_amdgcn_rcpf(d.x); r.y = __builtin_amdgcn_rcpf(d.y);
    return (g * u) * r;
}

__device__ __forceinline__ int lane_id_v() { int l; asm volatile("v_mbcnt_lo_u32_b32 %0, -1, 0\n\tv_mbcnt_hi_u32_b32 %0, -1, %0" : "=v"(l)); return l; }
template <class Epi, class Sched, bool ALIGN_EPI, bool SP2>
__device__ __forceinline__ void gemm_phase(PG8_LAS unsigned char* lds, const Gemm g, const Sched& S, const Epi& E, int wid) {
    const int lane = lane_id_v(), tid = wid * 64 + lane;
    const int wr = wid >> 2, wc = wid & 3, fr = lane & 15, fq = lane >> 4;
    const int K = g.K, nt = K / BK, lda = g.lda;
    unsigned voffA[2], voffB[2];
#pragma unroll
    for (int i = 0; i < 2; ++i) { int R, C; stage_rc(tid * 16 + i * 8192, R, C); const int Rb = Epi::PERM ? ((R & ~31) + perm32(R & 31)) : R;
        voffA[i] = (unsigned)(R * lda + C) * 2u; voffB[i] = (unsigned)(Rb * K + C) * 2u; }
    const size_t kstep = (size_t)(BK * 2);
    const size_t hstepA = (size_t)HALF * lda * 2, hstepB = (size_t)HALF * K * 2;
    const size_t tstepA = 2 * hstepA, tstepB = 2 * hstepB;
    const unsigned ldsw = (unsigned)wid * 1024u;
    const int aoff = lds_byte(wr * 64 + fr, fq * 8), boff = lds_byte(wc * 32 + fr, fq * 8);
#define PG8_SA(b, h) (((b) * 2 + (h)) * HTB)
#define PG8_SB(b, h) ((4 + (b) * 2 + (h)) * HTB)
#define PG8_STAGE(bufoff, gbase, voff) do { _Pragma("unroll") for (int _i = 0; _i < 2; ++_i) \
        __builtin_amdgcn_global_load_lds((const unsigned*)((const char*)(gbase) + (voff)[_i]), (PG8_LAS unsigned*)(lds + (bufoff) + ldsw + _i * 8192), 16, 0, 0); } while (0)
#define PG8_LDA(dst, b, h) do { _Pragma("unroll") for (int m = 0; m < 4; ++m) _Pragma("unroll") for (int k = 0; k < 2; ++k) dst[m][k] = *(const PG8_LAS bf16x8*)(lds + PG8_SA(b, h) + aoff + m * 2048 + k * 1024); } while (0)
#define PG8_LDB(dst, b, h) do { _Pragma("unroll") for (int n = 0; n < 2; ++n) _Pragma("unroll") for (int k = 0; k < 2; ++k) dst[n][k] = *(const PG8_LAS bf16x8*)(lds + PG8_SB(b, h) + boff + n * 2048 + k * 1024); } while (0)
#define PG8_MMA(ai, bj, At, Bt) do { __builtin_amdgcn_s_setprio(1); _Pragma("unroll") for (int m = 0; m < 4; ++m) _Pragma("unroll") for (int n = 0; n < 2; ++n) _Pragma("unroll") for (int k = 0; k < 2; ++k) \
        acc[ai][bj][m][n] = __builtin_amdgcn_mfma_f32_16x16x32_bf16(Bt[n][k], At[m][k], acc[ai][bj][m][n], 0, 0, 0); __builtin_amdgcn_s_setprio(0); } while (0)
#define PG8_WAIT_V(n) asm volatile("s_waitcnt vmcnt(" #n ")" ::: "memory")
#define PG8_WAIT_L(n) asm volatile("s_waitcnt lgkmcnt(" #n ")" ::: "memory")
#define PG8_BAR __builtin_amdgcn_s_barrier()
#define PG8_SCHED __builtin_amdgcn_sched_barrier(0)
    Unit cur, nxt; int ui = 0;
    if (!S.next(0, cur)) return;
    f32x4 acc[2][2][4][2];
#pragma unroll
    for (int a = 0; a < 2; ++a)
#pragma unroll
        for (int b = 0; b < 2; ++b)
#pragma unroll
            for (int m = 0; m < 4; ++m)
#pragma unroll
                for (int n = 0; n < 2; ++n) acc[a][b][m][n] = (f32x4){0.f, 0.f, 0.f, 0.f};
    bf16x8 At[4][2], B0[2][2], B1[2][2];
    const char* cA = (const char*)g.A + (size_t)cur.pm * tstepA; const char* cB = (const char*)g.Bt + (size_t)cur.pn * tstepB;
    if constexpr (SP2) {
        PG8_STAGE(PG8_SB(0, 0), cB, voffB); PG8_STAGE(PG8_SB(0, 1), cB + hstepB, voffB); PG8_STAGE(PG8_SA(0, 0), cA, voffA); PG8_STAGE(PG8_SA(0, 1), cA + hstepA, voffA);
        if (wr == 1) PG8_BAR;
        PG8_WAIT_V(2); PG8_BAR;
        PG8_STAGE(PG8_SB(1, 0), cB + kstep, voffB); PG8_STAGE(PG8_SA(1, 0), cA + kstep, voffA); PG8_STAGE(PG8_SB(1, 1), cB + hstepB + kstep, voffB);
        PG8_WAIT_V(6); PG8_BAR;
    } else {
        PG8_STAGE(PG8_SB(0, 0), cB, voffB); PG8_STAGE(PG8_SA(0, 0), cA, voffA); PG8_STAGE(PG8_SB(0, 1), cB + hstepB, voffB); PG8_STAGE(PG8_SA(0, 1), cA + hstepA, voffA);
        if (wr == 1) PG8_BAR;
        PG8_WAIT_V(4); PG8_BAR;
        PG8_STAGE(PG8_SB(1, 0), cB + kstep, voffB); PG8_STAGE(PG8_SA(1, 0), cA + kstep, voffA); PG8_STAGE(PG8_SB(1, 1), cB + hstepB + kstep, voffB);
        PG8_WAIT_V(6); PG8_BAR;
    }
    for (;;) {
        const bool has_next = S.next(ui + 1, nxt);
        const char* nA = has_next ? (const char*)g.A + (size_t)nxt.pm * tstepA : cA; const char* nB = has_next ? (const char*)g.Bt + (size_t)nxt.pn * tstepB : cB;
        for (int t = 0; t < nt; t += 2) {
            const bool last = (t == nt - 2);
            const char* a1 = cA + (size_t)(t + 1) * kstep;
            const char* a2 = last ? nA : cA + (size_t)(t + 2) * kstep; const char* b2 = last ? nB : cB + (size_t)(t + 2) * kstep;
            const char* a3 = a2 + kstep; const char* b3 = b2 + kstep;
            if constexpr (SP2) {
            PG8_LDB(B0, 0, 0); PG8_LDB(B1, 0, 1); PG8_SCHED; PG8_LDA(At, 0, 0); PG8_STAGE(PG8_SA(1, 1), a1 + hstepA, voffA);
            PG8_WAIT_V(8); PG8_WAIT_L(0); PG8_BAR; PG8_MMA(0, 0, At, B0); PG8_MMA(0, 1, At, B1); PG8_BAR; PG8_SCHED;
            PG8_LDA(At, 0, 1); PG8_STAGE(PG8_SB(0, 0), b2, voffB); PG8_STAGE(PG8_SB(0, 1), b2 + hstepB, voffB); PG8_STAGE(PG8_SA(0, 0), a2, voffA);
            PG8_WAIT_V(8); PG8_WAIT_L(0); PG8_BAR; PG8_MMA(1, 0, At, B0); PG8_MMA(1, 1, At, B1); PG8_BAR; PG8_SCHED;
            PG8_LDB(B0, 1, 0); PG8_LDB(B1, 1, 1); PG8_SCHED; PG8_LDA(At, 1, 0); PG8_STAGE(PG8_SA(0, 1), a2 + hstepA, voffA);
            PG8_WAIT_V(8); PG8_WAIT_L(0); PG8_BAR; PG8_MMA(0, 0, At, B0); PG8_MMA(0, 1, At, B1); PG8_BAR; PG8_SCHED;
            PG8_LDA(At, 1, 1); PG8_STAGE(PG8_SB(1, 0), b3, voffB); PG8_STAGE(PG8_SB(1, 1), b3 + hstepB, voffB); PG8_STAGE(PG8_SA(1, 0), a3, voffA);
            PG8_WAIT_V(8); PG8_WAIT_L(0); PG8_BAR; PG8_MMA(1, 0, At, B0); PG8_MMA(1, 1, At, B1); PG8_BAR; PG8_SCHED;
            } else {
            PG8_LDB(B0, 0, 0); PG8_SCHED; PG8_LDA(At, 0, 0); PG8_STAGE(PG8_SA(1, 1), a1 + hstepA, voffA);
            PG8_WAIT_L(8); PG8_BAR; PG8_WAIT_L(0); PG8_MMA(0, 0, At, B0); PG8_BAR; PG8_SCHED;
            PG8_LDB(B1, 0, 1); PG8_STAGE(PG8_SB(0, 0), b2, voffB);
            PG8_BAR; PG8_WAIT_L(0); PG8_MMA(0, 1, At, B1); PG8_BAR;
            PG8_LDA(At, 0, 1); PG8_STAGE(PG8_SA(0, 0), a2, voffA);
            PG8_BAR; PG8_WAIT_L(0); PG8_MMA(1, 0, At, B0); PG8_BAR; PG8_SCHED;
            PG8_STAGE(PG8_SB(0, 1), b2 + hstepB, voffB);
            PG8_WAIT_V(6); PG8_BAR; PG8_MMA(1, 1, At, B1); PG8_BAR;
            PG8_LDB(B0, 1, 0); PG8_SCHED; PG8_LDA(At, 1, 0); PG8_STAGE(PG8_SA(0, 1), a2 + hstepA, voffA);
            PG8_WAIT_L(8); PG8_BAR; PG8_WAIT_L(0); PG8_MMA(0, 0, At, B0); PG8_BAR; PG8_SCHED;
            PG8_LDB(B1, 1, 1); PG8_STAGE(PG8_SB(1, 0), b3, voffB);
            PG8_BAR; PG8_WAIT_L(0); PG8_MMA(0, 1, At, B1); PG8_BAR;
            PG8_LDA(At, 1, 1); PG8_STAGE(PG8_SA(1, 0), a3, voffA);
            PG8_BAR; PG8_WAIT_L(0); PG8_MMA(1, 0, At, B0); PG8_BAR; PG8_SCHED;
            PG8_STAGE(PG8_SB(1, 1), b3 + hstepB, voffB);
            PG8_WAIT_V(6); PG8_BAR; PG8_MMA(1, 1, At, B1); PG8_BAR;
            }
        }
        if constexpr (ALIGN_EPI) { if (wr == 0) PG8_BAR; }
        E(acc, cur, wr, wc, fr, fq);
        if (!has_next) break;
#pragma unroll
        for (int a = 0; a < 2; ++a)
#pragma unroll
            for (int b = 0; b < 2; ++b)
#pragma unroll
                for (int m = 0; m < 4; ++m)
#pragma unroll
                    for (int n = 0; n < 2; ++n) acc[a][b][m][n] = (f32x4){0.f, 0.f, 0.f, 0.f};
        cur = nxt; cA = nA; cB = nB; ++ui;
        if constexpr (ALIGN_EPI) { if (wr == 1) PG8_BAR; }
    }
    PG8_WAIT_V(0);
    if constexpr (!ALIGN_EPI) { if (wr == 0) PG8_BAR; }
    PG8_BAR;
#undef PG8_SA
#undef PG8_SB
#undef PG8_STAGE
#undef PG8_LDA
#undef PG8_LDB
#undef PG8_MMA
#undef PG8_WAIT_V
#undef PG8_WAIT_L
#undef PG8_BAR
#undef PG8_SCHED
}
}

using pg8::bf16_t; using pg8::f32x4; using pg8::f32x2; using pg8::u32x4; using pg8::u32x2; using pg8::bf16x8; using pg8::cvt_pk_bf16;
#define LAS __attribute__((address_space(3)))

__device__ __forceinline__ int batch_of(int r) { return r < MP ? (r >> 12) : 8 + ((r - MP) >> 14); }
__device__ __forceinline__ float wave_sum(float v) {
#pragma unroll
    for (int o = 1; o < 64; o <<= 1) v += __shfl_xor(v, o);
    return v;
}
__device__ __forceinline__ float bf_lo(unsigned w) { return __uint_as_float(w << 16); }
__device__ __forceinline__ float bf_hi(unsigned w) { return __uint_as_float(w & 0xffff0000u); }
__device__ __forceinline__ float row_rstd(const float* rss, int row, int fq) {
    const f32x4 p = *(const f32x4*)(rss + (size_t)row * 16 + 4 * fq);
    float s = (p[0] + p[1]) + (p[2] + p[3]);
    s += __shfl_xor(s, 16); s += __shfl_xor(s, 32);
    return rsqrtf(s * (1.0f / D) + EPS);
}

__device__ __forceinline__ void rows_rstd8(const float* rss, int row0, int fq, float (&rs)[8]) {
    f32x4 pr[8];
#pragma unroll
    for (int i = 0; i < 8; ++i) pr[i] = *(const f32x4*)(rss + (size_t)(row0 + (i >> 2) * 128 + (i & 3) * 16) * 16 + 4 * fq);
#pragma unroll
    for (int i = 0; i < 8; ++i) { float t = (pr[i][0] + pr[i][1]) + (pr[i][2] + pr[i][3]); t += __shfl_xor(t, 16); t += __shfl_xor(t, 32); rs[i] = rsqrtf(t * (1.0f / D) + EPS); }
}
struct EpiUp {
    static constexpr bool PERM = true;
    bf16_t* H; const float* rss; const float* S; int rowbase;
    __device__ __forceinline__ void operator()(const f32x4 (&acc)[2][2][4][2], const pg8::Unit& u, int wr, int wc, int fr_, int fq_) const {
        const int lane_ = pg8::lane_id_v(); const int fr = lane_ & 15, fq = lane_ >> 4;
        const int lrow0 = u.pm * 256 + wr * 64 + fr;
        const int b = batch_of(rowbase + u.pm * 256);
        const float* Sb = S + (size_t)b * NUP + u.pn * 256 + wc * 32 + 8 * fq;
        f32x4 sv[2][2];
#pragma unroll
        for (int bj = 0; bj < 2; ++bj)
#pragma unroll
            for (int n = 0; n < 2; ++n) sv[bj][n] = *(const f32x4*)(Sb + bj * 128 + 4 * n);
        float rs8[8]; rows_rstd8(rss, rowbase + lrow0, fq, rs8);
        const int hcol = u.pn * 128 + wc * 32 + 8 * fq;
#pragma unroll
        for (int ai = 0; ai < 2; ++ai)
#pragma unroll
            for (int m = 0; m < 4; ++m) {
                const int lr = lrow0 + ai * 128 + m * 16;
                const float rs = rs8[ai * 4 + m];
                const f32x4 g0 = acc[ai][0][m][0] * rs + sv[0][0], g1 = acc[ai][0][m][1] * rs + sv[0][1];
                const f32x4 u0 = acc[ai][1][m][0] * rs + sv[1][0], u1 = acc[ai][1][m][1] * rs + sv[1][1];
                const f32x2 ha = pg8::silu_mul_pk((f32x2){g0[0], g0[1]}, (f32x2){u0[0], u0[1]}), hb = pg8::silu_mul_pk((f32x2){g0[2], g0[3]}, (f32x2){u0[2], u0[3]});
                const f32x2 hc = pg8::silu_mul_pk((f32x2){g1[0], g1[1]}, (f32x2){u1[0], u1[1]}), hd = pg8::silu_mul_pk((f32x2){g1[2], g1[3]}, (f32x2){u1[2], u1[3]});
                u32x4 w; w.x = cvt_pk_bf16(ha.x, ha.y); w.y = cvt_pk_bf16(hb.x, hb.y); w.z = cvt_pk_bf16(hc.x, hc.y); w.w = cvt_pk_bf16(hd.x, hd.y);
                *(u32x4*)(H + (size_t)lr * FF + hcol) = w;
            }
    }
};

#ifndef RES_DEPTH
#define RES_DEPTH 3
#endif
struct EpiRes {
    static constexpr bool PERM = false;
    const float* xp; const float* xs; int first;
    float* out; bf16_t* xg; float* rss; const float* gate; const float* gm; float coef; int rowbase; int dostore;
    __device__ __forceinline__ void operator()(const f32x4 (&acc)[2][2][4][2], const pg8::Unit& u, int wr, int wc, int fr_, int fq_) const {
        const int lane_ = pg8::lane_id_v(); const int fr = lane_ & 15, fq = lane_ >> 4;
        const int grow0 = rowbase + u.pm * 256 + wr * 64 + fr;
        const int b = batch_of(rowbase + u.pm * 256);
        const int col0 = u.pn * 256 + wc * 32 + 4 * fq;
        const float* rp0 = (first ? (grow0 < MP ? xp + (size_t)grow0 * D : xs + (size_t)(grow0 - MP) * D) : out + (size_t)grow0 * D) + col0;
        f32x4 xi[RES_DEPTH][4];
#pragma unroll
        for (int r = 0; r < RES_DEPTH; ++r)
#pragma unroll
            for (int q = 0; q < 4; ++q) xi[r][q] = *(const f32x4*)(rp0 + (size_t)((r >> 2) * 128 + (r & 3) * 16) * D + (q >> 1) * 128 + (q & 1) * 16);
        const float* gp = gate + (size_t)b * NMOD + col0;
        f32x4 gv[2][2], mv[2][2];
#pragma unroll
        for (int bj = 0; bj < 2; ++bj)
#pragma unroll
            for (int n = 0; n < 2; ++n) { gv[bj][n] = *(const f32x4*)(gp + bj * 128 + n * 16) * coef;
                mv[bj][n] = gm ? *(const f32x4*)(gm + b * D + col0 + bj * 128 + n * 16) : (f32x4){0.f, 0.f, 0.f, 0.f}; }
#pragma unroll
        for (int r = 0; r < 8; ++r) {
            const int ai = r >> 2, m = r & 3;
            const int grow = grow0 + ai * 128 + m * 16;
            f32x4 xo[4];
#pragma unroll
            for (int q = 0; q < 4; ++q) xo[q] = xi[r % RES_DEPTH][q] + gv[q >> 1][q & 1] * acc[ai][q >> 1][m][q & 1];
            if (r + RES_DEPTH < 8) {
                const int r2 = r + RES_DEPTH;
#pragma unroll
                for (int q = 0; q < 4; ++q) xi[r % RES_DEPTH][q] = *(const f32x4*)(rp0 + (size_t)((r2 >> 2) * 128 + (r2 & 3) * 16) * D + (q >> 1) * 128 + (q & 1) * 16);
            }
            float ss = 0.f;
#pragma unroll
            for (int q = 0; q < 4; ++q) {
                const int c = col0 + (q >> 1) * 128 + (q & 1) * 16;
                if (dostore) *(f32x4*)(out + (size_t)grow * D + c) = xo[q];
                ss += (xo[q][0] * xo[q][0] + xo[q][1] * xo[q][1]) + (xo[q][2] * xo[q][2] + xo[q][3] * xo[q][3]);
                if (gm && dostore) { const f32x4 o = xo[q] * mv[q >> 1][q & 1]; u32x2 w; w.x = cvt_pk_bf16(o[0], o[1]); w.y = cvt_pk_bf16(o[2], o[3]); *(u32x2*)(xg + (size_t)grow * D + c) = w; }
            }
            ss += __shfl_xor(ss, 16); ss += __shfl_xor(ss, 32);
            if (fq == 0 && dostore) rss[(size_t)grow * 16 + u.pn * 4 + wc] = ss;
        }
    }
};

struct EpiMixIn {
    static constexpr bool PERM = true;
    bf16_t* Z; const float* rss; const float* S; float* vst;
    __device__ __forceinline__ void operator()(const f32x4 (&acc)[2][2][4][2], const pg8::Unit& u, int wr, int wc, int fr_, int fq_) const {
        const int lane_ = pg8::lane_id_v(); const int fr = lane_ & 15, fq = lane_ >> 4;
        const int row0 = u.pm * 256 + wr * 64 + fr;
        const int b = batch_of(u.pm * 256);
        const float* Sb = S + (size_t)b * DIN + u.pn * 256 + wc * 32 + 8 * fq;
        f32x4 sv[2][2];
#pragma unroll
        for (int bj = 0; bj < 2; ++bj)
#pragma unroll
            for (int n = 0; n < 2; ++n) sv[bj][n] = *(const f32x4*)(Sb + bj * 128 + 4 * n);
        float rs8[8]; rows_rstd8(rss, row0, fq, rs8);
        const int pn = u.pn;
        const int lc = wc * 32 + 8 * fq;
#pragma unroll
        for (int ai = 0; ai < 2; ++ai)
#pragma unroll
            for (int m = 0; m < 4; ++m) {
                const int row = row0 + ai * 128 + m * 16;
                const float rs = rs8[ai * 4 + m];
                f32x4 v00 = acc[ai][0][m][0] * rs + sv[0][0], v01 = acc[ai][0][m][1] * rs + sv[0][1];
                f32x4 v10 = acc[ai][1][m][0] * rs + sv[1][0], v11 = acc[ai][1][m][1] * rs + sv[1][1];
                bf16_t* zr = Z + (size_t)row * ZW;
                if (pn >= 2 && pn < 6) {
                    const f32x4 o0 = v00 * v10, o1 = v01 * v11;
                    u32x4 w; w.x = cvt_pk_bf16(o0[0], o0[1]); w.y = cvt_pk_bf16(o0[2], o0[3]); w.z = cvt_pk_bf16(o1[0], o1[1]); w.w = cvt_pk_bf16(o1[2], o1[3]);
                    *(u32x4*)(zr + 1024 + (pn - 2) * 128 + lc) = w;
                } else {
                    int cbase = pn * 256;
                    if (pn >= 6) {
                        v00 = pg8::gelu4(v00); v01 = pg8::gelu4(v01); v10 = pg8::gelu4(v10); v11 = pg8::gelu4(v11);
                        cbase = pn < 8 ? 512 + (pn - 6) * 256 : 1536 + (pn - 8) * 256;
                    }
                    u32x4 w0, w1;
                    w0.x = cvt_pk_bf16(v00[0], v00[1]); w0.y = cvt_pk_bf16(v00[2], v00[3]); w0.z = cvt_pk_bf16(v01[0], v01[1]); w0.w = cvt_pk_bf16(v01[2], v01[3]);
                    w1.x = cvt_pk_bf16(v10[0], v10[1]); w1.y = cvt_pk_bf16(v10[2], v10[3]); w1.z = cvt_pk_bf16(v11[0], v11[1]); w1.w = cvt_pk_bf16(v11[2], v11[3]);
                    *(u32x4*)(zr + cbase + lc) = w0;
                    *(u32x4*)(zr + cbase + 128 + lc) = w1;
                    if (pn >= 8) {
                        const f32x4 s4 = (v00 + v01) + (v10 + v11);
                        const f32x4 q4 = (v00 * v00 + v01 * v01) + (v10 * v10 + v11 * v11);
                        float s1 = (s4[0] + s4[1]) + (s4[2] + s4[3]), s2 = (q4[0] + q4[1]) + (q4[2] + q4[3]);
                        s1 += __shfl_xor(s1, 16); s1 += __shfl_xor(s1, 32); s2 += __shfl_xor(s2, 16); s2 += __shfl_xor(s2, 32);
                        if (fq == 0) *(f32x2*)(vst + (size_t)row * 16 + ((pn - 8) * 4 + wc) * 2) = (f32x2){s1, s2};
                    }
                }
            }
    }
};

struct Args {
    const float* xp; const float* xs; const float* cp; const float* cs; const float* ada_w; const float* ada_b; const float* norm_g;
    const float* ffn_w1; const float* ffn_w2; const float* mix_w_in; const float* conv_w; const float* sg_norm_g; const float* sg_ws;
    const float* sg_bs; const float* grp_g; const float* mix_w_out; const float* final_g;
    float* out; unsigned char* ws; int ph_lo, ph_hi;
};

__device__ __forceinline__ unsigned f2bf(float f) { unsigned u = __float_as_uint(f); return (u + 0x7fffu + ((u >> 16) & 1u)) >> 16; }
__device__ __forceinline__ unsigned pk2(float lo, float hi) { return f2bf(lo) | (f2bf(hi) << 16); }

__device__ __forceinline__ int map_col(int mode, int s) {
    if (mode == 1) { const int bj = s >= FF ? 1 : 0, h = s - bj * FF; return 256 * (h >> 7) + 128 * bj + (h & 127); }
    if (mode == 2) { if (s >= 512 && s < 1024) { const int q = s - 512; return 512 + 256 * (q >> 7) + (q & 127); }
                     if (s >= 1024 && s < 1536) { const int q = s - 1024; return 512 + 256 * (q >> 7) + 128 + (q & 127); } }
    return s;
}
__device__ __forceinline__ void transpose_item(const float* W, int K, int N, bf16_t* WT, int mode, LAS float* scr, int item, int lane) {
    const int nblk = N / 32, kb = item / nblk, nb = item % nblk, k0 = 64 * kb, n0 = 32 * nb, dn0 = map_col(mode, n0);
    float tv[32];
#pragma unroll
    for (int i = 0; i < 32; ++i) { const int kk = 2 * i + (lane >> 5); tv[i] = W[(size_t)(k0 + kk) * N + n0 + (lane & 31)]; }
#pragma unroll
    for (int i = 0; i < 32; ++i) { const int kk = 2 * i + (lane >> 5); scr[kk * 33 + (lane & 31)] = tv[i]; }
    asm volatile("s_waitcnt lgkmcnt(0)" ::: "memory");
    const int c = lane & 7;
#pragma unroll
    for (int j = 0; j < 4; ++j) { const int n = (lane >> 3) + 8 * j; const LAS float* s = scr + (8 * c) * 33 + n;
        u32x4 o; o.x = pk2(s[0 * 33], s[1 * 33]); o.y = pk2(s[2 * 33], s[3 * 33]); o.z = pk2(s[4 * 33], s[5 * 33]); o.w = pk2(s[6 * 33], s[7 * 33]);
        *(u32x4*)(WT + (size_t)(dn0 + n) * K + k0 + 8 * c) = o; }
    asm volatile("s_waitcnt lgkmcnt(0)" ::: "memory");
}

__device__ __forceinline__ void phase_p0a(const Args& a, LAS unsigned char* lds, int bid, int G, int wave) {
    const int lane = pg8::lane_id_v(), tid = wave * 64 + lane;
    LAS float* sc = (LAS float*)lds;
    LAS float* scr = (LAS float*)(lds + 49152 + wave * 10240);
    float* mod = (float*)(a.ws + WS_MOD);
    if (bid < 288) {
        for (int i = tid; i < NBATCH * D; i += NTHREADS) { const int b = i >> 10, k = i & 1023; const float c = b < 8 ? a.cp[b * D + k] : a.cs[(b - 8) * D + k]; sc[i] = c / (1.0f + __expf(-c)); }
        __syncthreads();
        for (int it = bid; it < 288; it += G) {
            const int l = it / 144, n0 = (it % 144) * 64;
            const float* W = a.ada_w + (size_t)l * D * NMOD + n0 + lane;
            float acc[NBATCH];
#pragma unroll
            for (int b = 0; b < NBATCH; ++b) acc[b] = 0.f;
#pragma unroll 16
            for (int kk = 0; kk < 128; ++kk) { const int k = wave * 128 + kk; const float w = W[(size_t)k * NMOD];
#pragma unroll
                for (int b = 0; b < NBATCH; ++b) acc[b] += sc[b * D + k] * w; }
#pragma unroll
            for (int b = 0; b < NBATCH; ++b) scr[b * 64 + lane] = acc[b];
            __syncthreads();
            for (int i = tid; i < NBATCH * 64; i += NTHREADS) { const int b = i >> 6, c = i & 63; float s = 0.f;
#pragma unroll
                for (int w = 0; w < NWAVES; ++w) s += ((LAS float*)(lds + 49152 + w * 10240))[b * 64 + c];
                mod[((size_t)l * NBATCH + b) * NMOD + n0 + c] = s + a.ada_b[(size_t)l * NMOD + n0 + c]; }
            __syncthreads();
        }
    }
    const int gw = bid * NWAVES + wave, NGW = G * NWAVES;
    constexpr int I_W1 = (D / 64) * (NUP / 32), I_W2 = (FF / 64) * (D / 32), I_WIN = (D / 64) * (DIN / 32), I_WOUT = (D / 64) * (D / 32);
    constexpr int NITEMS = 4 * I_W1 + 4 * I_W2 + 2 * I_WIN + 2 * I_WOUT;
    for (int it = gw; it < NITEMS; it += NGW) {
        int r = it;
        if (r < 4 * I_W1) { const int mi = r / I_W1; transpose_item(a.ffn_w1 + (size_t)mi * D * NUP, D, NUP, (bf16_t*)(a.ws + WS_W1T) + (size_t)mi * NUP * D, 1, scr, r % I_W1, lane); continue; } r -= 4 * I_W1;
        if (r < 4 * I_W2) { const int mi = r / I_W2; transpose_item(a.ffn_w2 + (size_t)mi * FF * D, FF, D, (bf16_t*)(a.ws + WS_W2T) + (size_t)mi * D * FF, 0, scr, r % I_W2, lane); continue; } r -= 4 * I_W2;
        if (r < 2 * I_WIN) { const int mi = r / I_WIN; transpose_item(a.mix_w_in + (size_t)mi * D * DIN, D, DIN, (bf16_t*)(a.ws + WS_WINT) + (size_t)mi * DIN * D, 2, scr, r % I_WIN, lane); continue; } r -= 2 * I_WIN;
        { const int mi = r / I_WOUT; transpose_item(a.mix_w_out + (size_t)mi * D * D, D, D, (bf16_t*)(a.ws + WS_WOUTT) + (size_t)mi * D * D, 0, scr, r % I_WOUT, lane); }
    }
    { const f32x4* src = (const f32x4*)a.sg_ws; u32x2* dst = (u32x2*)(a.ws + WS_WSG);
      for (int i = bid * NTHREADS + tid; i < 2 * 8 * 128 * 128 / 4; i += G * NTHREADS) { const f32x4 v = src[i]; u32x2 w; w.x = pk2(v[0], v[1]); w.y = pk2(v[2], v[3]); dst[i] = w; } }
}

__device__ __forceinline__ void phase_p0b(const Args& a, LAS unsigned char* lds, int bid, int G, int wave) {
    const int lane = pg8::lane_id_v(), tid = wave * 64 + lane;
    const float* mod = (const float*)(a.ws + WS_MOD);
    float* gmt = (float*)(a.ws + WS_GM);
    for (int i = bid * NTHREADS + tid; i < 6 * NBATCH * D; i += G * NTHREADS) {
        const int d = i & 1023, b = (i >> 10) % NBATCH, lk = i / (NBATCH * D), l = lk / 3, k = lk % 3;
        gmt[i] = a.norm_g[(l * 3 + k) * D + d] * (1.0f + mod[((size_t)l * NBATCH + b) * NMOD + (3 * k + 1) * D + d]);
    }
    const int gw = bid * NWAVES + wave, NGW = G * NWAVES;
    for (int t = gw; t < 2 * 864; t += NGW) {
        const int l = t / 864, r = t % 864;
        int k, tile; if (r < 352) { k = 0; tile = r; } else if (r < 512) { k = 1; tile = r - 352; } else { k = 2; tile = r - 512; }
        const int Nk = (k == 1) ? DIN : NUP;
        const bf16_t* WT = (k == 1) ? (const bf16_t*)(a.ws + WS_WINT) + (size_t)l * DIN * D : (const bf16_t*)(a.ws + WS_W1T) + (size_t)(l * 2 + (k == 2 ? 1 : 0)) * NUP * D;
        float* Sout = (float*)(a.ws + WS_SV) + (size_t)l * SV_LAYER + (k == 0 ? 0 : (k == 1 ? NBATCH * NUP : NBATCH * (NUP + DIN)));
        const int p0 = tile * 16, ii = lane & 15, kq = lane >> 4;
        const bf16_t* xrow = WT + (size_t)(p0 + ii) * D + kq * 8;
        const float* yrow = mod + ((size_t)l * NBATCH + (ii < NBATCH ? ii : 0)) * NMOD + (3 * k) * D + kq * 8;
        const float ymask = ii < NBATCH ? 1.0f : 0.0f;
        f32x4 sacc = (f32x4){0.f, 0.f, 0.f, 0.f};
#pragma unroll 8
        for (int ks = 0; ks < 32; ++ks) {
            const bf16x8 xf = *(const bf16x8*)(xrow + ks * 32);
            const f32x4 y0 = *(const f32x4*)(yrow + ks * 32) * ymask, y1 = *(const f32x4*)(yrow + ks * 32 + 4) * ymask;
            u32x4 yp; yp.x = cvt_pk_bf16(y0[0], y0[1]); yp.y = cvt_pk_bf16(y0[2], y0[3]); yp.z = cvt_pk_bf16(y1[0], y1[1]); yp.w = cvt_pk_bf16(y1[2], y1[3]);
            sacc = __builtin_amdgcn_mfma_f32_16x16x32_bf16(xf, __builtin_bit_cast(bf16x8, yp), sacc, 0, 0, 0);
        }
        if (ii < NBATCH) *(f32x4*)(Sout + (size_t)ii * Nk + p0 + 4 * kq) = sacc;
    }
    const float* gm0 = nullptr; (void)gm0;
    bf16_t* xg = (bf16_t*)(a.ws + WS_XG); float* rss = (float*)(a.ws + WS_RSS);
#pragma unroll 2
    for (int r = gw; r < MTOT; r += NGW) {
        const int b = batch_of(r);
        const float* xr = r < MP ? a.xp + (size_t)r * D : a.xs + (size_t)(r - MP) * D;
        float ss = 0.f; f32x4 v[4];
#pragma unroll
        for (int j = 0; j < 4; ++j) { v[j] = *(const f32x4*)(xr + 4 * lane + 256 * j); ss += (v[j][0] * v[j][0] + v[j][1] * v[j][1]) + (v[j][2] * v[j][2] + v[j][3] * v[j][3]); }
        ss = wave_sum(ss);
        if (lane < 16) rss[(size_t)r * 16 + lane] = lane == 0 ? ss : 0.f;
#pragma unroll
        for (int j = 0; j < 4; ++j) { const int d = 4 * lane + 256 * j;
            const f32x4 g = *(const f32x4*)(a.norm_g + d); const f32x4 sc = *(const f32x4*)(mod + (size_t)b * NMOD + D + d);
            const f32x4 o = v[j] * (g * (sc + 1.0f));
            u32x2 w; w.x = cvt_pk_bf16(o[0], o[1]); w.y = cvt_pk_bf16(o[2], o[3]); *(u32x2*)(xg + (size_t)r * D + d) = w; }
    }
}

__device__ __forceinline__ void phase_final(const Args& a, int bid, int G, int wave) {
    const int lane = pg8::lane_id_v();
    const int gw = bid * NWAVES + wave, NGW = G * NWAVES;
    const float* rss = (const float*)(a.ws + WS_RSS);
    f32x4 fg[4];
#pragma unroll
    for (int j = 0; j < 4; ++j) fg[j] = *(const f32x4*)(a.final_g + 4 * lane + 256 * j);
    for (int r = gw; r < MTOT; r += NGW) {
        float s = rss[(size_t)r * 16 + (lane & 15)];
        s += __shfl_xor(s, 1); s += __shfl_xor(s, 2); s += __shfl_xor(s, 4); s += __shfl_xor(s, 8);
        const float rs = rsqrtf(s * (1.0f / D) + EPS);
        float* xr = a.out + (size_t)r * D;
#pragma unroll
        for (int j = 0; j < 4; ++j) { f32x4 v = *(const f32x4*)(xr + 4 * lane + 256 * j); v = v * rs * fg[j]; *(f32x4*)(xr + 4 * lane + 256 * j) = v; }
    }
}

__device__ __forceinline__ bool seq_start(int t) { return t < MP ? (t & 4095) == 0 : (t & 16383) == 0; }
__device__ __forceinline__ void unpack8(const u32x4 w, float (&f)[8]) {
#pragma unroll
    for (int j = 0; j < 4; ++j) { f[2 * j] = bf_lo(w[j]); f[2 * j + 1] = bf_hi(w[j]); }
}
constexpr int VT_LD = 136;
__device__ __forceinline__ void phase_mixer(const Args& a, LAS unsigned char* lds, int l, int bid, int G, int dostore, int wave) {
    const int lane = pg8::lane_id_v(), tid = wave * 64 + lane, fr = lane & 15, fq = lane >> 4;
    bf16_t* Z = (bf16_t*)(a.ws + WS_ZH);
    const float* vst = (const float*)(a.ws + WS_VST);
    const float* convw = a.conv_w + (size_t)l * 3 * 512;
    const float* sgn = a.sg_norm_g + (size_t)l * 512;
    const bf16_t* wsg = (const bf16_t*)(a.ws + WS_WSG) + (size_t)l * 8 * 128 * 128;
    const float* sgb = a.sg_bs + (size_t)l * 8 * 128;
    const float* gg = a.grp_g + (size_t)l * 1024;
    LAS f32x2* st = (LAS f32x2*)lds;
    LAS bf16_t* vT = (LAS bf16_t*)(lds + 1024);
    for (int ch = bid; ch < MTOT / 128; ch += G) {
        const int r0 = ch * 128;
        if (tid < 128) {
            const f32x4* p = (const f32x4*)(vst + (size_t)(r0 + tid) * 16); float s1 = 0.f, s2 = 0.f;
#pragma unroll
            for (int i = 0; i < 4; ++i) { const f32x4 v = p[i]; s1 += v[0] + v[2]; s2 += v[1] + v[3]; }
            const float mean = s1 * (1.0f / 512.0f); const float var = fmaxf(s2 * (1.0f / 512.0f) - mean * mean, 0.f);
            st[tid] = (f32x2){mean, rsqrtf(var + EPS)};
        }
        {
            const int t0 = r0 + 16 * wave, c0 = 8 * lane;
            float w0[8], w1[8], w2[8], g8[8];
#pragma unroll
            for (int j = 0; j < 8; ++j) { w0[j] = convw[c0 + j]; w1[j] = convw[512 + c0 + j]; w2[j] = convw[1024 + c0 + j]; g8[j] = gg[c0 + j]; }
            float prev[8], cur[8], nxt[8];
            { u32x4 w = (u32x4){0u, 0u, 0u, 0u}; if (!seq_start(t0)) w = *(const u32x4*)(Z + (size_t)(t0 - 1) * ZW + 1024 + c0); unpack8(w, prev); }
            { const u32x4 w = *(const u32x4*)(Z + (size_t)t0 * ZW + 1024 + c0); unpack8(w, cur); }
#pragma unroll 4
            for (int i = 0; i < 16; ++i) {
                const int t = t0 + i;
                { u32x4 w = (u32x4){0u, 0u, 0u, 0u}; if (!(t + 1 >= MTOT || seq_start(t + 1))) w = *(const u32x4*)(Z + (size_t)(t + 1) * ZW + 1024 + c0); unpack8(w, nxt); }
                float bg[8]; { const u32x4 w = *(const u32x4*)(Z + (size_t)t * ZW + c0); unpack8(w, bg); }
                float y[8]; float ss = 0.f;
#pragma unroll
                for (int j = 0; j < 8; ++j) { y[j] = bg[j] * (w0[j] * prev[j] + w1[j] * cur[j] + w2[j] * nxt[j]); ss += y[j] * y[j]; }
                ss = wave_sum(ss);
                const float rs = rsqrtf(ss * (1.0f / 512.0f) + EPS);
                u32x4 o;
                o.x = cvt_pk_bf16(y[0] * rs * g8[0], y[1] * rs * g8[1]); o.y = cvt_pk_bf16(y[2] * rs * g8[2], y[3] * rs * g8[3]);
                o.z = cvt_pk_bf16(y[4] * rs * g8[4], y[5] * rs * g8[5]); o.w = cvt_pk_bf16(y[6] * rs * g8[6], y[7] * rs * g8[7]);
                if (dostore) *(u32x4*)(Z + (size_t)t * ZW + c0) = o;
#pragma unroll
                for (int j = 0; j < 8; ++j) { prev[j] = cur[j]; cur[j] = nxt[j]; }
            }
        }
        __syncthreads();
        f32x4 acc[8][4];
        float ss = 0.f;
        const int prow = 16 * wave + fr;
        const int sq = tid >> 3, sdc = tid & 7;
        u32x4 vw[2]; bf16x8 wf[4];
#pragma unroll
        for (int i = 0; i < 2; ++i) vw[i] = *(const u32x4*)(Z + (size_t)(r0 + sq + 64 * i) * ZW + 1536 + sdc * 8);
#pragma unroll
        for (int ks = 0; ks < 4; ++ks) wf[ks] = *(const bf16x8*)(wsg + ((size_t)prow) * 128 + fq * 8 + 32 * ks);
#pragma unroll
        for (int h = 0; h < 8; ++h) {
            LAS bf16_t* vb = vT + (h & 1) * 64 * VT_LD;
            const f32x4 ga = *(const f32x4*)(sgn + h * 64 + sdc * 8), gb = *(const f32x4*)(sgn + h * 64 + sdc * 8 + 4);
#pragma unroll
            for (int i = 0; i < 2; ++i) {
                const int q = sq + 64 * i;
                float f[8]; unpack8(vw[i], f);
                const f32x2 ms = st[q];
                const int qs = (((q >> 3) ^ sdc) << 3) | (q & 7);
#pragma unroll
                for (int j = 0; j < 8; ++j) { const float gj = j < 4 ? ga[j] : gb[j - 4]; const float vn = (f[j] - ms.x) * ms.y * gj; vb[(sdc * 8 + j) * VT_LD + qs] = (bf16_t)f2bf(vn); }
            }
            bf16x8 wcur[4];
#pragma unroll
            for (int ks = 0; ks < 4; ++ks) wcur[ks] = wf[ks];
            u32x2 uw[4];
#pragma unroll
            for (int nd = 0; nd < 4; ++nd) uw[nd] = *(const u32x2*)(Z + (size_t)(r0 + prow) * ZW + 512 + h * 64 + 16 * nd + 4 * fq);
            const float bias = sgb[h * 128 + prow];
            if (h + 1 < 8) {
#pragma unroll
                for (int i = 0; i < 2; ++i) vw[i] = *(const u32x4*)(Z + (size_t)(r0 + sq + 64 * i) * ZW + 1536 + (h + 1) * 64 + sdc * 8);
#pragma unroll
                for (int ks = 0; ks < 4; ++ks) wf[ks] = *(const bf16x8*)(wsg + ((size_t)((h + 1) * 128 + prow)) * 128 + fq * 8 + 32 * ks);
            }
            __syncthreads();
#pragma unroll
            for (int nd = 0; nd < 4; ++nd) {
                f32x4 c = (f32x4){0.f, 0.f, 0.f, 0.f};
                const int rowv = 16 * nd + fr, sw = (rowv >> 3) & 7;
#pragma unroll
                for (int ks = 0; ks < 4; ++ks) {
                    const bf16x8 vf = *(const LAS bf16x8*)(vb + rowv * VT_LD + (((fq + 4 * ks) ^ sw) << 3));
                    c = __builtin_amdgcn_mfma_f32_16x16x32_bf16(vf, wcur[ks], c, 0, 0, 0);
                }
                f32x4 y; y[0] = bf_lo(uw[nd].x) * (c[0] + bias); y[1] = bf_hi(uw[nd].x) * (c[1] + bias); y[2] = bf_lo(uw[nd].y) * (c[2] + bias); y[3] = bf_hi(uw[nd].y) * (c[3] + bias);
                ss += (y[0] * y[0] + y[1] * y[1]) + (y[2] * y[2] + y[3] * y[3]);
                acc[h][nd] = y;
            }
        }
        ss += __shfl_xor(ss, 16); ss += __shfl_xor(ss, 32);
        const float rs = rsqrtf(ss * (1.0f / 512.0f) + EPS);
#pragma unroll
        for (int h = 0; h < 8; ++h)
#pragma unroll
            for (int nd = 0; nd < 4; ++nd) {
                const int c = h * 64 + 16 * nd + 4 * fq;
                const f32x4 g = *(const f32x4*)(gg + 512 + c);
                const f32x4 o = acc[h][nd] * rs * g;
                u32x2 w; w.x = cvt_pk_bf16(o[0], o[1]); w.y = cvt_pk_bf16(o[2], o[3]);
                if (dostore) *(u32x2*)(Z + (size_t)(r0 + prow) * ZW + 512 + c) = w;
            }
        __syncthreads();
    }
}


#define XB_TMO      128
#define XB_XCNT(j)  (256  + 64 * (j))
#define XB_XSUB(j)  (1280 + 64 * (j))
#define XB_XGEN(j)  (2304 + 64 * (j))
#define XB_TOP      3328
#define XB_TOPGEN   3392
#define XCD_BAR_WORDS 3456
#define XB_SPIN_CAP (1u << 20)
__device__ __forceinline__ unsigned xb_ld(unsigned* p)              { return __hip_atomic_load(p, __ATOMIC_RELAXED, __HIP_MEMORY_SCOPE_AGENT); }
__device__ __forceinline__ unsigned xb_add(unsigned* p, unsigned v) { return __hip_atomic_fetch_add(p, v, __ATOMIC_RELAXED, __HIP_MEMORY_SCOPE_AGENT); }
__device__ __forceinline__ unsigned xb_xcc_id() { return (unsigned)__builtin_amdgcn_s_getreg((3 << 11) | 20) & 0xFu; }
#define XB_SPIN(cond, bar) do { unsigned _sp = 0; while (cond) { __builtin_amdgcn_s_sleep(1); \
    if ((++_sp & 255u) == 0u) { if (xb_ld(&(bar)[XB_TMO])) break; if (_sp > XB_SPIN_CAP) { atomicAdd(&(bar)[XB_TMO], 1u); break; } } } } while (0)
struct XcdBarrier { unsigned* bar; unsigned x; volatile LAS unsigned* st; };
__device__ __forceinline__ XcdBarrier xcd_barrier_post(unsigned* bar, volatile LAS unsigned* st, int wave) {
    XcdBarrier b; b.bar = bar; b.x = xb_xcc_id(); b.st = st;
    if (wave == 0 && pg8::lane_id_v() == 0) (void)xb_add(&bar[XB_XCNT(b.x)], 1u);
    return b;
}
__device__ __forceinline__ void xcd_barrier_complete(unsigned* bar, unsigned x, unsigned& nloc, unsigned& nx) {
    const unsigned G = gridDim.x * gridDim.y * gridDim.z;
    unsigned sum, cnt, mine, sp = 0u;
    for (;;) {
        sum = 0u; cnt = 0u; mine = 0u;
#pragma unroll
        for (unsigned j = 0; j < 16; ++j) { const unsigned c = xb_ld(&bar[XB_XCNT(j)]); sum += c; cnt += (c > 0u) ? 1u : 0u; mine = (j == x) ? c : mine; }
        if (sum == G) break;
        __builtin_amdgcn_s_sleep(1);
        if ((++sp & 255u) == 0u) { if (xb_ld(&bar[XB_TMO])) break; if (sp > XB_SPIN_CAP) { atomicAdd(&bar[XB_TMO], 1u); break; } }
    }
    nloc = mine > 0u ? mine : 1u; nx = cnt > 0u ? cnt : 1u;
}
__device__ __forceinline__ void xcd_barrier(const XcdBarrier& b, int wave) {
    asm volatile("s_waitcnt vmcnt(0)" ::: "memory");
    __syncthreads();
    if (wave == 0 && pg8::lane_id_v() == 0) {
        unsigned* bar = b.bar;
        __builtin_amdgcn_s_waitcnt(0);
        unsigned nloc = b.st[0], nx = b.st[1];
        if (nloc == 0u) { xcd_barrier_complete(bar, b.x, nloc, nx); b.st[0] = nloc; b.st[1] = nx; }
        const unsigned old = xb_add(&bar[XB_XSUB(b.x)], 1u);
        const unsigned gen = old / nloc;
        if (old + 1u == (gen + 1u) * nloc) {
            __builtin_amdgcn_fence(__ATOMIC_RELEASE, "agent");
            asm volatile("s_waitcnt vmcnt(0)" ::: "memory");
            const unsigned og = xb_add(&bar[XB_TOP], 1u);
            const unsigned tg = og / nx;
            if (og + 1u == (tg + 1u) * nx) xb_add(&bar[XB_TOPGEN], 1u);
            else XB_SPIN(xb_ld(&bar[XB_TOPGEN]) == tg, bar);
            __builtin_amdgcn_fence(__ATOMIC_ACQUIRE, "agent");
            xb_add(&bar[XB_XGEN(b.x)], 1u);
            asm volatile("s_waitcnt vmcnt(0)" ::: "memory");
        } else {
            XB_SPIN(xb_ld(&bar[XB_XGEN(b.x)]) == gen, bar);
            __builtin_amdgcn_fence(__ATOMIC_ACQUIRE, "agent");
            asm volatile("s_waitcnt vmcnt(0)" ::: "memory");
        }
    }
    __syncthreads();
}

__global__ void __launch_bounds__(NTHREADS, 2) fwd_megakernel(Args a) {
    extern __shared__ __attribute__((aligned(16))) unsigned char lds_raw[];
    LAS unsigned char* lds = (LAS unsigned char*)lds_raw;
    const int G = gridDim.x, bid = blockIdx.x;
    unsigned char* ws = a.ws;
    volatile LAS unsigned* bst = (volatile LAS unsigned*)(lds + 131072 + 512);
    if (threadIdx.x < 2) bst[threadIdx.x] = 0u;
    __syncthreads();
    XcdBarrier xbar; xbar.bar = (unsigned*)ws; xbar.x = 0; xbar.st = bst;
    const int wave = __builtin_amdgcn_readfirstlane(threadIdx.x >> 6);
    if (a.ph_hi - a.ph_lo > 1) xbar = xcd_barrier_post((unsigned*)ws, bst, wave);
    int ph0 = a.ph_lo;
    if (ph0 == 0 && a.ph_hi > 1) { phase_p0a(a, lds, bid, G, wave); cg::this_grid().sync(); ph0 = 1; }
#define GRID_SYNC(first) do { xcd_barrier(xbar, wave); } while (0)
    for (int ph = ph0; ph < a.ph_hi; ++ph) {
        int nrep = 1;
#if MK_PROBE == 1
        if (ph <= 1) nrep = 2;
#elif MK_PROBE == 2
        if (ph >= 2 && ph < NPHASES - 1) { const int s_ = (ph - 2) % 11; if (s_ == 0 || s_ == 2 || s_ == 7 || s_ == 9) nrep = 2; }
#elif MK_PROBE == 5
        if (ph >= 2 && ph < NPHASES - 1) { const int s_ = (ph - 2) % 11; if (s_ == 5) nrep = 2; }
#elif MK_PROBE == 6
        if (ph >= 2 && ph < NPHASES - 1) { const int s_ = (ph - 2) % 11; if (s_ == 1 || s_ == 3 || s_ == 6 || s_ == 8 || s_ == 10) nrep = 2; }
#elif MK_PROBE == 4
        if (ph >= 2 && ph < NPHASES - 1) { const int s_ = (ph - 2) % 11; if (s_ == 4) nrep = 2; }
#endif
        asm volatile("" : "+s"(nrep));
        for (int rep = 0; rep < nrep; ++rep) {
        int dostore = (rep + 1 == nrep) ? 1 : 0; dostore = __builtin_amdgcn_readfirstlane(dostore);
        if (ph == 0) phase_p0a(a, lds, bid, G, wave);
        else if (ph == 1) phase_p0b(a, lds, bid, G, wave);
        else if (ph == NPHASES - 1) phase_final(a, bid, G, wave);
        else {
            const int q = ph - 2, l = q / 11, s = q % 11;
            const float* mod_l = (const float*)(ws + WS_MOD) + (size_t)l * NBATCH * NMOD;
            const float* gmt = (const float*)(ws + WS_GM);
            const float* svl = (const float*)(ws + WS_SV) + (size_t)l * SV_LAYER;
            float* rss = (float*)(ws + WS_RSS);
            bf16_t* xg = (bf16_t*)(ws + WS_XG);
            bf16_t* zh = (bf16_t*)(ws + WS_ZH);
            if (s == 5) phase_mixer(a, lds, l, bid, G, dostore, wave);
            else if (s == 4) {
                pg8::Gemm g{xg, (const bf16_t*)(ws + WS_WINT) + (size_t)l * DIN * D, MTOT, DIN, D, D};
                pg8::StaticOrder S; S.init(MTOT, DIN, G, bid);
                EpiMixIn E{zh, rss, svl + NBATCH * NUP, (float*)(ws + WS_VST)};
                pg8::gemm_phase<EpiMixIn, pg8::StaticOrder, true, true>(lds, g, S, E, wave);
            } else if (s == 6) {
                pg8::Gemm g{zh, (const bf16_t*)(ws + WS_WOUTT) + (size_t)l * D * D, MTOT, D, D, ZW};
                pg8::StaticOrder S; S.init(MTOT, D, G, bid);
                EpiRes E{a.xp, a.xs, 0, a.out, xg, rss, mod_l + 5 * D, gmt + (size_t)(l * 3 + 2) * NBATCH * D, 1.0f, 0, dostore};
                pg8::gemm_phase<EpiRes, pg8::StaticOrder, true, true>(lds, g, S, E, wave);
            } else {
                const int f = s >= 7 ? 1 : 0, s2 = f ? s - 7 : s, half = s2 >> 1, rowbase = half * MP;
                if ((s2 & 1) == 0) {
                    pg8::Gemm g{xg + (size_t)rowbase * D, (const bf16_t*)(ws + WS_W1T) + (size_t)(l * 2 + f) * NUP * D, MP, NUP, D, D};
                    pg8::StaticOrder S; S.init(MP, NUP, G, bid);
                    EpiUp E{zh, rss, svl + (f ? NBATCH * (NUP + DIN) : 0), rowbase};
                    pg8::gemm_phase<EpiUp, pg8::StaticOrder, true, true>(lds, g, S, E, wave);
                } else {
                    pg8::Gemm g{zh, (const bf16_t*)(ws + WS_W2T) + (size_t)(l * 2 + f) * D * FF, MP, D, FF, FF};
                    pg8::StaticOrder S; S.init(MP, D, G, bid);
                    const float* gmn = f == 0 ? gmt + (size_t)(l * 3 + 1) * NBATCH * D : (l == 0 ? gmt + (size_t)3 * NBATCH * D : nullptr);
                    EpiRes E{a.xp, a.xs, (l == 0 && f == 0) ? 1 : 0, a.out, xg, rss, mod_l + (f ? 8 : 2) * D, gmn, 0.5f, rowbase, dostore};
                    pg8::gemm_phase<EpiRes, pg8::StaticOrder, true, true>(lds, g, S, E, wave);
                }
            }
        }
        if (rep + 1 < nrep) GRID_SYNC(0);
        }
        if (ph + 1 < a.ph_hi) GRID_SYNC(ph == a.ph_lo);
#if MK_PROBE == 3
        if (ph + 1 < a.ph_hi) GRID_SYNC(0);
#endif
    }
}

extern "C" void kernel_launch(void* const* d_in, const int* in_sizes, int n_in, void* d_out, int out_size, void* d_ws, size_t ws_size, hipStream_t stream) {
    static int grid = 0;
    if (grid == 0) {
        if (n_in != 17 || out_size != MTOT * D || ws_size < WS_END) { fprintf(stderr, "kernel_launch: unexpected shapes (n_in %d out %d ws %zu)\n", n_in, out_size, ws_size); grid = -1; return; }
        int dev = 0, cus = 0, per_cu = 0;
        hipGetDevice(&dev);
        hipDeviceGetAttribute(&cus, hipDeviceAttributeMultiprocessorCount, dev);
        if (hipFuncSetAttribute((const void*)fwd_megakernel, hipFuncAttributeMaxDynamicSharedMemorySize, LDS_BYTES) != hipSuccess) { fprintf(stderr, "kernel_launch: hipFuncSetAttribute failed\n"); grid = -1; return; }
        if (hipOccupancyMaxActiveBlocksPerMultiprocessor(&per_cu, (const void*)fwd_megakernel, NTHREADS, LDS_BYTES) != hipSuccess || per_cu < 1) { fprintf(stderr, "kernel_launch: occupancy query says %d\n", per_cu); per_cu = 1; }
        (void)hipGetLastError();
        grid = cus * per_cu;
        fprintf(stderr, "kernel_launch: grid %d (cus %d x %d)\n", grid, cus, per_cu);
    }
    if (grid < 0) return;
    Args a{};
    a.xp = (const float*)d_in[0]; a.xs = (const float*)d_in[1]; a.cp = (const float*)d_in[2]; a.cs = (const float*)d_in[3];
    a.ada_w = (const float*)d_in[4]; a.ada_b = (const float*)d_in[5]; a.norm_g = (const float*)d_in[6]; a.ffn_w1 = (const float*)d_in[7];
    a.ffn_w2 = (const float*)d_in[8]; a.mix_w_in = (const float*)d_in[9]; a.conv_w = (const float*)d_in[10]; a.sg_norm_g = (const float*)d_in[11];
    a.sg_ws = (const float*)d_in[12]; a.sg_bs = (const float*)d_in[13]; a.grp_g = (const float*)d_in[14]; a.mix_w_out = (const float*)d_in[15];
    a.final_g = (const float*)d_in[16];
    a.out = (float*)d_out; a.ws = (unsigned char*)d_ws;
#if MK_ONE_LAUNCH
    a.ph_lo = 0; a.ph_hi = NPHASES;
    if (hipMemsetAsync(d_ws, 0, XCD_BAR_WORDS * 4, stream) != hipSuccess) { fprintf(stderr, "kernel_launch: memset failed\n"); return; }
    void* args[] = {&a};
    hipError_t e = hipLaunchCooperativeKernel((const void*)fwd_megakernel, dim3(grid), dim3(NTHREADS), args, LDS_BYTES, stream);
    if (e != hipSuccess) fprintf(stderr, "cooperative launch failed: %s (grid %d)\n", hipGetErrorString(e), grid);
#else
    for (int ph = 0; ph < NPHASES; ++ph) {
        a.ph_lo = ph; a.ph_hi = ph + 1;
        hipLaunchKernelGGL(fwd_megakernel, dim3(grid), dim3(NTHREADS), LDS_BYTES, stream, a);
    }
#endif
}
```

```cpp
#include <hip/hip_runtime.h>
#include <hip/hip_cooperative_groups.h>
#include <cstdio>
#include <cstdint>
namespace cg = cooperative_groups;

#ifndef MK_PROBE
#define MK_PROBE 0
#endif
#ifndef MK_ONE_LAUNCH
#define MK_ONE_LAUNCH 1
#endif

constexpr int D = 1024, FF = 2816, NUP = 2 * FF, DIN = 2560, ZW = 2048;
constexpr int MTOT = 65536, MP = 32768;
constexpr int NBATCH = 10, NMOD = 9 * D;
constexpr float EPS = 1e-6f;
constexpr int NWAVES = 8, NTHREADS = 512;
constexpr int NPHASES = 25;

constexpr size_t MiB = 1u << 20;
constexpr size_t WS_MOD = 1 * MiB;
constexpr size_t WS_GM = 2 * MiB;
constexpr size_t WS_SV = 3 * MiB;
constexpr size_t WS_RSS = 5 * MiB;
constexpr size_t WS_VST = 9 * MiB;
constexpr size_t WS_WSG = 13 * MiB;
constexpr size_t WS_W1T = 14 * MiB;
constexpr size_t WS_W2T = 58 * MiB;
constexpr size_t WS_WINT = 80 * MiB;
constexpr size_t WS_WOUTT = 90 * MiB;
constexpr size_t WS_XG = 94 * MiB;
constexpr size_t WS_ZH = 222 * MiB;
constexpr size_t WS_END = 478 * MiB;
constexpr int SV_LAYER = NBATCH * (NUP + DIN + NUP);

constexpr int LDS_BYTES = 163840;
constexpr int LDS_XOFF = 132096;

namespace pg8 {
#define PG8_LAS __attribute__((address_space(3)))
typedef unsigned short bf16_t;
typedef short bf16x8 __attribute__((ext_vector_type(8)));
typedef float f32x4 __attribute__((ext_vector_type(4)));
typedef float f32x2 __attribute__((ext_vector_type(2)));
typedef unsigned u32x4 __attribute__((ext_vector_type(4)));
typedef unsigned u32x2 __attribute__((ext_vector_type(2)));
constexpr int BM = 256, BK = 64, HALF = 128, HTB = HALF * BK * 2, STAGE_BYTES = 8 * HTB, NXCD = 8, WGM = 8;

__host__ __device__ __forceinline__ int lds_byte(int r, int c) { const int st = (r >> 4) * 2 + (c >> 5), rr = r & 15, cc = c & 31, ob = rr * 64 + cc * 2; return st * 1024 + (ob ^ (((ob >> 9) & 1) << 5)); }
__host__ __device__ __forceinline__ void stage_rc(int b, int& R, int& C) { const int st = b / 1024, sb = b % 1024, swz = sb ^ (((sb >> 9) & 1) << 5); R = (st >> 1) * 16 + swz / 64; C = (st & 1) * 32 + (swz % 64) / 2; }
__host__ __device__ __forceinline__ int perm32(int rho) { const int n = rho >> 4, i = rho & 15; return 8 * (i >> 2) + 4 * n + (i & 3); }

struct Unit { int pm, pn; };
struct Gemm { const bf16_t* A; const bf16_t* Bt; int M, N, K, lda; };

struct StaticOrder {
    int nM, nN, nwg, G, c;
    __host__ __device__ void init(int M, int N, int G_, int c_) { nM = M / BM; nN = N / BM; nwg = nM * nN; G = G_; c = c_; }
    __host__ __device__ bool next(int i, Unit& u) const {
        const long L = (long)i * G + c; if (L >= nwg) return false;
        int wgid = (int)L; { const int q = nwg / NXCD, r = nwg % NXCD, xcd = wgid % NXCD, off = wgid / NXCD; wgid = (xcd < r ? xcd * (q + 1) : r * (q + 1) + (xcd - r) * q) + off; }
        const int nig = WGM * nN, gid = wgid / nig, fm = gid * WGM, gsz = (nM - fm) < WGM ? (nM - fm) : WGM;
        u.pm = fm + ((wgid % nig) % gsz); u.pn = (wgid % nig) / gsz; return true;
    }
};

__device__ __forceinline__ unsigned cvt_pk_bf16(float lo, float hi) { unsigned r; asm volatile("v_cvt_pk_bf16_f32 %0, %1, %2" : "=v"(r) : "v"(lo), "v"(hi)); return r; }
__device__ __forceinline__ f32x2 gelu_pk(f32x2 v) {
    const f32x2 av = __builtin_elementwise_abs(v), d = av * 0.2316418882f + 1.0f;
    f32x2 t; t.x = __builtin_amdgcn_rcpf(d.x); t.y = __builtin_amdgcn_rcpf(d.y);
    f32x2 q = t * 0.5307027145f + (-0.7265760135f); q = q * t + 0.7107068705f; q = q * t + (-0.142248368f); q = q * t + 0.127414796f; q = q * t;
    const f32x2 s = (v * v) * (-0.72134752044f);
    f32x2 e; e.x = __builtin_amdgcn_exp2f(s.x); e.y = __builtin_amdgcn_exp2f(s.y);
    const f32x2 m = v * (q * e), r = v - m;
    f32x2 o; o.x = v.x < 0.f ? m.x : r.x; o.y = v.y < 0.f ? m.y : r.y; return o;
}
__device__ __forceinline__ f32x4 gelu4(f32x4 v) { const f32x2 a = gelu_pk((f32x2){v[0], v[1]}), b = gelu_pk((f32x2){v[2], v[3]}); return (f32x4){a.x, a.y, b.x, b.y}; }
__device__ __forceinline__ float silu1(float g) { return g * __builtin_amdgcn_rcpf(1.0f + __builtin_amdgcn_exp2f(-1.4426950409f * g)); }
__device__ __forceinline__ f32x2 silu_mul_pk(f32x2 g, f32x2 u) {
    const f32x2 t = g * (-1.4426950409f);
    f32x2 e; e.x = __builtin_amdgcn_exp2f(t.x); e.y = __builtin_amdgcn_exp2f(t.y);
    const f32x2 d = e + 1.0f;
    f32x2 r; r.x = __builtin_amdgcn_rcpf(d.x); r.y = __builtin_amdgcn_rcpf(d.y);
    return (g * u) * r;
}

__device__ __forceinline__ int lane_id_v() { int l; asm volatile("v_mbcnt_lo_u32_b32 %0, -1, 0\n\tv_mbcnt_hi_u32_b32 %0, -1, %0" : "=v"(l)); return l; }
template <class Epi, class Sched, bool ALIGN_EPI, bool SP2>
__device__ __forceinline__ void gemm_phase(PG8_LAS unsigned char* lds, const Gemm g, const Sched& S, const Epi& E, int wid) {
    const int lane = lane_id_v(), tid = wid * 64 + lane;
    const int wr = wid >> 2, wc = wid & 3, fr = lane & 15, fq = lane >> 4;
    const int K = g.K, nt = K / BK, lda = g.lda;
    unsigned voffA[2], voffB[2];
#pragma unroll
    for (int i = 0; i < 2; ++i) { int R, C; stage_rc(tid * 16 + i * 8192, R, C); const int Rb = Epi::PERM ? ((R & ~31) + perm32(R & 31)) : R;
        voffA[i] = (unsigned)(R * lda + C) * 2u; voffB[i] = (unsigned)(Rb * K + C) * 2u; }
    const size_t kstep = (size_t)(BK * 2);
    const size_t hstepA = (size_t)HALF * lda * 2, hstepB = (size_t)HALF * K * 2;
    const size_t tstepA = 2 * hstepA, tstepB = 2 * hstepB;
    const unsigned ldsw = (unsigned)wid * 1024u;
    const int aoff = lds_byte(wr * 64 + fr, fq * 8), boff = lds_byte(wc * 32 + fr, fq * 8);
#define PG8_SA(b, h) (((b) * 2 + (h)) * HTB)
#define PG8_SB(b, h) ((4 + (b) * 2 + (h)) * HTB)
#define PG8_STAGE(bufoff, gbase, voff) do { _Pragma("unroll") for (int _i = 0; _i < 2; ++_i) \
        __builtin_amdgcn_global_load_lds((const unsigned*)((const char*)(gbase) + (voff)[_i]), (PG8_LAS unsigned*)(lds + (bufoff) + ldsw + _i * 8192), 16, 0, 0); } while (0)
#define PG8_LDA(dst, b, h) do { _Pragma("unroll") for (int m = 0; m < 4; ++m) _Pragma("unroll") for (int k = 0; k < 2; ++k) dst[m][k] = *(const PG8_LAS bf16x8*)(lds + PG8_SA(b, h) + aoff + m * 2048 + k * 1024); } while (0)
#define PG8_LDB(dst, b, h) do { _Pragma("unroll") for (int n = 0; n < 2; ++n) _Pragma("unroll") for (int k = 0; k < 2; ++k) dst[n][k] = *(const PG8_LAS bf16x8*)(lds + PG8_SB(b, h) + boff + n * 2048 + k * 1024); } while (0)
#define PG8_MMA(ai, bj, At, Bt) do { __builtin_amdgcn_s_setprio(1); _Pragma("unroll") for (int m = 0; m < 4; ++m) _Pragma("unroll") for (int n = 0; n < 2; ++n) _Pragma("unroll") for (int k = 0; k < 2; ++k) \
        acc[ai][bj][m][n] = __builtin_amdgcn_mfma_f32_16x16x32_bf16(Bt[n][k], At[m][k], acc[ai][bj][m][n], 0, 0, 0); __builtin_amdgcn_s_setprio(0); } while (0)
#define PG8_WAIT_V(n) asm volatile("s_waitcnt vmcnt(" #n ")" ::: "memory")
#define PG8_WAIT_L(n) asm volatile("s_waitcnt lgkmcnt(" #n ")" ::: "memory")
#define PG8_BAR __builtin_amdgcn_s_barrier()
#define PG8_SCHED __builtin_amdgcn_sched_barrier(0)
    Unit cur, nxt; int ui = 0;
    if (!S.next(0, cur)) return;
    f32x4 acc[2][2][4][2];
#pragma unroll
    for (int a = 0; a < 2; ++a)
#pragma unroll
        for (int b = 0; b < 2; ++b)
#pragma unroll
            for (int m = 0; m < 4; ++m)
#pragma unroll
                for (int n = 0; n < 2; ++n) acc[a][b][m][n] = (f32x4){0.f, 0.f, 0.f, 0.f};
    bf16x8 At[4][2], B0[2][2], B1[2][2];
    const char* cA = (const char*)g.A + (size_t)cur.pm * tstepA; const char* cB = (const char*)g.Bt + (size_t)cur.pn * tstepB;
    if constexpr (SP2) {
        PG8_STAGE(PG8_SB(0, 0), cB, voffB); PG8_STAGE(PG8_SB(0, 1), cB + hstepB, voffB); PG8_STAGE(PG8_SA(0, 0), cA, voffA); PG8_STAGE(PG8_SA(0, 1), cA + hstepA, voffA);
        if (wr == 1) PG8_BAR;
        PG8_WAIT_V(2); PG8_BAR;
        PG8_STAGE(PG8_SB(1, 0), cB + kstep, voffB); PG8_STAGE(PG8_SA(1, 0), cA + kstep, voffA); PG8_STAGE(PG8_SB(1, 1), cB + hstepB + kstep, voffB);
        PG8_WAIT_V(6); PG8_BAR;
    } else {
        PG8_STAGE(PG8_SB(0, 0), cB, voffB); PG8_STAGE(PG8_SA(0, 0), cA, voffA); PG8_STAGE(PG8_SB(0, 1), cB + hstepB, voffB); PG8_STAGE(PG8_SA(0, 1), cA + hstepA, voffA);
        if (wr == 1) PG8_BAR;
        PG8_WAIT_V(4); PG8_BAR;
        PG8_STAGE(PG8_SB(1, 0), cB + kstep, voffB); PG8_STAGE(PG8_SA(1, 0), cA + kstep, voffA); PG8_STAGE(PG8_SB(1, 1), cB + hstepB + kstep, voffB);
        PG8_WAIT_V(6); PG8_BAR;
    }
    for (;;) {
        const bool has_next = S.next(ui + 1, nxt);
        const char* nA = has_next ? (const char*)g.A + (size_t)nxt.pm * tstepA : cA; const char* nB = has_next ? (const char*)g.Bt + (size_t)nxt.pn * tstepB : cB;
        for (int t = 0; t < nt; t += 2) {
            const bool last = (t == nt - 2);
            const char* a1 = cA + (size_t)(t + 1) * kstep;
            const char* a2 = last ? nA : cA + (size_t)(t + 2) * kstep; const char* b2 = last ? nB : cB + (size_t)(t + 2) * kstep;
            const char* a3 = a2 + kstep; const char* b3 = b2 + kstep;
            if constexpr (Epi::PRE) { if (last) {
                const char* rsrc; const char* ssrc; E.pre(cur, rsrc, ssrc);
#pragma unroll
                for (int _i = 0; _i < 2; ++_i) __builtin_amdgcn_global_load_lds((const unsigned*)(rsrc + (wid + 8 * _i) * 1024 + lane * 16), (PG8_LAS unsigned*)(lds + LDS_XOFF + (wid + 8 * _i) * 1024), 16, 0, 0);
                if (wid == 0) __builtin_amdgcn_global_load_lds((const unsigned*)(ssrc + lane * 16), (PG8_LAS unsigned*)(lds + LDS_XOFF + 16384), 16, 0, 0);
            } }
            if constexpr (SP2) {
            PG8_LDB(B0, 0, 0); PG8_LDB(B1, 0, 1); PG8_SCHED; PG8_LDA(At, 0, 0); PG8_STAGE(PG8_SA(1, 1), a1 + hstepA, voffA);
            PG8_WAIT_V(8); PG8_WAIT_L(0); PG8_BAR; PG8_MMA(0, 0, At, B0); PG8_MMA(0, 1, At, B1); PG8_BAR; PG8_SCHED;
            PG8_LDA(At, 0, 1); PG8_STAGE(PG8_SB(0, 0), b2, voffB); PG8_STAGE(PG8_SB(0, 1), b2 + hstepB, voffB); PG8_STAGE(PG8_SA(0, 0), a2, voffA);
            PG8_WAIT_V(8); PG8_WAIT_L(0); PG8_BAR; PG8_MMA(1, 0, At, B0); PG8_MMA(1, 1, At, B1); PG8_BAR; PG8_SCHED;
            PG8_LDB(B0, 1, 0); PG8_LDB(B1, 1, 1); PG8_SCHED; PG8_LDA(At, 1, 0); PG8_STAGE(PG8_SA(0, 1), a2 + hstepA, voffA);
            PG8_WAIT_V(8); PG8_WAIT_L(0); PG8_BAR; PG8_MMA(0, 0, At, B0); PG8_MMA(0, 1, At, B1); PG8_BAR; PG8_SCHED;
            PG8_LDA(At, 1, 1); PG8_STAGE(PG8_SB(1, 0), b3, voffB); PG8_STAGE(PG8_SB(1, 1), b3 + hstepB, voffB); PG8_STAGE(PG8_SA(1, 0), a3, voffA);
            PG8_WAIT_V(8); PG8_WAIT_L(0); PG8_BAR; PG8_MMA(1, 0, At, B0); PG8_MMA(1, 1, At, B1); PG8_BAR; PG8_SCHED;
            } else {
            PG8_LDB(B0, 0, 0); PG8_SCHED; PG8_LDA(At, 0, 0); PG8_STAGE(PG8_SA(1, 1), a1 + hstepA, voffA);
            PG8_WAIT_L(8); PG8_BAR; PG8_WAIT_L(0); PG8_MMA(0, 0, At, B0); PG8_BAR; PG8_SCHED;
            PG8_LDB(B1, 0, 1); PG8_STAGE(PG8_SB(0, 0), b2, voffB);
            PG8_BAR; PG8_WAIT_L(0); PG8_MMA(0, 1, At, B1); PG8_BAR;
            PG8_LDA(At, 0, 1); PG8_STAGE(PG8_SA(0, 0), a2, voffA);
            PG8_BAR; PG8_WAIT_L(0); PG8_MMA(1, 0, At, B0); PG8_BAR; PG8_SCHED;
            PG8_STAGE(PG8_SB(0, 1), b2 + hstepB, voffB);
            PG8_WAIT_V(6); PG8_BAR; PG8_MMA(1, 1, At, B1); PG8_BAR;
            PG8_LDB(B0, 1, 0); PG8_SCHED; PG8_LDA(At, 1, 0); PG8_STAGE(PG8_SA(0, 1), a2 + hstepA, voffA);
            PG8_WAIT_L(8); PG8_BAR; PG8_WAIT_L(0); PG8_MMA(0, 0, At, B0); PG8_BAR; PG8_SCHED;
            PG8_LDB(B1, 1, 1); PG8_STAGE(PG8_SB(1, 0), b3, voffB);
            PG8_BAR; PG8_WAIT_L(0); PG8_MMA(0, 1, At, B1); PG8_BAR;
            PG8_LDA(At, 1, 1); PG8_STAGE(PG8_SA(1, 0), a3, voffA);
            PG8_BAR; PG8_WAIT_L(0); PG8_MMA(1, 0, At, B0); PG8_BAR; PG8_SCHED;
            PG8_STAGE(PG8_SB(1, 1), b3 + hstepB, voffB);
            PG8_WAIT_V(6); PG8_BAR; PG8_MMA(1, 1, At, B1); PG8_BAR;
            }
        }
        if constexpr (ALIGN_EPI) { if (wr == 0) PG8_BAR; }
        E(acc, cur, wr, wc, fr, fq);
        if (!has_next) break;
#pragma unroll
        for (int a = 0; a < 2; ++a)
#pragma unroll
            for (int b = 0; b < 2; ++b)
#pragma unroll
                for (int m = 0; m < 4; ++m)
#pragma unroll
                    for (int n = 0; n < 2; ++n) acc[a][b][m][n] = (f32x4){0.f, 0.f, 0.f, 0.f};
        cur = nxt; cA = nA; cB = nB; ++ui;
        if constexpr (ALIGN_EPI) { if (wr == 1) PG8_BAR; }
    }
    PG8_WAIT_V(0);
    if constexpr (!ALIGN_EPI) { if (wr == 0) PG8_BAR; }
    PG8_BAR;
#undef PG8_SA
#undef PG8_SB
#undef PG8_STAGE
#undef PG8_LDA
#undef PG8_LDB
#undef PG8_MMA
#undef PG8_WAIT_V
#undef PG8_WAIT_L
#undef PG8_BAR
#undef PG8_SCHED
}
}

using pg8::bf16_t; using pg8::f32x4; using pg8::f32x2; using pg8::u32x4; using pg8::u32x2; using pg8::bf16x8; using pg8::cvt_pk_bf16;
#define LAS __attribute__((address_space(3)))

__device__ __forceinline__ int batch_of(int r) { return r < MP ? (r >> 12) : 8 + ((r - MP) >> 14); }
__device__ __forceinline__ float wave_sum(float v) {
#pragma unroll
    for (int o = 1; o < 64; o <<= 1) v += __shfl_xor(v, o);
    return v;
}
__device__ __forceinline__ float bf_lo(unsigned w) { return __uint_as_float(w << 16); }
__device__ __forceinline__ float bf_hi(unsigned w) { return __uint_as_float(w & 0xffff0000u); }
__device__ __forceinline__ float row_rstd(const float* rss, int row, int fq) {
    const f32x4 p = *(const f32x4*)(rss + (size_t)row * 16 + 4 * fq);
    float s = (p[0] + p[1]) + (p[2] + p[3]);
    s += __shfl_xor(s, 16); s += __shfl_xor(s, 32);
    return rsqrtf(s * (1.0f / D) + EPS);
}

__device__ __forceinline__ void rows_rstd8(const float* rss, int row0, int fq, float (&rs)[8]) {
    f32x4 pr[8];
#pragma unroll
    for (int i = 0; i < 8; ++i) pr[i] = *(const f32x4*)(rss + (size_t)(row0 + (i >> 2) * 128 + (i & 3) * 16) * 16 + 4 * fq);
#pragma unroll
    for (int i = 0; i < 8; ++i) { float t = (pr[i][0] + pr[i][1]) + (pr[i][2] + pr[i][3]); t += __shfl_xor(t, 16); t += __shfl_xor(t, 32); rs[i] = rsqrtf(t * (1.0f / D) + EPS); }
}
__device__ __forceinline__ void rows_rstd8_lds(const LAS unsigned char* xl, int lrow0, int fq, float (&rs)[8]) {
#pragma unroll
    for (int i = 0; i < 8; ++i) { const f32x4 p = *(const LAS f32x4*)(xl + (lrow0 + (i >> 2) * 128 + (i & 3) * 16) * 64 + 16 * fq);
        float t = (p[0] + p[1]) + (p[2] + p[3]); t += __shfl_xor(t, 16); t += __shfl_xor(t, 32); rs[i] = rsqrtf(t * (1.0f / D) + EPS); }
}
struct EpiUp {
    static constexpr bool PERM = true, PRE = true;
    bf16_t* H; const float* rss; const float* S; int rowbase; LAS unsigned char* xl;
    __device__ __forceinline__ void pre(const pg8::Unit& u, const char*& rsrc, const char*& ssrc) const {
        rsrc = (const char*)(rss + (size_t)(rowbase + u.pm * 256) * 16); ssrc = (const char*)(S + (size_t)batch_of(rowbase + u.pm * 256) * NUP + u.pn * 256); }
    __device__ __forceinline__ void operator()(const f32x4 (&acc)[2][2][4][2], const pg8::Unit& u, int wr, int wc, int fr_, int fq_) const {
        const int lane_ = pg8::lane_id_v(); const int fr = lane_ & 15, fq = lane_ >> 4;
        const int lrow0 = u.pm * 256 + wr * 64 + fr;
        const int b = batch_of(rowbase + u.pm * 256);
        f32x4 sv[2][2];
#pragma unroll
        for (int bj = 0; bj < 2; ++bj)
#pragma unroll
            for (int n = 0; n < 2; ++n) sv[bj][n] = *(const LAS f32x4*)(xl + 16384 + (bj * 128 + wc * 32 + 8 * fq + 4 * n) * 4);
        float rs8[8]; rows_rstd8_lds(xl, wr * 64 + fr, fq, rs8);
        const int hcol = u.pn * 128 + wc * 32 + 8 * fq;
#pragma unroll
        for (int ai = 0; ai < 2; ++ai)
#pragma unroll
            for (int m = 0; m < 4; ++m) {
                const int lr = lrow0 + ai * 128 + m * 16;
                const float rs = rs8[ai * 4 + m];
                const f32x4 g0 = acc[ai][0][m][0] * rs + sv[0][0], g1 = acc[ai][0][m][1] * rs + sv[0][1];
                const f32x4 u0 = acc[ai][1][m][0] * rs + sv[1][0], u1 = acc[ai][1][m][1] * rs + sv[1][1];
                const f32x2 ha = pg8::silu_mul_pk((f32x2){g0[0], g0[1]}, (f32x2){u0[0], u0[1]}), hb = pg8::silu_mul_pk((f32x2){g0[2], g0[3]}, (f32x2){u0[2], u0[3]});
                const f32x2 hc = pg8::silu_mul_pk((f32x2){g1[0], g1[1]}, (f32x2){u1[0], u1[1]}), hd = pg8::silu_mul_pk((f32x2){g1[2], g1[3]}, (f32x2){u1[2], u1[3]});
                u32x4 w; w.x = cvt_pk_bf16(ha.x, ha.y); w.y = cvt_pk_bf16(hb.x, hb.y); w.z = cvt_pk_bf16(hc.x, hc.y); w.w = cvt_pk_bf16(hd.x, hd.y);
                *(u32x4*)(H + (size_t)lr * FF + hcol) = w;
            }
    }
};

#ifndef RES_DEPTH
#define RES_DEPTH 3
#endif
struct EpiRes {
    static constexpr bool PERM = false, PRE = false;
    __device__ __forceinline__ void pre(const pg8::Unit&, const char*&, const char*&) const {}
    const float* xp; const float* xs; int first;
    float* out; bf16_t* xg; float* rss; const float* gate; const float* gm; float coef; int rowbase; int dostore;
    __device__ __forceinline__ void operator()(const f32x4 (&acc)[2][2][4][2], const pg8::Unit& u, int wr, int wc, int fr_, int fq_) const {
        const int lane_ = pg8::lane_id_v(); const int fr = lane_ & 15, fq = lane_ >> 4;
        const int grow0 = rowbase + u.pm * 256 + wr * 64 + fr;
        const int b = batch_of(rowbase + u.pm * 256);
        const int col0 = u.pn * 256 + wc * 32 + 4 * fq;
        const float* rp0 = (first ? (grow0 < MP ? xp + (size_t)grow0 * D : xs + (size_t)(grow0 - MP) * D) : out + (size_t)grow0 * D) + col0;
        f32x4 xi[RES_DEPTH][4];
#pragma unroll
        for (int r = 0; r < RES_DEPTH; ++r)
#pragma unroll
            for (int q = 0; q < 4; ++q) xi[r][q] = *(const f32x4*)(rp0 + (size_t)((r >> 2) * 128 + (r & 3) * 16) * D + (q >> 1) * 128 + (q & 1) * 16);
        const float* gp = gate + (size_t)b * NMOD + col0;
        f32x4 gv[2][2], mv[2][2];
#pragma unroll
        for (int bj = 0; bj < 2; ++bj)
#pragma unroll
            for (int n = 0; n < 2; ++n) { gv[bj][n] = *(const f32x4*)(gp + bj * 128 + n * 16) * coef;
                mv[bj][n] = gm ? *(const f32x4*)(gm + b * D + col0 + bj * 128 + n * 16) : (f32x4){0.f, 0.f, 0.f, 0.f}; }
#pragma unroll
        for (int r = 0; r < 8; ++r) {
            const int ai = r >> 2, m = r & 3;
            const int grow = grow0 + ai * 128 + m * 16;
            f32x4 xo[4];
#pragma unroll
            for (int q = 0; q < 4; ++q) xo[q] = xi[r % RES_DEPTH][q] + gv[q >> 1][q & 1] * acc[ai][q >> 1][m][q & 1];
            if (r + RES_DEPTH < 8) {
                const int r2 = r + RES_DEPTH;
#pragma unroll
                for (int q = 0; q < 4; ++q) xi[r % RES_DEPTH][q] = *(const f32x4*)(rp0 + (size_t)((r2 >> 2) * 128 + (r2 & 3) * 16) * D + (q >> 1) * 128 + (q & 1) * 16);
            }
            float ss = 0.f;
#pragma unroll
            for (int q = 0; q < 4; ++q) {
                const int c = col0 + (q >> 1) * 128 + (q & 1) * 16;
                if (dostore) *(f32x4*)(out + (size_t)grow * D + c) = xo[q];
                ss += (xo[q][0] * xo[q][0] + xo[q][1] * xo[q][1]) + (xo[q][2] * xo[q][2] + xo[q][3] * xo[q][3]);
                if (gm && dostore) { const f32x4 o = xo[q] * mv[q >> 1][q & 1]; u32x2 w; w.x = cvt_pk_bf16(o[0], o[1]); w.y = cvt_pk_bf16(o[2], o[3]); *(u32x2*)(xg + (size_t)grow * D + c) = w; }
            }
            ss += __shfl_xor(ss, 16); ss += __shfl_xor(ss, 32);
            if (fq == 0 && dostore) rss[(size_t)grow * 16 + u.pn * 4 + wc] = ss;
        }
    }
};

struct EpiMixIn {
    static constexpr bool PERM = true, PRE = true;
    bf16_t* Z; const float* rss; const float* S; float* vst; LAS unsigned char* xl;
    __device__ __forceinline__ void pre(const pg8::Unit& u, const char*& rsrc, const char*& ssrc) const {
        rsrc = (const char*)(rss + (size_t)(u.pm * 256) * 16); ssrc = (const char*)(S + (size_t)batch_of(u.pm * 256) * DIN + u.pn * 256); }
    __device__ __forceinline__ void operator()(const f32x4 (&acc)[2][2][4][2], const pg8::Unit& u, int wr, int wc, int fr_, int fq_) const {
        const int lane_ = pg8::lane_id_v(); const int fr = lane_ & 15, fq = lane_ >> 4;
        const int row0 = u.pm * 256 + wr * 64 + fr;
        const int b = batch_of(u.pm * 256);
        f32x4 sv[2][2];
#pragma unroll
        for (int bj = 0; bj < 2; ++bj)
#pragma unroll
            for (int n = 0; n < 2; ++n) sv[bj][n] = *(const LAS f32x4*)(xl + 16384 + (bj * 128 + wc * 32 + 8 * fq + 4 * n) * 4);
        float rs8[8]; rows_rstd8_lds(xl, wr * 64 + fr, fq, rs8);
        const int pn = u.pn;
        const int lc = wc * 32 + 8 * fq;
#pragma unroll
        for (int ai = 0; ai < 2; ++ai)
#pragma unroll
            for (int m = 0; m < 4; ++m) {
                const int row = row0 + ai * 128 + m * 16;
                const float rs = rs8[ai * 4 + m];
                f32x4 v00 = acc[ai][0][m][0] * rs + sv[0][0], v01 = acc[ai][0][m][1] * rs + sv[0][1];
                f32x4 v10 = acc[ai][1][m][0] * rs + sv[1][0], v11 = acc[ai][1][m][1] * rs + sv[1][1];
                bf16_t* zr = Z + (size_t)row * ZW;
                if (pn >= 2 && pn < 6) {
                    const f32x4 o0 = v00 * v10, o1 = v01 * v11;
                    u32x4 w; w.x = cvt_pk_bf16(o0[0], o0[1]); w.y = cvt_pk_bf16(o0[2], o0[3]); w.z = cvt_pk_bf16(o1[0], o1[1]); w.w = cvt_pk_bf16(o1[2], o1[3]);
                    *(u32x4*)(zr + 1024 + (pn - 2) * 128 + lc) = w;
                } else {
                    int cbase = pn * 256;
                    if (pn >= 6) {
                        v00 = pg8::gelu4(v00); v01 = pg8::gelu4(v01); v10 = pg8::gelu4(v10); v11 = pg8::gelu4(v11);
                        cbase = pn < 8 ? 512 + (pn - 6) * 256 : 1536 + (pn - 8) * 256;
                    }
                    u32x4 w0, w1;
                    w0.x = cvt_pk_bf16(v00[0], v00[1]); w0.y = cvt_pk_bf16(v00[2], v00[3]); w0.z = cvt_pk_bf16(v01[0], v01[1]); w0.w = cvt_pk_bf16(v01[2], v01[3]);
                    w1.x = cvt_pk_bf16(v10[0], v10[1]); w1.y = cvt_pk_bf16(v10[2], v10[3]); w1.z = cvt_pk_bf16(v11[0], v11[1]); w1.w = cvt_pk_bf16(v11[2], v11[3]);
                    *(u32x4*)(zr + cbase + lc) = w0;
                    *(u32x4*)(zr + cbase + 128 + lc) = w1;
                    if (pn >= 8) {
                        const f32x4 s4 = (v00 + v01) + (v10 + v11);
                        const f32x4 q4 = (v00 * v00 + v01 * v01) + (v10 * v10 + v11 * v11);
                        float s1 = (s4[0] + s4[1]) + (s4[2] + s4[3]), s2 = (q4[0] + q4[1]) + (q4[2] + q4[3]);
                        s1 += __shfl_xor(s1, 16); s1 += __shfl_xor(s1, 32); s2 += __shfl_xor(s2, 16); s2 += __shfl_xor(s2, 32);
                        if (fq == 0) *(f32x2*)(vst + (size_t)row * 16 + ((pn - 8) * 4 + wc) * 2) = (f32x2){s1, s2};
                    }
                }
            }
    }
};

struct Args {
    const float* xp; const float* xs; const float* cp; const float* cs; const float* ada_w; const float* ada_b; const float* norm_g;
    const float* ffn_w1; const float* ffn_w2; const float* mix_w_in; const float* conv_w; const float* sg_norm_g; const float* sg_ws;
    const float* sg_bs; const float* grp_g; const float* mix_w_out; const float* final_g;
    float* out; unsigned char* ws; int ph_lo, ph_hi;
};

__device__ __forceinline__ unsigned f2bf(float f) { unsigned u = __float_as_uint(f); return (u + 0x7fffu + ((u >> 16) & 1u)) >> 16; }
__device__ __forceinline__ unsigned pk2(float lo, float hi) { return f2bf(lo) | (f2bf(hi) << 16); }

__device__ __forceinline__ int map_col(int mode, int s) {
    if (mode == 1) { const int bj = s >= FF ? 1 : 0, h = s - bj * FF; return 256 * (h >> 7) + 128 * bj + (h & 127); }
    if (mode == 2) { if (s >= 512 && s < 1024) { const int q = s - 512; return 512 + 256 * (q >> 7) + (q & 127); }
                     if (s >= 1024 && s < 1536) { const int q = s - 1024; return 512 + 256 * (q >> 7) + 128 + (q & 127); } }
    return s;
}
__device__ __forceinline__ void transpose_item(const float* W, int K, int N, bf16_t* WT, int mode, LAS float* scr, int item, int lane) {
    const int nblk = N / 32, kb = item / nblk, nb = item % nblk, k0 = 64 * kb, n0 = 32 * nb, dn0 = map_col(mode, n0);
    float tv[32];
#pragma unroll
    for (int i = 0; i < 32; ++i) { const int kk = 2 * i + (lane >> 5); tv[i] = W[(size_t)(k0 + kk) * N + n0 + (lane & 31)]; }
#pragma unroll
    for (int i = 0; i < 32; ++i) { const int kk = 2 * i + (lane >> 5); scr[kk * 33 + (lane & 31)] = tv[i]; }
    asm volatile("s_waitcnt lgkmcnt(0)" ::: "memory");
    const int c = lane & 7;
#pragma unroll
    for (int j = 0; j < 4; ++j) { const int n = (lane >> 3) + 8 * j; const LAS float* s = scr + (8 * c) * 33 + n;
        u32x4 o; o.x = pk2(s[0 * 33], s[1 * 33]); o.y = pk2(s[2 * 33], s[3 * 33]); o.z = pk2(s[4 * 33], s[5 * 33]); o.w = pk2(s[6 * 33], s[7 * 33]);
        *(u32x4*)(WT + (size_t)(dn0 + n) * K + k0 + 8 * c) = o; }
    asm volatile("s_waitcnt lgkmcnt(0)" ::: "memory");
}

__device__ __forceinline__ void phase_p0a(const Args& a, LAS unsigned char* lds, int bid, int G, int wave) {
    const int lane = pg8::lane_id_v(), tid = wave * 64 + lane;
    LAS float* sc = (LAS float*)lds;
    LAS float* scr = (LAS float*)(lds + 49152 + wave * 10240);
    float* mod = (float*)(a.ws + WS_MOD);
    if (bid < 288) {
        for (int i = tid; i < NBATCH * D; i += NTHREADS) { const int b = i >> 10, k = i & 1023; const float c = b < 8 ? a.cp[b * D + k] : a.cs[(b - 8) * D + k]; sc[i] = c / (1.0f + __expf(-c)); }
        __syncthreads();
        for (int it = bid; it < 288; it += G) {
            const int l = it / 144, n0 = (it % 144) * 64;
            const float* W = a.ada_w + (size_t)l * D * NMOD + n0 + lane;
            float acc[NBATCH];
#pragma unroll
            for (int b = 0; b < NBATCH; ++b) acc[b] = 0.f;
#pragma unroll 16
            for (int kk = 0; kk < 128; ++kk) { const int k = wave * 128 + kk; const float w = W[(size_t)k * NMOD];
#pragma unroll
                for (int b = 0; b < NBATCH; ++b) acc[b] += sc[b * D + k] * w; }
#pragma unroll
            for (int b = 0; b < NBATCH; ++b) scr[b * 64 + lane] = acc[b];
            __syncthreads();
            for (int i = tid; i < NBATCH * 64; i += NTHREADS) { const int b = i >> 6, c = i & 63; float s = 0.f;
#pragma unroll
                for (int w = 0; w < NWAVES; ++w) s += ((LAS float*)(lds + 49152 + w * 10240))[b * 64 + c];
                mod[((size_t)l * NBATCH + b) * NMOD + n0 + c] = s + a.ada_b[(size_t)l * NMOD + n0 + c]; }
            __syncthreads();
        }
    }
    const int gw = bid * NWAVES + wave, NGW = G * NWAVES;
    constexpr int I_W1 = (D / 64) * (NUP / 32), I_W2 = (FF / 64) * (D / 32), I_WIN = (D / 64) * (DIN / 32), I_WOUT = (D / 64) * (D / 32);
    constexpr int NITEMS = 4 * I_W1 + 4 * I_W2 + 2 * I_WIN + 2 * I_WOUT;
    for (int it = gw; it < NITEMS; it += NGW) {
        int r = it;
        if (r < 4 * I_W1) { const int mi = r / I_W1; transpose_item(a.ffn_w1 + (size_t)mi * D * NUP, D, NUP, (bf16_t*)(a.ws + WS_W1T) + (size_t)mi * NUP * D, 1, scr, r % I_W1, lane); continue; } r -= 4 * I_W1;
        if (r < 4 * I_W2) { const int mi = r / I_W2; transpose_item(a.ffn_w2 + (size_t)mi * FF * D, FF, D, (bf16_t*)(a.ws + WS_W2T) + (size_t)mi * D * FF, 0, scr, r % I_W2, lane); continue; } r -= 4 * I_W2;
        if (r < 2 * I_WIN) { const int mi = r / I_WIN; transpose_item(a.mix_w_in + (size_t)mi * D * DIN, D, DIN, (bf16_t*)(a.ws + WS_WINT) + (size_t)mi * DIN * D, 2, scr, r % I_WIN, lane); continue; } r -= 2 * I_WIN;
        { const int mi = r / I_WOUT; transpose_item(a.mix_w_out + (size_t)mi * D * D, D, D, (bf16_t*)(a.ws + WS_WOUTT) + (size_t)mi * D * D, 0, scr, r % I_WOUT, lane); }
    }
    { const f32x4* src = (const f32x4*)a.sg_ws; u32x2* dst = (u32x2*)(a.ws + WS_WSG);
      for (int i = bid * NTHREADS + tid; i < 2 * 8 * 128 * 128 / 4; i += G * NTHREADS) { const f32x4 v = src[i]; u32x2 w; w.x = pk2(v[0], v[1]); w.y = pk2(v[2], v[3]); dst[i] = w; } }
}

__device__ __forceinline__ void phase_p0b(const Args& a, LAS unsigned char* lds, int bid, int G, int wave) {
    const int lane = pg8::lane_id_v(), tid = wave * 64 + lane;
    const float* mod = (const float*)(a.ws + WS_MOD);
    float* gmt = (float*)(a.ws + WS_GM);
    for (int i = bid * NTHREADS + tid; i < 6 * NBATCH * D; i += G * NTHREADS) {
        const int d = i & 1023, b = (i >> 10) % NBATCH, lk = i / (NBATCH * D), l = lk / 3, k = lk % 3;
        gmt[i] = a.norm_g[(l * 3 + k) * D + d] * (1.0f + mod[((size_t)l * NBATCH + b) * NMOD + (3 * k + 1) * D + d]);
    }
    const int gw = bid * NWAVES + wave, NGW = G * NWAVES;
    for (int t = gw; t < 2 * 864; t += NGW) {
        const int l = t / 864, r = t % 864;
        int k, tile; if (r < 352) { k = 0; tile = r; } else if (r < 512) { k = 1; tile = r - 352; } else { k = 2; tile = r - 512; }
        const int Nk = (k == 1) ? DIN : NUP;
        const bf16_t* WT = (k == 1) ? (const bf16_t*)(a.ws + WS_WINT) + (size_t)l * DIN * D : (const bf16_t*)(a.ws + WS_W1T) + (size_t)(l * 2 + (k == 2 ? 1 : 0)) * NUP * D;
        float* Sout = (float*)(a.ws + WS_SV) + (size_t)l * SV_LAYER + (k == 0 ? 0 : (k == 1 ? NBATCH * NUP : NBATCH * (NUP + DIN)));
        const int p0 = tile * 16, ii = lane & 15, kq = lane >> 4;
        const bf16_t* xrow = WT + (size_t)(p0 + ii) * D + kq * 8;
        const float* yrow = mod + ((size_t)l * NBATCH + (ii < NBATCH ? ii : 0)) * NMOD + (3 * k) * D + kq * 8;
        const float ymask = ii < NBATCH ? 1.0f : 0.0f;
        f32x4 sacc = (f32x4){0.f, 0.f, 0.f, 0.f};
#pragma unroll 8
        for (int ks = 0; ks < 32; ++ks) {
            const bf16x8 xf = *(const bf16x8*)(xrow + ks * 32);
            const f32x4 y0 = *(const f32x4*)(yrow + ks * 32) * ymask, y1 = *(const f32x4*)(yrow + ks * 32 + 4) * ymask;
            u32x4 yp; yp.x = cvt_pk_bf16(y0[0], y0[1]); yp.y = cvt_pk_bf16(y0[2], y0[3]); yp.z = cvt_pk_bf16(y1[0], y1[1]); yp.w = cvt_pk_bf16(y1[2], y1[3]);
            sacc = __builtin_amdgcn_mfma_f32_16x16x32_bf16(xf, __builtin_bit_cast(bf16x8, yp), sacc, 0, 0, 0);
        }
        if (ii < NBATCH) *(f32x4*)(Sout + (size_t)ii * Nk + p0 + 4 * kq) = sacc;
    }
    const float* gm0 = nullptr; (void)gm0;
    bf16_t* xg = (bf16_t*)(a.ws + WS_XG); float* rss = (float*)(a.ws + WS_RSS);
#pragma unroll 2
    for (int r = gw; r < MTOT; r += NGW) {
        const int b = batch_of(r);
        const float* xr = r < MP ? a.xp + (size_t)r * D : a.xs + (size_t)(r - MP) * D;
        float ss = 0.f; f32x4 v[4];
#pragma unroll
        for (int j = 0; j < 4; ++j) { v[j] = *(const f32x4*)(xr + 4 * lane + 256 * j); ss += (v[j][0] * v[j][0] + v[j][1] * v[j][1]) + (v[j][2] * v[j][2] + v[j][3] * v[j][3]); }
        ss = wave_sum(ss);
        if (lane < 16) rss[(size_t)r * 16 + lane] = lane == 0 ? ss : 0.f;
#pragma unroll
        for (int j = 0; j < 4; ++j) { const int d = 4 * lane + 256 * j;
            const f32x4 g = *(const f32x4*)(a.norm_g + d); const f32x4 sc = *(const f32x4*)(mod + (size_t)b * NMOD + D + d);
            const f32x4 o = v[j] * (g * (sc + 1.0f));
            u32x2 w; w.x = cvt_pk_bf16(o[0], o[1]); w.y = cvt_pk_bf16(o[2], o[3]); *(u32x2*)(xg + (size_t)r * D + d) = w; }
    }
}

__device__ __forceinline__ void phase_final(const Args& a, int bid, int G, int wave) {
    const int lane = pg8::lane_id_v();
    const int gw = bid * NWAVES + wave, NGW = G * NWAVES;
    const float* rss = (const float*)(a.ws + WS_RSS);
    f32x4 fg[4];
#pragma unroll
    for (int j = 0; j < 4; ++j) fg[j] = *(const f32x4*)(a.final_g + 4 * lane + 256 * j);
    for (int r = gw; r < MTOT; r += NGW) {
        float s = rss[(size_t)r * 16 + (lane & 15)];
        s += __shfl_xor(s, 1); s += __shfl_xor(s, 2); s += __shfl_xor(s, 4); s += __shfl_xor(s, 8);
        const float rs = rsqrtf(s * (1.0f / D) + EPS);
        float* xr = a.out + (size_t)r * D;
#pragma unroll
        for (int j = 0; j < 4; ++j) { f32x4 v = *(const f32x4*)(xr + 4 * lane + 256 * j); v = v * rs * fg[j]; *(f32x4*)(xr + 4 * lane + 256 * j) = v; }
    }
}

__device__ __forceinline__ bool seq_start(int t) { return t < MP ? (t & 4095) == 0 : (t & 16383) == 0; }
__device__ __forceinline__ void unpack8(const u32x4 w, float (&f)[8]) {
#pragma unroll
    for (int j = 0; j < 4; ++j) { f[2 * j] = bf_lo(w[j]); f[2 * j + 1] = bf_hi(w[j]); }
}
constexpr int VT_LD = 136;
__device__ __forceinline__ void phase_mixer(const Args& a, LAS unsigned char* lds, int l, int bid, int G, int dostore, int wave) {
    const int lane = pg8::lane_id_v(), tid = wave * 64 + lane, fr = lane & 15, fq = lane >> 4;
    bf16_t* Z = (bf16_t*)(a.ws + WS_ZH);
    const float* vst = (const float*)(a.ws + WS_VST);
    const float* convw = a.conv_w + (size_t)l * 3 * 512;
    const float* sgn = a.sg_norm_g + (size_t)l * 512;
    const bf16_t* wsg = (const bf16_t*)(a.ws + WS_WSG) + (size_t)l * 8 * 128 * 128;
    const float* sgb = a.sg_bs + (size_t)l * 8 * 128;
    const float* gg = a.grp_g + (size_t)l * 1024;
    LAS f32x2* st = (LAS f32x2*)lds;
    LAS bf16_t* vT = (LAS bf16_t*)(lds + 1024);
    for (int ch = bid; ch < MTOT / 128; ch += G) {
        const int r0 = ch * 128;
        if (tid < 128) {
            const f32x4* p = (const f32x4*)(vst + (size_t)(r0 + tid) * 16); float s1 = 0.f, s2 = 0.f;
#pragma unroll
            for (int i = 0; i < 4; ++i) { const f32x4 v = p[i]; s1 += v[0] + v[2]; s2 += v[1] + v[3]; }
            const float mean = s1 * (1.0f / 512.0f); const float var = fmaxf(s2 * (1.0f / 512.0f) - mean * mean, 0.f);
            st[tid] = (f32x2){mean, rsqrtf(var + EPS)};
        }
        {
            const int t0 = r0 + 16 * wave, c0 = 8 * lane;
            float w0[8], w1[8], w2[8], g8[8];
#pragma unroll
            for (int j = 0; j < 8; ++j) { w0[j] = convw[c0 + j]; w1[j] = convw[512 + c0 + j]; w2[j] = convw[1024 + c0 + j]; g8[j] = gg[c0 + j]; }
            float prev[8], cur[8], nxt[8];
            { u32x4 w = (u32x4){0u, 0u, 0u, 0u}; if (!seq_start(t0)) w = *(const u32x4*)(Z + (size_t)(t0 - 1) * ZW + 1024 + c0); unpack8(w, prev); }
            { const u32x4 w = *(const u32x4*)(Z + (size_t)t0 * ZW + 1024 + c0); unpack8(w, cur); }
#pragma unroll 4
            for (int i = 0; i < 16; ++i) {
                const int t = t0 + i;
                { u32x4 w = (u32x4){0u, 0u, 0u, 0u}; if (!(t + 1 >= MTOT || seq_start(t + 1))) w = *(const u32x4*)(Z + (size_t)(t + 1) * ZW + 1024 + c0); unpack8(w, nxt); }
                float bg[8]; { const u32x4 w = *(const u32x4*)(Z + (size_t)t * ZW + c0); unpack8(w, bg); }
                float y[8]; float ss = 0.f;
#pragma unroll
                for (int j = 0; j < 8; ++j) { y[j] = bg[j] * (w0[j] * prev[j] + w1[j] * cur[j] + w2[j] * nxt[j]); ss += y[j] * y[j]; }
                ss = wave_sum(ss);
                const float rs = rsqrtf(ss * (1.0f / 512.0f) + EPS);
                u32x4 o;
                o.x = cvt_pk_bf16(y[0] * rs * g8[0], y[1] * rs * g8[1]); o.y = cvt_pk_bf16(y[2] * rs * g8[2], y[3] * rs * g8[3]);
                o.z = cvt_pk_bf16(y[4] * rs * g8[4], y[5] * rs * g8[5]); o.w = cvt_pk_bf16(y[6] * rs * g8[6], y[7] * rs * g8[7]);
                if (dostore) *(u32x4*)(Z + (size_t)t * ZW + c0) = o;
#pragma unroll
                for (int j = 0; j < 8; ++j) { prev[j] = cur[j]; cur[j] = nxt[j]; }
            }
        }
        __syncthreads();
        f32x4 acc[8][4];
        float ss = 0.f;
        const int prow = 16 * wave + fr;
        const int sq = tid >> 3, sdc = tid & 7;
        u32x4 vw[2]; bf16x8 wf[4];
#pragma unroll
        for (int i = 0; i < 2; ++i) vw[i] = *(const u32x4*)(Z + (size_t)(r0 + sq + 64 * i) * ZW + 1536 + sdc * 8);
#pragma unroll
        for (int ks = 0; ks < 4; ++ks) wf[ks] = *(const bf16x8*)(wsg + ((size_t)prow) * 128 + fq * 8 + 32 * ks);
#pragma unroll
        for (int h = 0; h < 8; ++h) {
            LAS bf16_t* vb = vT + (h & 1) * 64 * VT_LD;
            const f32x4 ga = *(const f32x4*)(sgn + h * 64 + sdc * 8), gb = *(const f32x4*)(sgn + h * 64 + sdc * 8 + 4);
#pragma unroll
            for (int i = 0; i < 2; ++i) {
                const int q = sq + 64 * i;
                float f[8]; unpack8(vw[i], f);
                const f32x2 ms = st[q];
                const int qs = (((q >> 3) ^ sdc) << 3) | (q & 7);
#pragma unroll
                for (int j = 0; j < 8; ++j) { const float gj = j < 4 ? ga[j] : gb[j - 4]; const float vn = (f[j] - ms.x) * ms.y * gj; vb[(sdc * 8 + j) * VT_LD + qs] = (bf16_t)f2bf(vn); }
            }
            bf16x8 wcur[4];
#pragma unroll
            for (int ks = 0; ks < 4; ++ks) wcur[ks] = wf[ks];
            u32x2 uw[4];
#pragma unroll
            for (int nd = 0; nd < 4; ++nd) uw[nd] = *(const u32x2*)(Z + (size_t)(r0 + prow) * ZW + 512 + h * 64 + 16 * nd + 4 * fq);
            const float bias = sgb[h * 128 + prow];
            if (h + 1 < 8) {
#pragma unroll
                for (int i = 0; i < 2; ++i) vw[i] = *(const u32x4*)(Z + (size_t)(r0 + sq + 64 * i) * ZW + 1536 + (h + 1) * 64 + sdc * 8);
#pragma unroll
                for (int ks = 0; ks < 4; ++ks) wf[ks] = *(const bf16x8*)(wsg + ((size_t)((h + 1) * 128 + prow)) * 128 + fq * 8 + 32 * ks);
            }
            __syncthreads();
#pragma unroll
            for (int nd = 0; nd < 4; ++nd) {
                f32x4 c = (f32x4){0.f, 0.f, 0.f, 0.f};
                const int rowv = 16 * nd + fr, sw = (rowv >> 3) & 7;
#pragma unroll
                for (int ks = 0; ks < 4; ++ks) {
                    const bf16x8 vf = *(const LAS bf16x8*)(vb + rowv * VT_LD + (((fq + 4 * ks) ^ sw) << 3));
                    c = __builtin_amdgcn_mfma_f32_16x16x32_bf16(vf, wcur[ks], c, 0, 0, 0);
                }
                f32x4 y; y[0] = bf_lo(uw[nd].x) * (c[0] + bias); y[1] = bf_hi(uw[nd].x) * (c[1] + bias); y[2] = bf_lo(uw[nd].y) * (c[2] + bias); y[3] = bf_hi(uw[nd].y) * (c[3] + bias);
                ss += (y[0] * y[0] + y[1] * y[1]) + (y[2] * y[2] + y[3] * y[3]);
                acc[h][nd] = y;
            }
        }
        ss += __shfl_xor(ss, 16); ss += __shfl_xor(ss, 32);
        const float rs = rsqrtf(ss * (1.0f / 512.0f) + EPS);
#pragma unroll
        for (int h = 0; h < 8; ++h)
#pragma unroll
            for (int nd = 0; nd < 4; ++nd) {
                const int c = h * 64 + 16 * nd + 4 * fq;
                const f32x4 g = *(const f32x4*)(gg + 512 + c);
                const f32x4 o = acc[h][nd] * rs * g;
                u32x2 w; w.x = cvt_pk_bf16(o[0], o[1]); w.y = cvt_pk_bf16(o[2], o[3]);
                if (dostore) *(u32x2*)(Z + (size_t)(r0 + prow) * ZW + 512 + c) = w;
            }
        __syncthreads();
    }
}


#define XB_TMO      128
#define XB_XCNT(j)  (256  + 64 * (j))
#define XB_XSUB(j)  (1280 + 64 * (j))
#define XB_XGEN(j)  (2304 + 64 * (j))
#define XB_TOP      3328
#define XB_TOPGEN   3392
#define XCD_BAR_WORDS 3456
#define XB_SPIN_CAP (1u << 20)
__device__ __forceinline__ unsigned xb_ld(unsigned* p)              { return __hip_atomic_load(p, __ATOMIC_RELAXED, __HIP_MEMORY_SCOPE_AGENT); }
__device__ __forceinline__ unsigned xb_add(unsigned* p, unsigned v) { return __hip_atomic_fetch_add(p, v, __ATOMIC_RELAXED, __HIP_MEMORY_SCOPE_AGENT); }
__device__ __forceinline__ unsigned xb_xcc_id() { return (unsigned)__builtin_amdgcn_s_getreg((3 << 11) | 20) & 0xFu; }
#define XB_SPIN(cond, bar) do { unsigned _sp = 0; while (cond) { __builtin_amdgcn_s_sleep(1); \
    if ((++_sp & 255u) == 0u) { if (xb_ld(&(bar)[XB_TMO])) break; if (_sp > XB_SPIN_CAP) { atomicAdd(&(bar)[XB_TMO], 1u); break; } } } } while (0)
struct XcdBarrier { unsigned* bar; unsigned x; volatile LAS unsigned* st; };
__device__ __forceinline__ XcdBarrier xcd_barrier_post(unsigned* bar, volatile LAS unsigned* st, int wave) {
    XcdBarrier b; b.bar = bar; b.x = xb_xcc_id(); b.st = st;
    if (wave == 0 && pg8::lane_id_v() == 0) (void)xb_add(&bar[XB_XCNT(b.x)], 1u);
    return b;
}
__device__ __forceinline__ void xcd_barrier_complete(unsigned* bar, unsigned x, unsigned& nloc, unsigned& nx) {
    const unsigned G = gridDim.x * gridDim.y * gridDim.z;
    unsigned sum, cnt, mine, sp = 0u;
    for (;;) {
        sum = 0u; cnt = 0u; mine = 0u;
#pragma unroll
        for (unsigned j = 0; j < 16; ++j) { const unsigned c = xb_ld(&bar[XB_XCNT(j)]); sum += c; cnt += (c > 0u) ? 1u : 0u; mine = (j == x) ? c : mine; }
        if (sum == G) break;
        __builtin_amdgcn_s_sleep(1);
        if ((++sp & 255u) == 0u) { if (xb_ld(&bar[XB_TMO])) break; if (sp > XB_SPIN_CAP) { atomicAdd(&bar[XB_TMO], 1u); break; } }
    }
    nloc = mine > 0u ? mine : 1u; nx = cnt > 0u ? cnt : 1u;
}
__device__ __forceinline__ void xcd_barrier(const XcdBarrier& b, int wave) {
    asm volatile("s_waitcnt vmcnt(0)" ::: "memory");
    __syncthreads();
    if (wave == 0 && pg8::lane_id_v() == 0) {
        unsigned* bar = b.bar;
        __builtin_amdgcn_s_waitcnt(0);
        unsigned nloc = b.st[0], nx = b.st[1];
        if (nloc == 0u) { xcd_barrier_complete(bar, b.x, nloc, nx); b.st[0] = nloc; b.st[1] = nx; }
        const unsigned old = xb_add(&bar[XB_XSUB(b.x)], 1u);
        const unsigned gen = old / nloc;
        if (old + 1u == (gen + 1u) * nloc) {
            __builtin_amdgcn_fence(__ATOMIC_RELEASE, "agent");
            asm volatile("s_waitcnt vmcnt(0)" ::: "memory");
            const unsigned og = xb_add(&bar[XB_TOP], 1u);
            const unsigned tg = og / nx;
            if (og + 1u == (tg + 1u) * nx) xb_add(&bar[XB_TOPGEN], 1u);
            else XB_SPIN(xb_ld(&bar[XB_TOPGEN]) == tg, bar);
            __builtin_amdgcn_fence(__ATOMIC_ACQUIRE, "agent");
            xb_add(&bar[XB_XGEN(b.x)], 1u);
            asm volatile("s_waitcnt vmcnt(0)" ::: "memory");
        } else {
            XB_SPIN(xb_ld(&bar[XB_XGEN(b.x)]) == gen, bar);
            __builtin_amdgcn_fence(__ATOMIC_ACQUIRE, "agent");
            asm volatile("s_waitcnt vmcnt(0)" ::: "memory");
        }
    }
    __syncthreads();
}

__global__ void __launch_bounds__(NTHREADS, 2) fwd_megakernel(Args a) {
    extern __shared__ __attribute__((aligned(16))) unsigned char lds_raw[];
    LAS unsigned char* lds = (LAS unsigned char*)lds_raw;
    const int G = gridDim.x, bid = blockIdx.x;
    unsigned char* ws = a.ws;
    volatile LAS unsigned* bst = (volatile LAS unsigned*)(lds + 131072 + 512);
    if (threadIdx.x < 2) bst[threadIdx.x] = 0u;
    __syncthreads();
    XcdBarrier xbar; xbar.bar = (unsigned*)ws; xbar.x = 0; xbar.st = bst;
    const int wave = __builtin_amdgcn_readfirstlane(threadIdx.x >> 6);
    if (a.ph_hi - a.ph_lo > 1) xbar = xcd_barrier_post((unsigned*)ws, bst, wave);
    int ph0 = a.ph_lo;
    if (ph0 == 0 && a.ph_hi > 1) { phase_p0a(a, lds, bid, G, wave); cg::this_grid().sync(); ph0 = 1; }
#define GRID_SYNC(first) do { xcd_barrier(xbar, wave); } while (0)
    for (int ph = ph0; ph < a.ph_hi; ++ph) {
        int nrep = 1;
#if MK_PROBE == 1
        if (ph <= 1) nrep = 2;
#elif MK_PROBE == 2
        if (ph >= 2 && ph < NPHASES - 1) { const int s_ = (ph - 2) % 11; if (s_ == 0 || s_ == 2 || s_ == 7 || s_ == 9) nrep = 2; }
#elif MK_PROBE == 5
        if (ph >= 2 && ph < NPHASES - 1) { const int s_ = (ph - 2) % 11; if (s_ == 5) nrep = 2; }
#elif MK_PROBE == 6
        if (ph >= 2 && ph < NPHASES - 1) { const int s_ = (ph - 2) % 11; if (s_ == 1 || s_ == 3 || s_ == 6 || s_ == 8 || s_ == 10) nrep = 2; }
#elif MK_PROBE == 4
        if (ph >= 2 && ph < NPHASES - 1) { const int s_ = (ph - 2) % 11; if (s_ == 4) nrep = 2; }
#endif
        asm volatile("" : "+s"(nrep));
        for (int rep = 0; rep < nrep; ++rep) {
        int dostore = (rep + 1 == nrep) ? 1 : 0; dostore = __builtin_amdgcn_readfirstlane(dostore);
        if (ph == 0) phase_p0a(a, lds, bid, G, wave);
        else if (ph == 1) phase_p0b(a, lds, bid, G, wave);
        else if (ph == NPHASES - 1) phase_final(a, bid, G, wave);
        else {
            const int q = ph - 2, l = q / 11, s = q % 11;
            const float* mod_l = (const float*)(ws + WS_MOD) + (size_t)l * NBATCH * NMOD;
            const float* gmt = (const float*)(ws + WS_GM);
            const float* svl = (const float*)(ws + WS_SV) + (size_t)l * SV_LAYER;
            float* rss = (float*)(ws + WS_RSS);
            bf16_t* xg = (bf16_t*)(ws + WS_XG);
            bf16_t* zh = (bf16_t*)(ws + WS_ZH);
            if (s == 5) phase_mixer(a, lds, l, bid, G, dostore, wave);
            else if (s == 4) {
                pg8::Gemm g{xg, (const bf16_t*)(ws + WS_WINT) + (size_t)l * DIN * D, MTOT, DIN, D, D};
                pg8::StaticOrder S; S.init(MTOT, DIN, G, bid);
                EpiMixIn E{zh, rss, svl + NBATCH * NUP, (float*)(ws + WS_VST), lds + LDS_XOFF};
                pg8::gemm_phase<EpiMixIn, pg8::StaticOrder, true, true>(lds, g, S, E, wave);
            } else if (s == 6) {
                pg8::Gemm g{zh, (const bf16_t*)(ws + WS_WOUTT) + (size_t)l * D * D, MTOT, D, D, ZW};
                pg8::StaticOrder S; S.init(MTOT, D, G, bid);
                EpiRes E{a.xp, a.xs, 0, a.out, xg, rss, mod_l + 5 * D, gmt + (size_t)(l * 3 + 2) * NBATCH * D, 1.0f, 0, dostore};
                pg8::gemm_phase<EpiRes, pg8::StaticOrder, true, true>(lds, g, S, E, wave);
            } else {
                const int f = s >= 7 ? 1 : 0, s2 = f ? s - 7 : s, half = s2 >> 1, rowbase = half * MP;
                if ((s2 & 1) == 0) {
                    pg8::Gemm g{xg + (size_t)rowbase * D, (const bf16_t*)(ws + WS_W1T) + (size_t)(l * 2 + f) * NUP * D, MP, NUP, D, D};
                    pg8::StaticOrder S; S.init(MP, NUP, G, bid);
                    EpiUp E{zh, rss, svl + (f ? NBATCH * (NUP + DIN) : 0), rowbase, lds + LDS_XOFF};
                    pg8::gemm_phase<EpiUp, pg8::StaticOrder, true, true>(lds, g, S, E, wave);
                } else {
                    pg8::Gemm g{zh, (const bf16_t*)(ws + WS_W2T) + (size_t)(l * 2 + f) * D * FF, MP, D, FF, FF};
                    pg8::StaticOrder S; S.init(MP, D, G, bid);
                    const float* gmn = f == 0 ? gmt + (size_t)(l * 3 + 1) * NBATCH * D : (l == 0 ? gmt + (size_t)3 * NBATCH * D : nullptr);
                    EpiRes E{a.xp, a.xs, (l == 0 && f == 0) ? 1 : 0, a.out, xg, rss, mod_l + (f ? 8 : 2) * D, gmn, 0.5f, rowbase, dostore};
                    pg8::gemm_phase<EpiRes, pg8::StaticOrder, true, true>(lds, g, S, E, wave);
                }
            }
        }
        if (rep + 1 < nrep) GRID_SYNC(0);
        }
        if (ph + 1 < a.ph_hi) GRID_SYNC(ph == a.ph_lo);
#if MK_PROBE == 3
        if (ph + 1 < a.ph_hi) GRID_SYNC(0);
#endif
    }
}

extern "C" void kernel_launch(void* const* d_in, const int* in_sizes, int n_in, void* d_out, int out_size, void* d_ws, size_t ws_size, hipStream_t stream) {
    static int grid = 0;
    if (grid == 0) {
        if (n_in != 17 || out_size != MTOT * D || ws_size < WS_END) { fprintf(stderr, "kernel_launch: unexpected shapes (n_in %d out %d ws %zu)\n", n_in, out_size, ws_size); grid = -1; return; }
        int dev = 0, cus = 0, per_cu = 0;
        hipGetDevice(&dev);
        hipDeviceGetAttribute(&cus, hipDeviceAttributeMultiprocessorCount, dev);
        if (hipFuncSetAttribute((const void*)fwd_megakernel, hipFuncAttributeMaxDynamicSharedMemorySize, LDS_BYTES) != hipSuccess) { fprintf(stderr, "kernel_launch: hipFuncSetAttribute failed\n"); grid = -1; return; }
        if (hipOccupancyMaxActiveBlocksPerMultiprocessor(&per_cu, (const void*)fwd_megakernel, NTHREADS, LDS_BYTES) != hipSuccess || per_cu < 1) { fprintf(stderr, "kernel_launch: occupancy query says %d\n", per_cu); per_cu = 1; }
        (void)hipGetLastError();
        grid = cus * per_cu;
        fprintf(stderr, "kernel_launch: grid %d (cus %d x %d)\n", grid, cus, per_cu);
    }
    if (grid < 0) return;
    Args a{};
    a.xp = (const float*)d_in[0]; a.xs = (const float*)d_in[1]; a.cp = (const float*)d_in[2]; a.cs = (const float*)d_in[3];
    a.ada_w = (const float*)d_in[4]; a.ada_b = (const float*)d_in[5]; a.norm_g = (const float*)d_in[6]; a.ffn_w1 = (const float*)d_in[7];
    a.ffn_w2 = (const float*)d_in[8]; a.mix_w_in = (const float*)d_in[9]; a.conv_w = (const float*)d_in[10]; a.sg_norm_g = (const float*)d_in[11];
    a.sg_ws = (const float*)d_in[12]; a.sg_bs = (const float*)d_in[13]; a.grp_g = (const float*)d_in[14]; a.mix_w_out = (const float*)d_in[15];
    a.final_g = (const float*)d_in[16];
    a.out = (float*)d_out; a.ws = (unsigned char*)d_ws;
#if MK_ONE_LAUNCH
    a.ph_lo = 0; a.ph_hi = NPHASES;
    if (hipMemsetAsync(d_ws, 0, XCD_BAR_WORDS * 4, stream) != hipSuccess) { fprintf(stderr, "kernel_launch: memset failed\n"); return; }
    void* args[] = {&a};
    hipError_t e = hipLaunchCooperativeKernel((const void*)fwd_megakernel, dim3(grid), dim3(NTHREADS), args, LDS_BYTES, stream);
    if (e != hipSuccess) fprintf(stderr, "cooperative launch failed: %s (grid %d)\n", hipGetErrorString(e), grid);
#else
    for (int ph = 0; ph < NPHASES; ++ph) {
        a.ph_lo = ph; a.ph_hi = ph + 1;
        hipLaunchKernelGGL(fwd_megakernel, dim3(grid), dim3(NTHREADS), LDS_BYTES, stream, a);
    }
#endif
}
```

```cpp
#include <hip/hip_runtime.h>
#include <hip/hip_cooperative_groups.h>
#include <cstdio>
#include <cstdint>
namespace cg = cooperative_groups;

#ifndef MK_PROBE
#define MK_PROBE 0
#endif
#ifndef MK_ONE_LAUNCH
#define MK_ONE_LAUNCH 1
#endif

constexpr int D = 1024, FF = 2816, NUP = 2 * FF, DIN = 2560, ZW = 2048;
constexpr int MTOT = 65536, MP = 32768;
constexpr int NBATCH = 10, NMOD = 9 * D;
constexpr float EPS = 1e-6f;
constexpr int NWAVES = 8, NTHREADS = 512;
constexpr int NPHASES = 25;

constexpr size_t MiB = 1u << 20;
constexpr size_t WS_MOD = 1 * MiB;
constexpr size_t WS_GM = 2 * MiB;
constexpr size_t WS_SV = 3 * MiB;
constexpr size_t WS_RSS = 5 * MiB;
constexpr size_t WS_VST = 9 * MiB;
constexpr size_t WS_WSG = 13 * MiB;
constexpr size_t WS_W1T = 14 * MiB;
constexpr size_t WS_W2T = 58 * MiB;
constexpr size_t WS_WINT = 80 * MiB;
constexpr size_t WS_WOUTT = 90 * MiB;
constexpr size_t WS_XG = 94 * MiB;
constexpr size_t WS_ZH = 222 * MiB;
constexpr size_t WS_END = 478 * MiB;
constexpr int SV_LAYER = NBATCH * (NUP + DIN + NUP);

constexpr int LDS_BYTES = 163840;
constexpr int LDS_XOFF = 132096;

namespace pg8 {
#define PG8_LAS __attribute__((address_space(3)))
typedef unsigned short bf16_t;
typedef short bf16x8 __attribute__((ext_vector_type(8)));
typedef float f32x4 __attribute__((ext_vector_type(4)));
typedef float f32x2 __attribute__((ext_vector_type(2)));
typedef unsigned u32x4 __attribute__((ext_vector_type(4)));
typedef unsigned u32x2 __attribute__((ext_vector_type(2)));
constexpr int BM = 256, BK = 64, HALF = 128, HTB = HALF * BK * 2, STAGE_BYTES = 8 * HTB, NXCD = 8, WGM = 8;

__host__ __device__ __forceinline__ int lds_byte(int r, int c) { const int st = (r >> 4) * 2 + (c >> 5), rr = r & 15, cc = c & 31, ob = rr * 64 + cc * 2; return st * 1024 + (ob ^ (((ob >> 9) & 1) << 5)); }
__host__ __device__ __forceinline__ void stage_rc(int b, int& R, int& C) { const int st = b / 1024, sb = b % 1024, swz = sb ^ (((sb >> 9) & 1) << 5); R = (st >> 1) * 16 + swz / 64; C = (st & 1) * 32 + (swz % 64) / 2; }
__host__ __device__ __forceinline__ int perm32(int rho) { const int n = rho >> 4, i = rho & 15; return 8 * (i >> 2) + 4 * n + (i & 3); }

struct Unit { int pm, pn; };
struct Gemm { const bf16_t* A; const bf16_t* Bt; int M, N, K, lda; };

struct StaticOrder {
    int nM, nN, nwg, G, c;
    __host__ __device__ void init(int M, int N, int G_, int c_) { nM = M / BM; nN = N / BM; nwg = nM * nN; G = G_; c = c_; }
    __host__ __device__ bool next(int i, Unit& u) const {
        const long L = (long)i * G + c; if (L >= nwg) return false;
        int wgid = (int)L; { const int q = nwg / NXCD, r = nwg % NXCD, xcd = wgid % NXCD, off = wgid / NXCD; wgid = (xcd < r ? xcd * (q + 1) : r * (q + 1) + (xcd - r) * q) + off; }
        const int nig = WGM * nN, gid = wgid / nig, fm = gid * WGM, gsz = (nM - fm) < WGM ? (nM - fm) : WGM;
        u.pm = fm + ((wgid % nig) % gsz); u.pn = (wgid % nig) / gsz; return true;
    }
};

__device__ __forceinline__ unsigned cvt_pk_bf16(float lo, float hi) { unsigned r; asm volatile("v_cvt_pk_bf16_f32 %0, %1, %2" : "=v"(r) : "v"(lo), "v"(hi)); return r; }
__device__ __forceinline__ f32x2 gelu_pk(f32x2 v) {
    const f32x2 av = __builtin_elementwise_abs(v), d = av * 0.2316418882f + 1.0f;
    f32x2 t; t.x = __builtin_amdgcn_rcpf(d.x); t.y = __builtin_amdgcn_rcpf(d.y);
    f32x2 q = t * 0.5307027145f + (-0.7265760135f); q = q * t + 0.7107068705f; q = q * t + (-0.142248368f); q = q * t + 0.127414796f; q = q * t;
    const f32x2 s = (v * v) * (-0.72134752044f);
    f32x2 e; e.x = __builtin_amdgcn_exp2f(s.x); e.y = __builtin_amdgcn_exp2f(s.y);
    const f32x2 m = v * (q * e), r = v - m;
    f32x2 o; o.x = v.x < 0.f ? m.x : r.x; o.y = v.y < 0.f ? m.y : r.y; return o;
}
__device__ __forceinline__ f32x4 gelu4(f32x4 v) { const f32x2 a = gelu_pk((f32x2){v[0], v[1]}), b = gelu_pk((f32x2){v[2], v[3]}); return (f32x4){a.x, a.y, b.x, b.y}; }
__device__ __forceinline__ float silu1(float g) { return g * __builtin_amdgcn_rcpf(1.0f + __builtin_amdgcn_exp2f(-1.4426950409f * g)); }
__device__ __forceinline__ f32x2 silu_mul_pk(f32x2 g, f32x2 u) {
    const f32x2 t = g * (-1.4426950409f);
    f32x2 e; e.x = __builtin_amdgcn_exp2f(t.x); e.y = __builtin_amdgcn_exp2f(t.y);
    const f32x2 d = e + 1.0f;
    f32x2 r; r.x = __builtin_amdgcn_rcpf(d.x); r.y = __builtin_amdgcn_rcpf(d.y);
    return (g * u) * r;
}

__device__ __forceinline__ int lane_id_v() { int l; asm volatile("v_mbcnt_lo_u32_b32 %0, -1, 0\n\tv_mbcnt_hi_u32_b32 %0, -1, %0" : "=v"(l)); return l; }
template <class Epi, class Sched, bool ALIGN_EPI, bool SP2>
__device__ __forceinline__ void gemm_phase(PG8_LAS unsigned char* lds, const Gemm g, const Sched& S, const Epi& E, int wid) {
    const int lane = lane_id_v(), tid = wid * 64 + lane;
    const int wr = wid >> 2, wc = wid & 3, fr = lane & 15, fq = lane >> 4;
    const int K = g.K, nt = K / BK, lda = g.lda;
    unsigned voffA[2], voffB[2];
#pragma unroll
    for (int i = 0; i < 2; ++i) { int R, C; stage_rc(tid * 16 + i * 8192, R, C); const int Rb = Epi::PERM ? ((R & ~31) + perm32(R & 31)) : R;
        voffA[i] = (unsigned)(R * lda + C) * 2u; voffB[i] = (unsigned)(Rb * K + C) * 2u; }
    const size_t kstep = (size_t)(BK * 2);
    const size_t hstepA = (size_t)HALF * lda * 2, hstepB = (size_t)HALF * K * 2;
    const size_t tstepA = 2 * hstepA, tstepB = 2 * hstepB;
    const unsigned ldsw = (unsigned)wid * 1024u;
    const int aoff = lds_byte(wr * 64 + fr, fq * 8), boff = lds_byte(wc * 32 + fr, fq * 8);
#define PG8_SA(b, h) (((b) * 2 + (h)) * HTB)
#define PG8_SB(b, h) ((4 + (b) * 2 + (h)) * HTB)
#define PG8_STAGE(bufoff, gbase, voff) do { _Pragma("unroll") for (int _i = 0; _i < 2; ++_i) \
        __builtin_amdgcn_global_load_lds((const unsigned*)((const char*)(gbase) + (voff)[_i]), (PG8_LAS unsigned*)(lds + (bufoff) + ldsw + _i * 8192), 16, 0, 0); } while (0)
#define PG8_LDA(dst, b, h) do { _Pragma("unroll") for (int m = 0; m < 4; ++m) _Pragma("unroll") for (int k = 0; k < 2; ++k) dst[m][k] = *(const PG8_LAS bf16x8*)(lds + PG8_SA(b, h) + aoff + m * 2048 + k * 1024); } while (0)
#define PG8_LDB(dst, b, h) do { _Pragma("unroll") for (int n = 0; n < 2; ++n) _Pragma("unroll") for (int k = 0; k < 2; ++k) dst[n][k] = *(const PG8_LAS bf16x8*)(lds + PG8_SB(b, h) + boff + n * 2048 + k * 1024); } while (0)
#define PG8_MMA(ai, bj, At, Bt) do { __builtin_amdgcn_s_setprio(1); _Pragma("unroll") for (int m = 0; m < 4; ++m) _Pragma("unroll") for (int n = 0; n < 2; ++n) _Pragma("unroll") for (int k = 0; k < 2; ++k) \
        acc[ai][bj][m][n] = __builtin_amdgcn_mfma_f32_16x16x32_bf16(Bt[n][k], At[m][k], acc[ai][bj][m][n], 0, 0, 0); __builtin_amdgcn_s_setprio(0); } while (0)
#define PG8_WAIT_V(n) asm volatile("s_waitcnt vmcnt(" #n ")" ::: "memory")
#define PG8_WAIT_L(n) asm volatile("s_waitcnt lgkmcnt(" #n ")" ::: "memory")
#define PG8_BAR __builtin_amdgcn_s_barrier()
#define PG8_SCHED __builtin_amdgcn_sched_barrier(0)
    Unit cur, nxt; int ui = 0;
    if (!S.next(0, cur)) return;
    f32x4 acc[2][2][4][2];
#pragma unroll
    for (int a = 0; a < 2; ++a)
#pragma unroll
        for (int b = 0; b < 2; ++b)
#pragma unroll
            for (int m = 0; m < 4; ++m)
#pragma unroll
                for (int n = 0; n < 2; ++n) acc[a][b][m][n] = (f32x4){0.f, 0.f, 0.f, 0.f};
    bf16x8 At[4][2], B0[2][2], B1[2][2];
    const char* cA = (const char*)g.A + (size_t)cur.pm * tstepA; const char* cB = (const char*)g.Bt + (size_t)cur.pn * tstepB;
    if constexpr (SP2) {
        PG8_STAGE(PG8_SB(0, 0), cB, voffB); PG8_STAGE(PG8_SB(0, 1), cB + hstepB, voffB); PG8_STAGE(PG8_SA(0, 0), cA, voffA); PG8_STAGE(PG8_SA(0, 1), cA + hstepA, voffA);
        if (wr == 1) PG8_BAR;
        PG8_WAIT_V(2); PG8_BAR;
        PG8_STAGE(PG8_SB(1, 0), cB + kstep, voffB); PG8_STAGE(PG8_SA(1, 0), cA + kstep, voffA); PG8_STAGE(PG8_SB(1, 1), cB + hstepB + kstep, voffB);
        PG8_WAIT_V(6); PG8_BAR;
    } else {
        PG8_STAGE(PG8_SB(0, 0), cB, voffB); PG8_STAGE(PG8_SA(0, 0), cA, voffA); PG8_STAGE(PG8_SB(0, 1), cB + hstepB, voffB); PG8_STAGE(PG8_SA(0, 1), cA + hstepA, voffA);
        if (wr == 1) PG8_BAR;
        PG8_WAIT_V(4); PG8_BAR;
        PG8_STAGE(PG8_SB(1, 0), cB + kstep, voffB); PG8_STAGE(PG8_SA(1, 0), cA + kstep, voffA); PG8_STAGE(PG8_SB(1, 1), cB + hstepB + kstep, voffB);
        PG8_WAIT_V(6); PG8_BAR;
    }
    for (;;) {
        const bool has_next = S.next(ui + 1, nxt);
        const char* nA = has_next ? (const char*)g.A + (size_t)nxt.pm * tstepA : cA; const char* nB = has_next ? (const char*)g.Bt + (size_t)nxt.pn * tstepB : cB;
        for (int t = 0; t < nt; t += 2) {
            const bool last = (t == nt - 2);
            const char* a1 = cA + (size_t)(t + 1) * kstep;
            const char* a2 = last ? nA : cA + (size_t)(t + 2) * kstep; const char* b2 = last ? nB : cB + (size_t)(t + 2) * kstep;
            const char* a3 = a2 + kstep; const char* b3 = b2 + kstep;
            if constexpr (Epi::PRE == 1) { if (last) {
                const char* rsrc; const char* ssrc; E.pre(cur, rsrc, ssrc);
#pragma unroll
                for (int _i = 0; _i < 2; ++_i) __builtin_amdgcn_global_load_lds((const unsigned*)(rsrc + (wid + 8 * _i) * 1024 + lane * 16), (PG8_LAS unsigned*)(lds + LDS_XOFF + (wid + 8 * _i) * 1024), 16, 0, 0);
                if (wid == 0) __builtin_amdgcn_global_load_lds((const unsigned*)(ssrc + lane * 16), (PG8_LAS unsigned*)(lds + LDS_XOFF + 16384), 16, 0, 0);
            } }
            if constexpr (SP2) {
            PG8_LDB(B0, 0, 0); PG8_LDB(B1, 0, 1); PG8_SCHED; PG8_LDA(At, 0, 0); PG8_STAGE(PG8_SA(1, 1), a1 + hstepA, voffA);
            PG8_WAIT_V(8); PG8_WAIT_L(0); PG8_BAR; PG8_MMA(0, 0, At, B0); PG8_MMA(0, 1, At, B1); PG8_BAR; PG8_SCHED;
            PG8_LDA(At, 0, 1); PG8_STAGE(PG8_SB(0, 0), b2, voffB); PG8_STAGE(PG8_SB(0, 1), b2 + hstepB, voffB); PG8_STAGE(PG8_SA(0, 0), a2, voffA);
            PG8_WAIT_V(8); PG8_WAIT_L(0); PG8_BAR; PG8_MMA(1, 0, At, B0); PG8_MMA(1, 1, At, B1); PG8_BAR; PG8_SCHED;
            PG8_LDB(B0, 1, 0); PG8_LDB(B1, 1, 1); PG8_SCHED; PG8_LDA(At, 1, 0); PG8_STAGE(PG8_SA(0, 1), a2 + hstepA, voffA);
            PG8_WAIT_V(8); PG8_WAIT_L(0); PG8_BAR; PG8_MMA(0, 0, At, B0); PG8_MMA(0, 1, At, B1); PG8_BAR; PG8_SCHED;
            PG8_LDA(At, 1, 1); PG8_STAGE(PG8_SB(1, 0), b3, voffB); PG8_STAGE(PG8_SB(1, 1), b3 + hstepB, voffB); PG8_STAGE(PG8_SA(1, 0), a3, voffA);
            PG8_WAIT_V(8); PG8_WAIT_L(0); PG8_BAR; PG8_MMA(1, 0, At, B0); PG8_MMA(1, 1, At, B1); PG8_BAR; PG8_SCHED;
            } else {
            PG8_LDB(B0, 0, 0); PG8_SCHED; PG8_LDA(At, 0, 0); PG8_STAGE(PG8_SA(1, 1), a1 + hstepA, voffA);
            PG8_WAIT_L(8); PG8_BAR; PG8_WAIT_L(0); PG8_MMA(0, 0, At, B0); PG8_BAR; PG8_SCHED;
            PG8_LDB(B1, 0, 1); PG8_STAGE(PG8_SB(0, 0), b2, voffB);
            PG8_BAR; PG8_WAIT_L(0); PG8_MMA(0, 1, At, B1); PG8_BAR;
            PG8_LDA(At, 0, 1); PG8_STAGE(PG8_SA(0, 0), a2, voffA);
            PG8_BAR; PG8_WAIT_L(0); PG8_MMA(1, 0, At, B0); PG8_BAR; PG8_SCHED;
            PG8_STAGE(PG8_SB(0, 1), b2 + hstepB, voffB);
            PG8_WAIT_V(6); PG8_BAR; PG8_MMA(1, 1, At, B1); PG8_BAR;
            PG8_LDB(B0, 1, 0); PG8_SCHED; PG8_LDA(At, 1, 0); PG8_STAGE(PG8_SA(0, 1), a2 + hstepA, voffA);
            PG8_WAIT_L(8); PG8_BAR; PG8_WAIT_L(0); PG8_MMA(0, 0, At, B0); PG8_BAR; PG8_SCHED;
            PG8_LDB(B1, 1, 1); PG8_STAGE(PG8_SB(1, 0), b3, voffB);
            PG8_BAR; PG8_WAIT_L(0); PG8_MMA(0, 1, At, B1); PG8_BAR;
            PG8_LDA(At, 1, 1); PG8_STAGE(PG8_SA(1, 0), a3, voffA);
            PG8_BAR; PG8_WAIT_L(0); PG8_MMA(1, 0, At, B0); PG8_BAR; PG8_SCHED;
            PG8_STAGE(PG8_SB(1, 1), b3 + hstepB, voffB);
            PG8_WAIT_V(6); PG8_BAR; PG8_MMA(1, 1, At, B1); PG8_BAR;
            }
        }
        if constexpr (ALIGN_EPI) { if (wr == 0) PG8_BAR; }
        E(acc, cur, wr, wc, fr, fq);
        if (!has_next) break;
#pragma unroll
        for (int a = 0; a < 2; ++a)
#pragma unroll
            for (int b = 0; b < 2; ++b)
#pragma unroll
                for (int m = 0; m < 4; ++m)
#pragma unroll
                    for (int n = 0; n < 2; ++n) acc[a][b][m][n] = (f32x4){0.f, 0.f, 0.f, 0.f};
        cur = nxt; cA = nA; cB = nB; ++ui;
        if constexpr (ALIGN_EPI) { if (wr == 1) PG8_BAR; }
    }
    PG8_WAIT_V(0);
    if constexpr (!ALIGN_EPI) { if (wr == 0) PG8_BAR; }
    PG8_BAR;
#undef PG8_SA
#undef PG8_SB
#undef PG8_STAGE
#undef PG8_LDA
#undef PG8_LDB
#undef PG8_MMA
#undef PG8_WAIT_V
#undef PG8_WAIT_L
#undef PG8_BAR
#undef PG8_SCHED
}
}

using pg8::bf16_t; using pg8::f32x4; using pg8::f32x2; using pg8::u32x4; using pg8::u32x2; using pg8::bf16x8; using pg8::cvt_pk_bf16;
#define LAS __attribute__((address_space(3)))

__device__ __forceinline__ int batch_of(int r) { return r < MP ? (r >> 12) : 8 + ((r - MP) >> 14); }
__device__ __forceinline__ float wave_sum(float v) {
#pragma unroll
    for (int o = 1; o < 64; o <<= 1) v += __shfl_xor(v, o);
    return v;
}
__device__ __forceinline__ float bf_lo(unsigned w) { return __uint_as_float(w << 16); }
__device__ __forceinline__ float bf_hi(unsigned w) { return __uint_as_float(w & 0xffff0000u); }
__device__ __forceinline__ float row_rstd(const float* rss, int row, int fq) {
    const f32x4 p = *(const f32x4*)(rss + (size_t)row * 16 + 4 * fq);
    float s = (p[0] + p[1]) + (p[2] + p[3]);
    s += __shfl_xor(s, 16); s += __shfl_xor(s, 32);
    return rsqrtf(s * (1.0f / D) + EPS);
}

__device__ __forceinline__ void rows_rstd8(const float* rss, int row0, int fq, float (&rs)[8]) {
    f32x4 pr[8];
#pragma unroll
    for (int i = 0; i < 8; ++i) pr[i] = *(const f32x4*)(rss + (size_t)(row0 + (i >> 2) * 128 + (i & 3) * 16) * 16 + 4 * fq);
#pragma unroll
    for (int i = 0; i < 8; ++i) { float t = (pr[i][0] + pr[i][1]) + (pr[i][2] + pr[i][3]); t += __shfl_xor(t, 16); t += __shfl_xor(t, 32); rs[i] = rsqrtf(t * (1.0f / D) + EPS); }
}
__device__ __forceinline__ void rows_rstd8_lds(const LAS unsigned char* xl, int lrow0, int fq, float (&rs)[8]) {
#pragma unroll
    for (int i = 0; i < 8; ++i) { const f32x4 p = *(const LAS f32x4*)(xl + (lrow0 + (i >> 2) * 128 + (i & 3) * 16) * 64 + 16 * fq);
        float t = (p[0] + p[1]) + (p[2] + p[3]); t += __shfl_xor(t, 16); t += __shfl_xor(t, 32); rs[i] = rsqrtf(t * (1.0f / D) + EPS); }
}
struct EpiUp {
    static constexpr bool PERM = true; static constexpr int PRE = 1;
    bf16_t* H; const float* rss; const float* S; int rowbase; LAS unsigned char* xl;
    __device__ __forceinline__ void pre(const pg8::Unit& u, const char*& rsrc, const char*& ssrc) const {
        rsrc = (const char*)(rss + (size_t)(rowbase + u.pm * 256) * 16); ssrc = (const char*)(S + (size_t)batch_of(rowbase + u.pm * 256) * NUP + u.pn * 256); }
    __device__ __forceinline__ void operator()(const f32x4 (&acc)[2][2][4][2], const pg8::Unit& u, int wr, int wc, int fr_, int fq_) const {
        const int lane_ = pg8::lane_id_v(); const int fr = lane_ & 15, fq = lane_ >> 4;
        const int lrow0 = u.pm * 256 + wr * 64 + fr;
        const int b = batch_of(rowbase + u.pm * 256);
        f32x4 sv[2][2];
#pragma unroll
        for (int bj = 0; bj < 2; ++bj)
#pragma unroll
            for (int n = 0; n < 2; ++n) sv[bj][n] = *(const LAS f32x4*)(xl + 16384 + (bj * 128 + wc * 32 + 8 * fq + 4 * n) * 4);
        float rs8[8]; rows_rstd8_lds(xl, wr * 64 + fr, fq, rs8);
        const int hcol = u.pn * 128 + wc * 32 + 8 * fq;
#pragma unroll
        for (int ai = 0; ai < 2; ++ai)
#pragma unroll
            for (int m = 0; m < 4; ++m) {
                const int lr = lrow0 + ai * 128 + m * 16;
                const float rs = rs8[ai * 4 + m];
                const f32x4 g0 = acc[ai][0][m][0] * rs + sv[0][0], g1 = acc[ai][0][m][1] * rs + sv[0][1];
                const f32x4 u0 = acc[ai][1][m][0] * rs + sv[1][0], u1 = acc[ai][1][m][1] * rs + sv[1][1];
                const f32x2 ha = pg8::silu_mul_pk((f32x2){g0[0], g0[1]}, (f32x2){u0[0], u0[1]}), hb = pg8::silu_mul_pk((f32x2){g0[2], g0[3]}, (f32x2){u0[2], u0[3]});
                const f32x2 hc = pg8::silu_mul_pk((f32x2){g1[0], g1[1]}, (f32x2){u1[0], u1[1]}), hd = pg8::silu_mul_pk((f32x2){g1[2], g1[3]}, (f32x2){u1[2], u1[3]});
                u32x4 w; w.x = cvt_pk_bf16(ha.x, ha.y); w.y = cvt_pk_bf16(hb.x, hb.y); w.z = cvt_pk_bf16(hc.x, hc.y); w.w = cvt_pk_bf16(hd.x, hd.y);
                *(u32x4*)(H + (size_t)lr * FF + hcol) = w;
            }
    }
};

#ifndef RES_DEPTH
#define RES_DEPTH 2
#endif
__device__ __forceinline__ f32x4 dpp_ror8(f32x4 v) { f32x4 r;
#pragma unroll
    for (int j = 0; j < 4; ++j) r[j] = __int_as_float(__builtin_amdgcn_update_dpp(0, __float_as_int(v[j]), 0x128, 0xF, 0xF, false));
    return r; }
__device__ __forceinline__ u32x2 dpp_ror8(u32x2 v) { u32x2 r; r.x = (unsigned)__builtin_amdgcn_update_dpp(0, (int)v.x, 0x128, 0xF, 0xF, false); r.y = (unsigned)__builtin_amdgcn_update_dpp(0, (int)v.y, 0x128, 0xF, 0xF, false); return r; }
struct EpiRes {
    static constexpr bool PERM = false; static constexpr int PRE = 0;
    __device__ __forceinline__ void pre(const pg8::Unit&, const char*&, const char*&) const {}
    const float* xp; const float* xs; int first;
    float* out; bf16_t* xg; float* rss; const float* gate; const float* gm; float coef; int rowbase; int dostore;
    __device__ __forceinline__ void operator()(const f32x4 (&acc)[2][2][4][2], const pg8::Unit& u, int wr, int wc, int fr_, int fq_) const {
        const int lane_ = pg8::lane_id_v(); const int fr = lane_ & 15, fq = lane_ >> 4;
        const bool hi = (fr & 8) != 0; const int r8 = fr & 7;
        const int grow0 = rowbase + u.pm * 256 + wr * 64 + fr;
        const int mrow0 = rowbase + u.pm * 256 + wr * 64 + r8;
        const int b = batch_of(rowbase + u.pm * 256);
        const int col0 = u.pn * 256 + wc * 32 + 4 * fq;
        const int mcol = col0 + (hi ? 16 : 0);
        const float* rp0 = (first ? (mrow0 < MP ? xp + (size_t)mrow0 * D : xs + (size_t)(mrow0 - MP) * D) : out + (size_t)mrow0 * D) + mcol;
        f32x4 xi[RES_DEPTH][4];
#pragma unroll
        for (int r = 0; r < RES_DEPTH; ++r)
#pragma unroll
            for (int q = 0; q < 4; ++q) xi[r][q] = *(const f32x4*)(rp0 + (size_t)((r >> 2) * 128 + (r & 3) * 16 + (q & 1) * 8) * D + (q >> 1) * 128);
        const float* gp = gate + (size_t)b * NMOD + col0;
        f32x4 gv[2][2], mv[2][2];
#pragma unroll
        for (int bj = 0; bj < 2; ++bj)
#pragma unroll
            for (int n = 0; n < 2; ++n) { gv[bj][n] = *(const f32x4*)(gp + bj * 128 + n * 16) * coef;
                mv[bj][n] = gm ? *(const f32x4*)(gm + b * D + col0 + bj * 128 + n * 16) : (f32x4){0.f, 0.f, 0.f, 0.f}; }
#pragma unroll
        for (int r = 0; r < 8; ++r) {
            const int ai = r >> 2, m = r & 3;
            const int grow = grow0 + ai * 128 + m * 16;
            const size_t mo0 = (size_t)(mrow0 + ai * 128 + m * 16) * D + mcol, mo1 = mo0 + (size_t)8 * D;
            f32x4 xo[2][2];
#pragma unroll
            for (int bj = 0; bj < 2; ++bj) {
                const f32x4 L1 = xi[r % RES_DEPTH][bj * 2], L2 = xi[r % RES_DEPTH][bj * 2 + 1];
                const f32x4 T = dpp_ror8(hi ? L1 : L2);
                const f32x4 x0 = hi ? T : L1, x1 = hi ? L2 : T;
                xo[bj][0] = x0 + gv[bj][0] * acc[ai][bj][m][0]; xo[bj][1] = x1 + gv[bj][1] * acc[ai][bj][m][1];
            }
            if (r + RES_DEPTH < 8) {
                const int r2 = r + RES_DEPTH;
#pragma unroll
                for (int q = 0; q < 4; ++q) xi[r % RES_DEPTH][q] = *(const f32x4*)(rp0 + (size_t)((r2 >> 2) * 128 + (r2 & 3) * 16 + (q & 1) * 8) * D + (q >> 1) * 128);
            }
            float ss = 0.f;
#pragma unroll
            for (int bj = 0; bj < 2; ++bj) {
                const f32x4 a0 = xo[bj][0], a1 = xo[bj][1];
                ss += ((a0[0] * a0[0] + a0[1] * a0[1]) + (a0[2] * a0[2] + a0[3] * a0[3])) + ((a1[0] * a1[0] + a1[1] * a1[1]) + (a1[2] * a1[2] + a1[3] * a1[3]));
                const f32x4 T2 = dpp_ror8(hi ? a0 : a1);
                const f32x4 d1 = hi ? T2 : a0, d2 = hi ? a1 : T2;
                *(f32x4*)(out + mo0 + bj * 128) = d1; *(f32x4*)(out + mo1 + bj * 128) = d2;
                if (gm) { const f32x4 o0 = a0 * mv[bj][0], o1 = a1 * mv[bj][1];
                    u32x2 w0, w1; w0.x = cvt_pk_bf16(o0[0], o0[1]); w0.y = cvt_pk_bf16(o0[2], o0[3]); w1.x = cvt_pk_bf16(o1[0], o1[1]); w1.y = cvt_pk_bf16(o1[2], o1[3]);
                    const u32x2 T3 = dpp_ror8(hi ? w0 : w1);
                    const u32x2 e1 = hi ? T3 : w0, e2 = hi ? w1 : T3;
                    *(u32x2*)(xg + mo0 + bj * 128) = e1; *(u32x2*)(xg + mo1 + bj * 128) = e2; }
            }
            ss += __shfl_xor(ss, 16); ss += __shfl_xor(ss, 32);
            if (fq == 0) rss[(size_t)grow * 16 + u.pn * 4 + wc] = ss;
        }
    }
};

struct EpiMixIn {
    static constexpr bool PERM = true; static constexpr int PRE = 1;
    bf16_t* Z; const float* rss; const float* S; float* vst; LAS unsigned char* xl;
    __device__ __forceinline__ void pre(const pg8::Unit& u, const char*& rsrc, const char*& ssrc) const {
        rsrc = (const char*)(rss + (size_t)(u.pm * 256) * 16); ssrc = (const char*)(S + (size_t)batch_of(u.pm * 256) * DIN + u.pn * 256); }
    __device__ __forceinline__ void operator()(const f32x4 (&acc)[2][2][4][2], const pg8::Unit& u, int wr, int wc, int fr_, int fq_) const {
        const int lane_ = pg8::lane_id_v(); const int fr = lane_ & 15, fq = lane_ >> 4;
        const int row0 = u.pm * 256 + wr * 64 + fr;
        const int b = batch_of(u.pm * 256);
        f32x4 sv[2][2];
#pragma unroll
        for (int bj = 0; bj < 2; ++bj)
#pragma unroll
            for (int n = 0; n < 2; ++n) sv[bj][n] = *(const LAS f32x4*)(xl + 16384 + (bj * 128 + wc * 32 + 8 * fq + 4 * n) * 4);
        float rs8[8]; rows_rstd8_lds(xl, wr * 64 + fr, fq, rs8);
        const int pn = u.pn;
        const int lc = wc * 32 + 8 * fq;
#pragma unroll
        for (int ai = 0; ai < 2; ++ai)
#pragma unroll
            for (int m = 0; m < 4; ++m) {
                const int row = row0 + ai * 128 + m * 16;
                const float rs = rs8[ai * 4 + m];
                f32x4 v00 = acc[ai][0][m][0] * rs + sv[0][0], v01 = acc[ai][0][m][1] * rs + sv[0][1];
                f32x4 v10 = acc[ai][1][m][0] * rs + sv[1][0], v11 = acc[ai][1][m][1] * rs + sv[1][1];
                bf16_t* zr = Z + (size_t)row * ZW;
                if (pn >= 2 && pn < 6) {
                    const f32x4 o0 = v00 * v10, o1 = v01 * v11;
                    u32x4 w; w.x = cvt_pk_bf16(o0[0], o0[1]); w.y = cvt_pk_bf16(o0[2], o0[3]); w.z = cvt_pk_bf16(o1[0], o1[1]); w.w = cvt_pk_bf16(o1[2], o1[3]);
                    *(u32x4*)(zr + 1024 + (pn - 2) * 128 + lc) = w;
                } else {
                    int cbase = pn * 256;
                    if (pn >= 6) {
                        v00 = pg8::gelu4(v00); v01 = pg8::gelu4(v01); v10 = pg8::gelu4(v10); v11 = pg8::gelu4(v11);
                        cbase = pn < 8 ? 512 + (pn - 6) * 256 : 1536 + (pn - 8) * 256;
                    }
                    u32x4 w0, w1;
                    w0.x = cvt_pk_bf16(v00[0], v00[1]); w0.y = cvt_pk_bf16(v00[2], v00[3]); w0.z = cvt_pk_bf16(v01[0], v01[1]); w0.w = cvt_pk_bf16(v01[2], v01[3]);
                    w1.x = cvt_pk_bf16(v10[0], v10[1]); w1.y = cvt_pk_bf16(v10[2], v10[3]); w1.z = cvt_pk_bf16(v11[0], v11[1]); w1.w = cvt_pk_bf16(v11[2], v11[3]);
                    *(u32x4*)(zr + cbase + lc) = w0;
                    *(u32x4*)(zr + cbase + 128 + lc) = w1;
                    if (pn >= 8) {
                        const f32x4 s4 = (v00 + v01) + (v10 + v11);
                        const f32x4 q4 = (v00 * v00 + v01 * v01) + (v10 * v10 + v11 * v11);
                        float s1 = (s4[0] + s4[1]) + (s4[2] + s4[3]), s2 = (q4[0] + q4[1]) + (q4[2] + q4[3]);
                        s1 += __shfl_xor(s1, 16); s1 += __shfl_xor(s1, 32); s2 += __shfl_xor(s2, 16); s2 += __shfl_xor(s2, 32);
                        if (fq == 0) *(f32x2*)(vst + (size_t)row * 16 + ((pn - 8) * 4 + wc) * 2) = (f32x2){s1, s2};
                    }
                }
            }
    }
};

struct Args {
    const float* xp; const float* xs; const float* cp; const float* cs; const float* ada_w; const float* ada_b; const float* norm_g;
    const float* ffn_w1; const float* ffn_w2; const float* mix_w_in; const float* conv_w; const float* sg_norm_g; const float* sg_ws;
    const float* sg_bs; const float* grp_g; const float* mix_w_out; const float* final_g;
    float* out; unsigned char* ws; int ph_lo, ph_hi;
};

__device__ __forceinline__ unsigned f2bf(float f) { unsigned u = __float_as_uint(f); return (u + 0x7fffu + ((u >> 16) & 1u)) >> 16; }
__device__ __forceinline__ unsigned pk2(float lo, float hi) { return f2bf(lo) | (f2bf(hi) << 16); }

__device__ __forceinline__ int map_col(int mode, int s) {
    if (mode == 1) { const int bj = s >= FF ? 1 : 0, h = s - bj * FF; return 256 * (h >> 7) + 128 * bj + (h & 127); }
    if (mode == 2) { if (s >= 512 && s < 1024) { const int q = s - 512; return 512 + 256 * (q >> 7) + (q & 127); }
                     if (s >= 1024 && s < 1536) { const int q = s - 1024; return 512 + 256 * (q >> 7) + 128 + (q & 127); } }
    return s;
}
__device__ __forceinline__ void transpose_item(const float* W, int K, int N, bf16_t* WT, int mode, LAS float* scr, int item, int lane) {
    const int nblk = N / 32, kb = item / nblk, nb = item % nblk, k0 = 64 * kb, n0 = 32 * nb, dn0 = map_col(mode, n0);
    float tv[32];
#pragma unroll
    for (int i = 0; i < 32; ++i) { const int kk = 2 * i + (lane >> 5); tv[i] = W[(size_t)(k0 + kk) * N + n0 + (lane & 31)]; }
#pragma unroll
    for (int i = 0; i < 32; ++i) { const int kk = 2 * i + (lane >> 5); scr[kk * 33 + (lane & 31)] = tv[i]; }
    asm volatile("s_waitcnt lgkmcnt(0)" ::: "memory");
    const int c = lane & 7;
#pragma unroll
    for (int j = 0; j < 4; ++j) { const int n = (lane >> 3) + 8 * j; const LAS float* s = scr + (8 * c) * 33 + n;
        u32x4 o; o.x = pk2(s[0 * 33], s[1 * 33]); o.y = pk2(s[2 * 33], s[3 * 33]); o.z = pk2(s[4 * 33], s[5 * 33]); o.w = pk2(s[6 * 33], s[7 * 33]);
        *(u32x4*)(WT + (size_t)(dn0 + n) * K + k0 + 8 * c) = o; }
    asm volatile("s_waitcnt lgkmcnt(0)" ::: "memory");
}

__device__ __forceinline__ void phase_p0a(const Args& a, LAS unsigned char* lds, int bid, int G, int wave) {
    const int lane = pg8::lane_id_v(), tid = wave * 64 + lane;
    LAS float* sc = (LAS float*)lds;
    LAS float* scr = (LAS float*)(lds + 49152 + wave * 10240);
    float* mod = (float*)(a.ws + WS_MOD);
    if (bid < 288) {
        for (int i = tid; i < NBATCH * D; i += NTHREADS) { const int b = i >> 10, k = i & 1023; const float c = b < 8 ? a.cp[b * D + k] : a.cs[(b - 8) * D + k]; sc[i] = c / (1.0f + __expf(-c)); }
        __syncthreads();
        for (int it = bid; it < 288; it += G) {
            const int l = it / 144, n0 = (it % 144) * 64;
            const float* W = a.ada_w + (size_t)l * D * NMOD + n0 + lane;
            float acc[NBATCH];
#pragma unroll
            for (int b = 0; b < NBATCH; ++b) acc[b] = 0.f;
#pragma unroll 16
            for (int kk = 0; kk < 128; ++kk) { const int k = wave * 128 + kk; const float w = W[(size_t)k * NMOD];
#pragma unroll
                for (int b = 0; b < NBATCH; ++b) acc[b] += sc[b * D + k] * w; }
#pragma unroll
            for (int b = 0; b < NBATCH; ++b) scr[b * 64 + lane] = acc[b];
            __syncthreads();
            for (int i = tid; i < NBATCH * 64; i += NTHREADS) { const int b = i >> 6, c = i & 63; float s = 0.f;
#pragma unroll
                for (int w = 0; w < NWAVES; ++w) s += ((LAS float*)(lds + 49152 + w * 10240))[b * 64 + c];
                mod[((size_t)l * NBATCH + b) * NMOD + n0 + c] = s + a.ada_b[(size_t)l * NMOD + n0 + c]; }
            __syncthreads();
        }
    }
    const int gw = bid * NWAVES + wave, NGW = G * NWAVES;
    constexpr int I_W1 = (D / 64) * (NUP / 32), I_W2 = (FF / 64) * (D / 32), I_WIN = (D / 64) * (DIN / 32), I_WOUT = (D / 64) * (D / 32);
    constexpr int NITEMS = 4 * I_W1 + 4 * I_W2 + 2 * I_WIN + 2 * I_WOUT;
    for (int it = gw; it < NITEMS; it += NGW) {
        int r = it;
        if (r < 4 * I_W1) { const int mi = r / I_W1; transpose_item(a.ffn_w1 + (size_t)mi * D * NUP, D, NUP, (bf16_t*)(a.ws + WS_W1T) + (size_t)mi * NUP * D, 1, scr, r % I_W1, lane); continue; } r -= 4 * I_W1;
        if (r < 4 * I_W2) { const int mi = r / I_W2; transpose_item(a.ffn_w2 + (size_t)mi * FF * D, FF, D, (bf16_t*)(a.ws + WS_W2T) + (size_t)mi * D * FF, 0, scr, r % I_W2, lane); continue; } r -= 4 * I_W2;
        if (r < 2 * I_WIN) { const int mi = r / I_WIN; transpose_item(a.mix_w_in + (size_t)mi * D * DIN, D, DIN, (bf16_t*)(a.ws + WS_WINT) + (size_t)mi * DIN * D, 2, scr, r % I_WIN, lane); continue; } r -= 2 * I_WIN;
        { const int mi = r / I_WOUT; transpose_item(a.mix_w_out + (size_t)mi * D * D, D, D, (bf16_t*)(a.ws + WS_WOUTT) + (size_t)mi * D * D, 0, scr, r % I_WOUT, lane); }
    }
    { const f32x4* src = (const f32x4*)a.sg_ws; u32x2* dst = (u32x2*)(a.ws + WS_WSG);
      for (int i = bid * NTHREADS + tid; i < 2 * 8 * 128 * 128 / 4; i += G * NTHREADS) { const f32x4 v = src[i]; u32x2 w; w.x = pk2(v[0], v[1]); w.y = pk2(v[2], v[3]); dst[i] = w; } }
}

__device__ __forceinline__ void phase_p0b(const Args& a, LAS unsigned char* lds, int bid, int G, int wave) {
    const int lane = pg8::lane_id_v(), tid = wave * 64 + lane;
    const float* mod = (const float*)(a.ws + WS_MOD);
    float* gmt = (float*)(a.ws + WS_GM);
    for (int i = bid * NTHREADS + tid; i < 6 * NBATCH * D; i += G * NTHREADS) {
        const int d = i & 1023, b = (i >> 10) % NBATCH, lk = i / (NBATCH * D), l = lk / 3, k = lk % 3;
        gmt[i] = a.norm_g[(l * 3 + k) * D + d] * (1.0f + mod[((size_t)l * NBATCH + b) * NMOD + (3 * k + 1) * D + d]);
    }
    const int gw = bid * NWAVES + wave, NGW = G * NWAVES;
    for (int t = gw; t < 2 * 864; t += NGW) {
        const int l = t / 864, r = t % 864;
        int k, tile; if (r < 352) { k = 0; tile = r; } else if (r < 512) { k = 1; tile = r - 352; } else { k = 2; tile = r - 512; }
        const int Nk = (k == 1) ? DIN : NUP;
        const bf16_t* WT = (k == 1) ? (const bf16_t*)(a.ws + WS_WINT) + (size_t)l * DIN * D : (const bf16_t*)(a.ws + WS_W1T) + (size_t)(l * 2 + (k == 2 ? 1 : 0)) * NUP * D;
        float* Sout = (float*)(a.ws + WS_SV) + (size_t)l * SV_LAYER + (k == 0 ? 0 : (k == 1 ? NBATCH * NUP : NBATCH * (NUP + DIN)));
        const int p0 = tile * 16, ii = lane & 15, kq = lane >> 4;
        const bf16_t* xrow = WT + (size_t)(p0 + ii) * D + kq * 8;
        const float* yrow = mod + ((size_t)l * NBATCH + (ii < NBATCH ? ii : 0)) * NMOD + (3 * k) * D + kq * 8;
        const float ymask = ii < NBATCH ? 1.0f : 0.0f;
        f32x4 sacc = (f32x4){0.f, 0.f, 0.f, 0.f};
#pragma unroll 8
        for (int ks = 0; ks < 32; ++ks) {
            const bf16x8 xf = *(const bf16x8*)(xrow + ks * 32);
            const f32x4 y0 = *(const f32x4*)(yrow + ks * 32) * ymask, y1 = *(const f32x4*)(yrow + ks * 32 + 4) * ymask;
            u32x4 yp; yp.x = cvt_pk_bf16(y0[0], y0[1]); yp.y = cvt_pk_bf16(y0[2], y0[3]); yp.z = cvt_pk_bf16(y1[0], y1[1]); yp.w = cvt_pk_bf16(y1[2], y1[3]);
            sacc = __builtin_amdgcn_mfma_f32_16x16x32_bf16(xf, __builtin_bit_cast(bf16x8, yp), sacc, 0, 0, 0);
        }
        if (ii < NBATCH) *(f32x4*)(Sout + (size_t)ii * Nk + p0 + 4 * kq) = sacc;
    }
    const float* gm0 = nullptr; (void)gm0;
    bf16_t* xg = (bf16_t*)(a.ws + WS_XG); float* rss = (float*)(a.ws + WS_RSS);
#pragma unroll 2
    for (int r = gw; r < MTOT; r += NGW) {
        const int b = batch_of(r);
        const float* xr = r < MP ? a.xp + (size_t)r * D : a.xs + (size_t)(r - MP) * D;
        float ss = 0.f; f32x4 v[4];
#pragma unroll
        for (int j = 0; j < 4; ++j) { v[j] = *(const f32x4*)(xr + 4 * lane + 256 * j); ss += (v[j][0] * v[j][0] + v[j][1] * v[j][1]) + (v[j][2] * v[j][2] + v[j][3] * v[j][3]); }
        ss = wave_sum(ss);
        if (lane < 16) rss[(size_t)r * 16 + lane] = lane == 0 ? ss : 0.f;
#pragma unroll
        for (int j = 0; j < 4; ++j) { const int d = 4 * lane + 256 * j;
            const f32x4 g = *(const f32x4*)(a.norm_g + d); const f32x4 sc = *(const f32x4*)(mod + (size_t)b * NMOD + D + d);
            const f32x4 o = v[j] * (g * (sc + 1.0f));
            u32x2 w; w.x = cvt_pk_bf16(o[0], o[1]); w.y = cvt_pk_bf16(o[2], o[3]); *(u32x2*)(xg + (size_t)r * D + d) = w; }
    }
}

__device__ __forceinline__ void phase_final(const Args& a, int bid, int G, int wave) {
    const int lane = pg8::lane_id_v();
    const int gw = bid * NWAVES + wave, NGW = G * NWAVES;
    const float* rss = (const float*)(a.ws + WS_RSS);
    f32x4 fg[4];
#pragma unroll
    for (int j = 0; j < 4; ++j) fg[j] = *(const f32x4*)(a.final_g + 4 * lane + 256 * j);
    for (int r = gw; r < MTOT; r += NGW) {
        float s = rss[(size_t)r * 16 + (lane & 15)];
        s += __shfl_xor(s, 1); s += __shfl_xor(s, 2); s += __shfl_xor(s, 4); s += __shfl_xor(s, 8);
        const float rs = rsqrtf(s * (1.0f / D) + EPS);
        float* xr = a.out + (size_t)r * D;
#pragma unroll
        for (int j = 0; j < 4; ++j) { f32x4 v = *(const f32x4*)(xr + 4 * lane + 256 * j); v = v * rs * fg[j]; *(f32x4*)(xr + 4 * lane + 256 * j) = v; }
    }
}

__device__ __forceinline__ bool seq_start(int t) { return t < MP ? (t & 4095) == 0 : (t & 16383) == 0; }
__device__ __forceinline__ void unpack8(const u32x4 w, float (&f)[8]) {
#pragma unroll
    for (int j = 0; j < 4; ++j) { f[2 * j] = bf_lo(w[j]); f[2 * j + 1] = bf_hi(w[j]); }
}
constexpr int VT_LD = 136;
__device__ __forceinline__ void phase_mixer(const Args& a, LAS unsigned char* lds, int l, int bid, int G, int dostore, int wave) {
    const int lane = pg8::lane_id_v(), tid = wave * 64 + lane, fr = lane & 15, fq = lane >> 4;
    bf16_t* Z = (bf16_t*)(a.ws + WS_ZH);
    const float* vst = (const float*)(a.ws + WS_VST);
    const float* convw = a.conv_w + (size_t)l * 3 * 512;
    const float* sgn = a.sg_norm_g + (size_t)l * 512;
    const bf16_t* wsg = (const bf16_t*)(a.ws + WS_WSG) + (size_t)l * 8 * 128 * 128;
    const float* sgb = a.sg_bs + (size_t)l * 8 * 128;
    const float* gg = a.grp_g + (size_t)l * 1024;
    LAS f32x2* st = (LAS f32x2*)lds;
    LAS bf16_t* vT = (LAS bf16_t*)(lds + 1024);
    for (int ch = bid; ch < MTOT / 128; ch += G) {
        const int r0 = ch * 128;
        if (tid < 128) {
            const f32x4* p = (const f32x4*)(vst + (size_t)(r0 + tid) * 16); float s1 = 0.f, s2 = 0.f;
#pragma unroll
            for (int i = 0; i < 4; ++i) { const f32x4 v = p[i]; s1 += v[0] + v[2]; s2 += v[1] + v[3]; }
            const float mean = s1 * (1.0f / 512.0f); const float var = fmaxf(s2 * (1.0f / 512.0f) - mean * mean, 0.f);
            st[tid] = (f32x2){mean, rsqrtf(var + EPS)};
        }
        {
            const int t0 = r0 + 16 * wave, c0 = 8 * lane;
            float w0[8], w1[8], w2[8], g8[8];
#pragma unroll
            for (int j = 0; j < 8; ++j) { w0[j] = convw[c0 + j]; w1[j] = convw[512 + c0 + j]; w2[j] = convw[1024 + c0 + j]; g8[j] = gg[c0 + j]; }
            float prev[8], cur[8], nxt[8];
            { u32x4 w = (u32x4){0u, 0u, 0u, 0u}; if (!seq_start(t0)) w = *(const u32x4*)(Z + (size_t)(t0 - 1) * ZW + 1024 + c0); unpack8(w, prev); }
            { const u32x4 w = *(const u32x4*)(Z + (size_t)t0 * ZW + 1024 + c0); unpack8(w, cur); }
#pragma unroll 4
            for (int i = 0; i < 16; ++i) {
                const int t = t0 + i;
                { u32x4 w = (u32x4){0u, 0u, 0u, 0u}; if (!(t + 1 >= MTOT || seq_start(t + 1))) w = *(const u32x4*)(Z + (size_t)(t + 1) * ZW + 1024 + c0); unpack8(w, nxt); }
                float bg[8]; { const u32x4 w = *(const u32x4*)(Z + (size_t)t * ZW + c0); unpack8(w, bg); }
                float y[8]; float ss = 0.f;
#pragma unroll
                for (int j = 0; j < 8; ++j) { y[j] = bg[j] * (w0[j] * prev[j] + w1[j] * cur[j] + w2[j] * nxt[j]); ss += y[j] * y[j]; }
                ss = wave_sum(ss);
                const float rs = rsqrtf(ss * (1.0f / 512.0f) + EPS);
                u32x4 o;
                o.x = cvt_pk_bf16(y[0] * rs * g8[0], y[1] * rs * g8[1]); o.y = cvt_pk_bf16(y[2] * rs * g8[2], y[3] * rs * g8[3]);
                o.z = cvt_pk_bf16(y[4] * rs * g8[4], y[5] * rs * g8[5]); o.w = cvt_pk_bf16(y[6] * rs * g8[6], y[7] * rs * g8[7]);
                if (dostore) *(u32x4*)(Z + (size_t)t * ZW + c0) = o;
#pragma unroll
                for (int j = 0; j < 8; ++j) { prev[j] = cur[j]; cur[j] = nxt[j]; }
            }
        }
        __syncthreads();
        f32x4 acc[8][4];
        float ss = 0.f;
        const int prow = 16 * wave + fr;
        const int sq = tid >> 3, sdc = tid & 7;
        u32x4 vw[2]; bf16x8 wf[4];
#pragma unroll
        for (int i = 0; i < 2; ++i) vw[i] = *(const u32x4*)(Z + (size_t)(r0 + sq + 64 * i) * ZW + 1536 + sdc * 8);
#pragma unroll
        for (int ks = 0; ks < 4; ++ks) wf[ks] = *(const bf16x8*)(wsg + ((size_t)prow) * 128 + fq * 8 + 32 * ks);
#pragma unroll
        for (int h = 0; h < 8; ++h) {
            LAS bf16_t* vb = vT + (h & 1) * 64 * VT_LD;
            const f32x4 ga = *(const f32x4*)(sgn + h * 64 + sdc * 8), gb = *(const f32x4*)(sgn + h * 64 + sdc * 8 + 4);
#pragma unroll
            for (int i = 0; i < 2; ++i) {
                const int q = sq + 64 * i;
                float f[8]; unpack8(vw[i], f);
                const f32x2 ms = st[q];
                const int qs = (((q >> 3) ^ sdc) << 3) | (q & 7);
#pragma unroll
                for (int j = 0; j < 8; ++j) { const float gj = j < 4 ? ga[j] : gb[j - 4]; const float vn = (f[j] - ms.x) * ms.y * gj; vb[(sdc * 8 + j) * VT_LD + qs] = (bf16_t)f2bf(vn); }
            }
            bf16x8 wcur[4];
#pragma unroll
            for (int ks = 0; ks < 4; ++ks) wcur[ks] = wf[ks];
            u32x2 uw[4];
#pragma unroll
            for (int nd = 0; nd < 4; ++nd) uw[nd] = *(const u32x2*)(Z + (size_t)(r0 + prow) * ZW + 512 + h * 64 + 16 * nd + 4 * fq);
            const float bias = sgb[h * 128 + prow];
            if (h + 1 < 8) {
#pragma unroll
                for (int i = 0; i < 2; ++i) vw[i] = *(const u32x4*)(Z + (size_t)(r0 + sq + 64 * i) * ZW + 1536 + (h + 1) * 64 + sdc * 8);
#pragma unroll
                for (int ks = 0; ks < 4; ++ks) wf[ks] = *(const bf16x8*)(wsg + ((size_t)((h + 1) * 128 + prow)) * 128 + fq * 8 + 32 * ks);
            }
            __syncthreads();
#pragma unroll
            for (int nd = 0; nd < 4; ++nd) {
                f32x4 c = (f32x4){0.f, 0.f, 0.f, 0.f};
                const int rowv = 16 * nd + fr, sw = (rowv >> 3) & 7;
#pragma unroll
                for (int ks = 0; ks < 4; ++ks) {
                    const bf16x8 vf = *(const LAS bf16x8*)(vb + rowv * VT_LD + (((fq + 4 * ks) ^ sw) << 3));
                    c = __builtin_amdgcn_mfma_f32_16x16x32_bf16(vf, wcur[ks], c, 0, 0, 0);
                }
                f32x4 y; y[0] = bf_lo(uw[nd].x) * (c[0] + bias); y[1] = bf_hi(uw[nd].x) * (c[1] + bias); y[2] = bf_lo(uw[nd].y) * (c[2] + bias); y[3] = bf_hi(uw[nd].y) * (c[3] + bias);
                ss += (y[0] * y[0] + y[1] * y[1]) + (y[2] * y[2] + y[3] * y[3]);
                acc[h][nd] = y;
            }
        }
        ss += __shfl_xor(ss, 16); ss += __shfl_xor(ss, 32);
        const float rs = rsqrtf(ss * (1.0f / 512.0f) + EPS);
#pragma unroll
        for (int h = 0; h < 8; ++h)
#pragma unroll
            for (int nd = 0; nd < 4; ++nd) {
                const int c = h * 64 + 16 * nd + 4 * fq;
                const f32x4 g = *(const f32x4*)(gg + 512 + c);
                const f32x4 o = acc[h][nd] * rs * g;
                u32x2 w; w.x = cvt_pk_bf16(o[0], o[1]); w.y = cvt_pk_bf16(o[2], o[3]);
                if (dostore) *(u32x2*)(Z + (size_t)(r0 + prow) * ZW + 512 + c) = w;
            }
        __syncthreads();
    }
}


#define XB_TMO      128
#define XB_XCNT(j)  (256  + 64 * (j))
#define XB_XSUB(j)  (1280 + 64 * (j))
#define XB_XGEN(j)  (2304 + 64 * (j))
#define XB_TOP      3328
#define XB_TOPGEN   3392
#define XCD_BAR_WORDS 3456
#define XB_SPIN_CAP (1u << 20)
__device__ __forceinline__ unsigned xb_ld(unsigned* p)              { return __hip_atomic_load(p, __ATOMIC_RELAXED, __HIP_MEMORY_SCOPE_AGENT); }
__device__ __forceinline__ unsigned xb_add(unsigned* p, unsigned v) { return __hip_atomic_fetch_add(p, v, __ATOMIC_RELAXED, __HIP_MEMORY_SCOPE_AGENT); }
__device__ __forceinline__ unsigned xb_xcc_id() { return (unsigned)__builtin_amdgcn_s_getreg((3 << 11) | 20) & 0xFu; }
#define XB_SPIN(cond, bar) do { unsigned _sp = 0; while (cond) { __builtin_amdgcn_s_sleep(1); \
    if ((++_sp & 255u) == 0u) { if (xb_ld(&(bar)[XB_TMO])) break; if (_sp > XB_SPIN_CAP) { atomicAdd(&(bar)[XB_TMO], 1u); break; } } } } while (0)
struct XcdBarrier { unsigned* bar; unsigned x; volatile LAS unsigned* st; };
__device__ __forceinline__ XcdBarrier xcd_barrier_post(unsigned* bar, volatile LAS unsigned* st, int wave) {
    XcdBarrier b; b.bar = bar; b.x = xb_xcc_id(); b.st = st;
    if (wave == 0 && pg8::lane_id_v() == 0) (void)xb_add(&bar[XB_XCNT(b.x)], 1u);
    return b;
}
__device__ __forceinline__ void xcd_barrier_complete(unsigned* bar, unsigned x, unsigned& nloc, unsigned& nx) {
    const unsigned G = gridDim.x * gridDim.y * gridDim.z;
    unsigned sum, cnt, mine, sp = 0u;
    for (;;) {
        sum = 0u; cnt = 0u; mine = 0u;
#pragma unroll
        for (unsigned j = 0; j < 16; ++j) { const unsigned c = xb_ld(&bar[XB_XCNT(j)]); sum += c; cnt += (c > 0u) ? 1u : 0u; mine = (j == x) ? c : mine; }
        if (sum == G) break;
        __builtin_amdgcn_s_sleep(1);
        if ((++sp & 255u) == 0u) { if (xb_ld(&bar[XB_TMO])) break; if (sp > XB_SPIN_CAP) { atomicAdd(&bar[XB_TMO], 1u); break; } }
    }
    nloc = mine > 0u ? mine : 1u; nx = cnt > 0u ? cnt : 1u;
}
__device__ __forceinline__ void xcd_barrier(const XcdBarrier& b, int wave) {
    asm volatile("s_waitcnt vmcnt(0)" ::: "memory");
    __syncthreads();
    if (wave == 0 && pg8::lane_id_v() == 0) {
        unsigned* bar = b.bar;
        __builtin_amdgcn_s_waitcnt(0);
        unsigned nloc = b.st[0], nx = b.st[1];
        if (nloc == 0u) { xcd_barrier_complete(bar, b.x, nloc, nx); b.st[0] = nloc; b.st[1] = nx; }
        const unsigned old = xb_add(&bar[XB_XSUB(b.x)], 1u);
        const unsigned gen = old / nloc;
        if (old + 1u == (gen + 1u) * nloc) {
            __builtin_amdgcn_fence(__ATOMIC_RELEASE, "agent");
            asm volatile("s_waitcnt vmcnt(0)" ::: "memory");
            const unsigned og = xb_add(&bar[XB_TOP], 1u);
            const unsigned tg = og / nx;
            if (og + 1u == (tg + 1u) * nx) xb_add(&bar[XB_TOPGEN], 1u);
            else XB_SPIN(xb_ld(&bar[XB_TOPGEN]) == tg, bar);
            __builtin_amdgcn_fence(__ATOMIC_ACQUIRE, "agent");
            xb_add(&bar[XB_XGEN(b.x)], 1u);
            asm volatile("s_waitcnt vmcnt(0)" ::: "memory");
        } else {
            XB_SPIN(xb_ld(&bar[XB_XGEN(b.x)]) == gen, bar);
            __builtin_amdgcn_fence(__ATOMIC_ACQUIRE, "agent");
            asm volatile("s_waitcnt vmcnt(0)" ::: "memory");
        }
    }
    __syncthreads();
}

__global__ void __launch_bounds__(NTHREADS, 2) fwd_megakernel(Args a) {
    extern __shared__ __attribute__((aligned(16))) unsigned char lds_raw[];
    LAS unsigned char* lds = (LAS unsigned char*)lds_raw;
    const int G = gridDim.x, bid = blockIdx.x;
    unsigned char* ws = a.ws;
    volatile LAS unsigned* bst = (volatile LAS unsigned*)(lds + 131072 + 512);
    if (threadIdx.x < 2) bst[threadIdx.x] = 0u;
    __syncthreads();
    XcdBarrier xbar; xbar.bar = (unsigned*)ws; xbar.x = 0; xbar.st = bst;
    const int wave = __builtin_amdgcn_readfirstlane(threadIdx.x >> 6);
    if (a.ph_hi - a.ph_lo > 1) xbar = xcd_barrier_post((unsigned*)ws, bst, wave);
    int ph0 = a.ph_lo;
    if (ph0 == 0 && a.ph_hi > 1) { phase_p0a(a, lds, bid, G, wave); cg::this_grid().sync(); ph0 = 1; }
#define GRID_SYNC(first) do { xcd_barrier(xbar, wave); } while (0)
    for (int ph = ph0; ph < a.ph_hi; ++ph) {
        int nrep = 1;
#if MK_PROBE == 1
        if (ph <= 1) nrep = 2;
#elif MK_PROBE == 2
        if (ph >= 2 && ph < NPHASES - 1) { const int s_ = (ph - 2) % 11; if (s_ == 0 || s_ == 2 || s_ == 7 || s_ == 9) nrep = 2; }
#elif MK_PROBE == 5
        if (ph >= 2 && ph < NPHASES - 1) { const int s_ = (ph - 2) % 11; if (s_ == 5) nrep = 2; }
#elif MK_PROBE == 6
        if (ph >= 2 && ph < NPHASES - 1) { const int s_ = (ph - 2) % 11; if (s_ == 1 || s_ == 3 || s_ == 6 || s_ == 8 || s_ == 10) nrep = 2; }
#elif MK_PROBE == 4
        if (ph >= 2 && ph < NPHASES - 1) { const int s_ = (ph - 2) % 11; if (s_ == 4) nrep = 2; }
#endif
        asm volatile("" : "+s"(nrep));
        for (int rep = 0; rep < nrep; ++rep) {
        int dostore = (rep + 1 == nrep) ? 1 : 0; dostore = __builtin_amdgcn_readfirstlane(dostore);
        if (ph == 0) phase_p0a(a, lds, bid, G, wave);
        else if (ph == 1) phase_p0b(a, lds, bid, G, wave);
        else if (ph == NPHASES - 1) phase_final(a, bid, G, wave);
        else {
            const int q = ph - 2, l = q / 11, s = q % 11;
            const float* mod_l = (const float*)(ws + WS_MOD) + (size_t)l * NBATCH * NMOD;
            const float* gmt = (const float*)(ws + WS_GM);
            const float* svl = (const float*)(ws + WS_SV) + (size_t)l * SV_LAYER;
            float* rss = (float*)(ws + WS_RSS);
            bf16_t* xg = (bf16_t*)(ws + WS_XG);
            bf16_t* zh = (bf16_t*)(ws + WS_ZH);
            if (s == 5) phase_mixer(a, lds, l, bid, G, dostore, wave);
            else if (s == 4) {
                pg8::Gemm g{xg, (const bf16_t*)(ws + WS_WINT) + (size_t)l * DIN * D, MTOT, DIN, D, D};
                pg8::StaticOrder S; S.init(MTOT, DIN, G, bid);
                EpiMixIn E{zh, rss, svl + NBATCH * NUP, (float*)(ws + WS_VST), lds + LDS_XOFF};
                pg8::gemm_phase<EpiMixIn, pg8::StaticOrder, true, true>(lds, g, S, E, wave);
            } else if (s == 6) {
                pg8::Gemm g{zh, (const bf16_t*)(ws + WS_WOUTT) + (size_t)l * D * D, MTOT, D, D, ZW};
                pg8::StaticOrder S; S.init(MTOT, D, G, bid);
                EpiRes E{a.xp, a.xs, 0, a.out, xg, rss, mod_l + 5 * D, gmt + (size_t)(l * 3 + 2) * NBATCH * D, 1.0f, 0, dostore};
                pg8::gemm_phase<EpiRes, pg8::StaticOrder, true, true>(lds, g, S, E, wave);
            } else {
                const int f = s >= 7 ? 1 : 0, s2 = f ? s - 7 : s, half = s2 >> 1, rowbase = half * MP;
                if ((s2 & 1) == 0) {
                    pg8::Gemm g{xg + (size_t)rowbase * D, (const bf16_t*)(ws + WS_W1T) + (size_t)(l * 2 + f) * NUP * D, MP, NUP, D, D};
                    pg8::StaticOrder S; S.init(MP, NUP, G, bid);
                    EpiUp E{zh, rss, svl + (f ? NBATCH * (NUP + DIN) : 0), rowbase, lds + LDS_XOFF};
                    pg8::gemm_phase<EpiUp, pg8::StaticOrder, true, true>(lds, g, S, E, wave);
                } else {
                    pg8::Gemm g{zh, (const bf16_t*)(ws + WS_W2T) + (size_t)(l * 2 + f) * D * FF, MP, D, FF, FF};
                    pg8::StaticOrder S; S.init(MP, D, G, bid);
                    const float* gmn = f == 0 ? gmt + (size_t)(l * 3 + 1) * NBATCH * D : (l == 0 ? gmt + (size_t)3 * NBATCH * D : nullptr);
                    EpiRes E{a.xp, a.xs, (l == 0 && f == 0) ? 1 : 0, a.out, xg, rss, mod_l + (f ? 8 : 2) * D, gmn, 0.5f, rowbase, dostore};
                    pg8::gemm_phase<EpiRes, pg8::StaticOrder, true, true>(lds, g, S, E, wave);
                }
            }
        }
        if (rep + 1 < nrep) GRID_SYNC(0);
        }
        if (ph + 1 < a.ph_hi) GRID_SYNC(ph == a.ph_lo);
#if MK_PROBE == 3
        if (ph + 1 < a.ph_hi) GRID_SYNC(0);
#endif
    }
}

extern "C" void kernel_launch(void* const* d_in, const int* in_sizes, int n_in, void* d_out, int out_size, void* d_ws, size_t ws_size, hipStream_t stream) {
    static int grid = 0;
    if (grid == 0) {
        if (n_in != 17 || out_size != MTOT * D || ws_size < WS_END) { fprintf(stderr, "kernel_launch: unexpected shapes (n_in %d out %d ws %zu)\n", n_in, out_size, ws_size); grid = -1; return; }
        int dev = 0, cus = 0, per_cu = 0;
        hipGetDevice(&dev);
        hipDeviceGetAttribute(&cus, hipDeviceAttributeMultiprocessorCount, dev);
        if (hipFuncSetAttribute((const void*)fwd_megakernel, hipFuncAttributeMaxDynamicSharedMemorySize, LDS_BYTES) != hipSuccess) { fprintf(stderr, "kernel_launch: hipFuncSetAttribute failed\n"); grid = -1; return; }
        if (hipOccupancyMaxActiveBlocksPerMultiprocessor(&per_cu, (const void*)fwd_megakernel, NTHREADS, LDS_BYTES) != hipSuccess || per_cu < 1) { fprintf(stderr, "kernel_launch: occupancy query says %d\n", per_cu); per_cu = 1; }
        (void)hipGetLastError();
        grid = cus * per_cu;
        fprintf(stderr, "kernel_launch: grid %d (cus %d x %d)\n", grid, cus, per_cu);
    }
    if (grid < 0) return;
    Args a{};
    a.xp = (const float*)d_in[0]; a.xs = (const float*)d_in[1]; a.cp = (const float*)d_in[2]; a.cs = (const float*)d_in[3];
    a.ada_w = (const float*)d_in[4]; a.ada_b = (const float*)d_in[5]; a.norm_g = (const float*)d_in[6]; a.ffn_w1 = (const float*)d_in[7];
    a.ffn_w2 = (const float*)d_in[8]; a.mix_w_in = (const float*)d_in[9]; a.conv_w = (const float*)d_in[10]; a.sg_norm_g = (const float*)d_in[11];
    a.sg_ws = (const float*)d_in[12]; a.sg_bs = (const float*)d_in[13]; a.grp_g = (const float*)d_in[14]; a.mix_w_out = (const float*)d_in[15];
    a.final_g = (const float*)d_in[16];
    a.out = (float*)d_out; a.ws = (unsigned char*)d_ws;
#if MK_ONE_LAUNCH
    a.ph_lo = 0; a.ph_hi = NPHASES;
    if (hipMemsetAsync(d_ws, 0, XCD_BAR_WORDS * 4, stream) != hipSuccess) { fprintf(stderr, "kernel_launch: memset failed\n"); return; }
    void* args[] = {&a};
    hipError_t e = hipLaunchCooperativeKernel((const void*)fwd_megakernel, dim3(grid), dim3(NTHREADS), args, LDS_BYTES, stream);
    if (e != hipSuccess) fprintf(stderr, "cooperative launch failed: %s (grid %d)\n", hipGetErrorString(e), grid);
#else
    for (int ph = 0; ph < NPHASES; ++ph) {
        a.ph_lo = ph; a.ph_hi = ph + 1;
        hipLaunchKernelGGL(fwd_megakernel, dim3(grid), dim3(NTHREADS), LDS_BYTES, stream, a);
    }
#endif
}
```

```cpp
#include <hip/hip_runtime.h>
#include <hip/hip_cooperative_groups.h>
#include <cstdio>
#include <cstdint>
namespace cg = cooperative_groups;

#ifndef MK_PROBE
#define MK_PROBE 0
#endif
#ifndef MK_ONE_LAUNCH
#define MK_ONE_LAUNCH 1
#endif

constexpr int D = 1024, FF = 2816, NUP = 2 * FF, DIN = 2560, ZW = 2048;
constexpr int MTOT = 65536, MP = 32768;
constexpr int NBATCH = 10, NMOD = 9 * D;
constexpr float EPS = 1e-6f;
constexpr int NWAVES = 8, NTHREADS = 512;
constexpr int NPHASES = 25;

constexpr size_t MiB = 1u << 20;
constexpr size_t WS_MOD = 1 * MiB;
constexpr size_t WS_GM = 2 * MiB;
constexpr size_t WS_SV = 3 * MiB;
constexpr size_t WS_RSS = 5 * MiB;
constexpr size_t WS_VST = 9 * MiB;
constexpr size_t WS_WSG = 13 * MiB;
constexpr size_t WS_W1T = 14 * MiB;
constexpr size_t WS_W2T = 58 * MiB;
constexpr size_t WS_WINT = 80 * MiB;
constexpr size_t WS_WOUTT = 90 * MiB;
constexpr size_t WS_XG = 94 * MiB;
constexpr size_t WS_ZH = 222 * MiB;
constexpr size_t WS_END = 478 * MiB;
constexpr int SV_LAYER = NBATCH * (NUP + DIN + NUP);

constexpr int LDS_BYTES = 163840;
constexpr int LDS_RING = 8 * 16 * 1088;
constexpr int LDS_XOFF = LDS_RING + 1024;

namespace pg8 {
#define PG8_LAS __attribute__((address_space(3)))
typedef unsigned short bf16_t;
typedef short bf16x8 __attribute__((ext_vector_type(8)));
typedef float f32x4 __attribute__((ext_vector_type(4)));
typedef float f32x2 __attribute__((ext_vector_type(2)));
typedef unsigned u32x4 __attribute__((ext_vector_type(4)));
typedef unsigned u32x2 __attribute__((ext_vector_type(2)));
constexpr int BM = 256, BK = 64, HALF = 128, USTR = 1088, HTB = 16 * USTR, STAGE_BYTES = 8 * HTB, NXCD = 8, WGM = 8;

__host__ __device__ __forceinline__ int lds_byte(int r, int c) { const int st = (r >> 4) * 2 + (c >> 5), rr = r & 15, cc = c & 31, ob = rr * 64 + cc * 2; return st * 1024 + (ob ^ (((ob >> 9) & 1) << 5)); }
__host__ __device__ __forceinline__ void stage_rc(int b, int& R, int& C) { const int st = b / 1024, sb = b % 1024, swz = sb ^ (((sb >> 9) & 1) << 5); R = (st >> 1) * 16 + swz / 64; C = (st & 1) * 32 + (swz % 64) / 2; }
__host__ __device__ __forceinline__ int perm32(int rho) { const int n = rho >> 4, i = rho & 15; return 8 * (i >> 2) + 4 * n + (i & 3); }

struct Unit { int pm, pn; };
struct Gemm { const bf16_t* A; const bf16_t* Bt; int M, N, K, lda; };

struct StaticOrder {
    int nM, nN, nwg, G, c;
    __host__ __device__ void init(int M, int N, int G_, int c_) { nM = M / BM; nN = N / BM; nwg = nM * nN; G = G_; c = c_; }
    __host__ __device__ bool next(int i, Unit& u) const {
        const long L = (long)i * G + c; if (L >= nwg) return false;
        int wgid = (int)L; { const int q = nwg / NXCD, r = nwg % NXCD, xcd = wgid % NXCD, off = wgid / NXCD; wgid = (xcd < r ? xcd * (q + 1) : r * (q + 1) + (xcd - r) * q) + off; }
        const int nig = WGM * nN, gid = wgid / nig, fm = gid * WGM, gsz = (nM - fm) < WGM ? (nM - fm) : WGM;
        u.pm = fm + ((wgid % nig) % gsz); u.pn = (wgid % nig) / gsz; return true;
    }
};

__device__ __forceinline__ unsigned cvt_pk_bf16(float lo, float hi) { unsigned r; asm volatile("v_cvt_pk_bf16_f32 %0, %1, %2" : "=v"(r) : "v"(lo), "v"(hi)); return r; }
__device__ __forceinline__ f32x2 gelu_pk(f32x2 v) {
    const f32x2 av = __builtin_elementwise_abs(v), d = av * 0.2316418882f + 1.0f;
    f32x2 t; t.x = __builtin_amdgcn_rcpf(d.x); t.y = __builtin_amdgcn_rcpf(d.y);
    f32x2 q = t * 0.5307027145f + (-0.7265760135f); q = q * t + 0.7107068705f; q = q * t + (-0.142248368f); q = q * t + 0.127414796f; q = q * t;
    const f32x2 s = (v * v) * (-0.72134752044f);
    f32x2 e; e.x = __builtin_amdgcn_exp2f(s.x); e.y = __builtin_amdgcn_exp2f(s.y);
    const f32x2 m = v * (q * e), r = v - m;
    f32x2 o; o.x = v.x < 0.f ? m.x : r.x; o.y = v.y < 0.f ? m.y : r.y; return o;
}
__device__ __forceinline__ f32x4 gelu4(f32x4 v) { const f32x2 a = gelu_pk((f32x2){v[0], v[1]}), b = gelu_pk((f32x2){v[2], v[3]}); return (f32x4){a.x, a.y, b.x, b.y}; }
__device__ __forceinline__ float silu1(float g) { return g * __builtin_amdgcn_rcpf(1.0f + __builtin_amdgcn_exp2f(-1.4426950409f * g)); }
__device__ __forceinline__ f32x2 silu_mul_pk(f32x2 g, f32x2 u) {
    const f32x2 t = g * (-1.4426950409f);
    f32x2 e; e.x = __builtin_amdgcn_exp2f(t.x); e.y = __builtin_amdgcn_exp2f(t.y);
    const f32x2 d = e + 1.0f;
    f32x2 r; r.x = __builtin_amdgcn_rcpf(d.x); r.y = __builtin_amdgcn_rcpf(d.y);
    return (g * u) * r;
}

__device__ __forceinline__ int lane_id_v() { int l; asm volatile("v_mbcnt_lo_u32_b32 %0, -1, 0\n\tv_mbcnt_hi_u32_b32 %0, -1, %0" : "=v"(l)); return l; }
template <class Epi, class Sched, bool ALIGN_EPI, bool SP2>
__device__ __forceinline__ void gemm_phase(PG8_LAS unsigned char* lds, const Gemm g, const Sched& S, const Epi& E, int wid) {
    const int lane = lane_id_v(), tid = wid * 64 + lane;
    const int wr = wid >> 2, wc = wid & 3, fr = lane & 15, fq = lane >> 4;
    const int K = g.K, nt = K / BK, lda = g.lda;
    unsigned voffA[2], voffB[2];
#pragma unroll
    for (int i = 0; i < 2; ++i) { const int u_ = wid + 8 * i, rr_ = lane >> 3, ch_ = (lane & 7) ^ ((rr_ >> 1) & 3); const int R = u_ * 8 + rr_, C = ch_ * 8;
        const int Rb = Epi::PERM ? ((R & ~31) + perm32(R & 31)) : R;
        voffA[i] = (unsigned)(R * lda + C) * 2u; voffB[i] = (unsigned)(Rb * K + C) * 2u; }
    const size_t kstep = (size_t)(BK * 2);
    const size_t hstepA = (size_t)HALF * lda * 2, hstepB = (size_t)HALF * K * 2;
    const size_t tstepA = 2 * hstepA, tstepB = 2 * hstepB;
    const unsigned ldsw = (unsigned)wid * (unsigned)USTR;
    const int foff = (fr >> 3) * USTR + (fr & 7) * 128 + ((fq ^ ((fr >> 1) & 3)) << 4);
    const int aoff = wr * 8 * USTR + foff, boff = wc * 4 * USTR + foff;
#define PG8_SA(b, h) (((b) * 2 + (h)) * HTB)
#define PG8_SB(b, h) ((4 + (b) * 2 + (h)) * HTB)
#define PG8_STAGE(bufoff, gbase, voff) do { _Pragma("unroll") for (int _i = 0; _i < 2; ++_i) \
        __builtin_amdgcn_global_load_lds((const unsigned*)((const char*)(gbase) + (voff)[_i]), (PG8_LAS unsigned*)(lds + (bufoff) + ldsw + _i * (8 * USTR)), 16, 0, 0); } while (0)
#define PG8_LDA(dst, b, h) do { _Pragma("unroll") for (int m = 0; m < 4; ++m) _Pragma("unroll") for (int k = 0; k < 2; ++k) dst[m][k] = *(const PG8_LAS bf16x8*)(lds + PG8_SA(b, h) + aoff + m * (2 * USTR) + k * 64); } while (0)
#define PG8_LDB(dst, b, h) do { _Pragma("unroll") for (int n = 0; n < 2; ++n) _Pragma("unroll") for (int k = 0; k < 2; ++k) dst[n][k] = *(const PG8_LAS bf16x8*)(lds + PG8_SB(b, h) + boff + n * (2 * USTR) + k * 64); } while (0)
#define PG8_MMA(ai, bj, At, Bt) do { __builtin_amdgcn_s_setprio(1); _Pragma("unroll") for (int m = 0; m < 4; ++m) _Pragma("unroll") for (int n = 0; n < 2; ++n) _Pragma("unroll") for (int k = 0; k < 2; ++k) \
        acc[ai][bj][m][n] = __builtin_amdgcn_mfma_f32_16x16x32_bf16(Bt[n][k], At[m][k], acc[ai][bj][m][n], 0, 0, 0); __builtin_amdgcn_s_setprio(0); } while (0)
#define PG8_WAIT_V(n) asm volatile("s_waitcnt vmcnt(" #n ")" ::: "memory")
#define PG8_WAIT_L(n) asm volatile("s_waitcnt lgkmcnt(" #n ")" ::: "memory")
#define PG8_BAR __builtin_amdgcn_s_barrier()
#define PG8_SCHED __builtin_amdgcn_sched_barrier(0)
    Unit cur, nxt; int ui = 0;
    if (!S.next(0, cur)) return;
    f32x4 acc[2][2][4][2];
#pragma unroll
    for (int a = 0; a < 2; ++a)
#pragma unroll
        for (int b = 0; b < 2; ++b)
#pragma unroll
            for (int m = 0; m < 4; ++m)
#pragma unroll
                for (int n = 0; n < 2; ++n) acc[a][b][m][n] = (f32x4){0.f, 0.f, 0.f, 0.f};
    bf16x8 At[4][2], B0[2][2], B1[2][2];
    const char* cA = (const char*)g.A + (size_t)cur.pm * tstepA; const char* cB = (const char*)g.Bt + (size_t)cur.pn * tstepB;
    if constexpr (SP2) {
        PG8_STAGE(PG8_SB(0, 0), cB, voffB); PG8_STAGE(PG8_SB(0, 1), cB + hstepB, voffB); PG8_STAGE(PG8_SA(0, 0), cA, voffA); PG8_STAGE(PG8_SA(0, 1), cA + hstepA, voffA);
        if (wr == 1) PG8_BAR;
        PG8_WAIT_V(2); PG8_BAR;
        PG8_STAGE(PG8_SB(1, 0), cB + kstep, voffB); PG8_STAGE(PG8_SA(1, 0), cA + kstep, voffA); PG8_STAGE(PG8_SB(1, 1), cB + hstepB + kstep, voffB);
        PG8_WAIT_V(6); PG8_BAR;
    } else {
        PG8_STAGE(PG8_SB(0, 0), cB, voffB); PG8_STAGE(PG8_SA(0, 0), cA, voffA); PG8_STAGE(PG8_SB(0, 1), cB + hstepB, voffB); PG8_STAGE(PG8_SA(0, 1), cA + hstepA, voffA);
        if (wr == 1) PG8_BAR;
        PG8_WAIT_V(4); PG8_BAR;
        PG8_STAGE(PG8_SB(1, 0), cB + kstep, voffB); PG8_STAGE(PG8_SA(1, 0), cA + kstep, voffA); PG8_STAGE(PG8_SB(1, 1), cB + hstepB + kstep, voffB);
        PG8_WAIT_V(6); PG8_BAR;
    }
    for (;;) {
        const bool has_next = S.next(ui + 1, nxt);
        const char* nA = has_next ? (const char*)g.A + (size_t)nxt.pm * tstepA : cA; const char* nB = has_next ? (const char*)g.Bt + (size_t)nxt.pn * tstepB : cB;
        for (int t = 0; t < nt; t += 2) {
            const bool last = (t == nt - 2);
            const char* a1 = cA + (size_t)(t + 1) * kstep;
            const char* a2 = last ? nA : cA + (size_t)(t + 2) * kstep; const char* b2 = last ? nB : cB + (size_t)(t + 2) * kstep;
            const char* a3 = a2 + kstep; const char* b3 = b2 + kstep;
            if constexpr (Epi::PRE == 1) { if (last) {
                const char* rsrc; const char* ssrc; E.pre(cur, rsrc, ssrc);
#pragma unroll
                for (int _i = 0; _i < 2; ++_i) __builtin_amdgcn_global_load_lds((const unsigned*)(rsrc + (wid + 8 * _i) * 1024 + lane * 16), (PG8_LAS unsigned*)(lds + LDS_XOFF + (wid + 8 * _i) * 1024), 16, 0, 0);
                if (wid == 0) __builtin_amdgcn_global_load_lds((const unsigned*)(ssrc + lane * 16), (PG8_LAS unsigned*)(lds + LDS_XOFF + 16384), 16, 0, 0);
            } }
            if constexpr (SP2) {
            PG8_LDB(B0, 0, 0); PG8_LDB(B1, 0, 1); PG8_SCHED; PG8_LDA(At, 0, 0); PG8_STAGE(PG8_SA(1, 1), a1 + hstepA, voffA);
            PG8_WAIT_V(8); PG8_WAIT_L(0); PG8_BAR; PG8_MMA(0, 0, At, B0); PG8_MMA(0, 1, At, B1); PG8_BAR; PG8_SCHED;
            PG8_LDA(At, 0, 1); PG8_STAGE(PG8_SB(0, 0), b2, voffB); PG8_STAGE(PG8_SB(0, 1), b2 + hstepB, voffB); PG8_STAGE(PG8_SA(0, 0), a2, voffA);
            PG8_WAIT_V(8); PG8_WAIT_L(0); PG8_BAR; PG8_MMA(1, 0, At, B0); PG8_MMA(1, 1, At, B1); PG8_BAR; PG8_SCHED;
            PG8_LDB(B0, 1, 0); PG8_LDB(B1, 1, 1); PG8_SCHED; PG8_LDA(At, 1, 0); PG8_STAGE(PG8_SA(0, 1), a2 + hstepA, voffA);
            PG8_WAIT_V(8); PG8_WAIT_L(0); PG8_BAR; PG8_MMA(0, 0, At, B0); PG8_MMA(0, 1, At, B1); PG8_BAR; PG8_SCHED;
            PG8_LDA(At, 1, 1); PG8_STAGE(PG8_SB(1, 0), b3, voffB); PG8_STAGE(PG8_SB(1, 1), b3 + hstepB, voffB); PG8_STAGE(PG8_SA(1, 0), a3, voffA);
            PG8_WAIT_V(8); PG8_WAIT_L(0); PG8_BAR; PG8_MMA(1, 0, At, B0); PG8_MMA(1, 1, At, B1); PG8_BAR; PG8_SCHED;
            } else {
            PG8_LDB(B0, 0, 0); PG8_SCHED; PG8_LDA(At, 0, 0); PG8_STAGE(PG8_SA(1, 1), a1 + hstepA, voffA);
            PG8_WAIT_L(8); PG8_BAR; PG8_WAIT_L(0); PG8_MMA(0, 0, At, B0); PG8_BAR; PG8_SCHED;
            PG8_LDB(B1, 0, 1); PG8_STAGE(PG8_SB(0, 0), b2, voffB);
            PG8_BAR; PG8_WAIT_L(0); PG8_MMA(0, 1, At, B1); PG8_BAR;
            PG8_LDA(At, 0, 1); PG8_STAGE(PG8_SA(0, 0), a2, voffA);
            PG8_BAR; PG8_WAIT_L(0); PG8_MMA(1, 0, At, B0); PG8_BAR; PG8_SCHED;
            PG8_STAGE(PG8_SB(0, 1), b2 + hstepB, voffB);
            PG8_WAIT_V(6); PG8_BAR; PG8_MMA(1, 1, At, B1); PG8_BAR;
            PG8_LDB(B0, 1, 0); PG8_SCHED; PG8_LDA(At, 1, 0); PG8_STAGE(PG8_SA(0, 1), a2 + hstepA, voffA);
            PG8_WAIT_L(8); PG8_BAR; PG8_WAIT_L(0); PG8_MMA(0, 0, At, B0); PG8_BAR; PG8_SCHED;
            PG8_LDB(B1, 1, 1); PG8_STAGE(PG8_SB(1, 0), b3, voffB);
            PG8_BAR; PG8_WAIT_L(0); PG8_MMA(0, 1, At, B1); PG8_BAR;
            PG8_LDA(At, 1, 1); PG8_STAGE(PG8_SA(1, 0), a3, voffA);
            PG8_BAR; PG8_WAIT_L(0); PG8_MMA(1, 0, At, B0); PG8_BAR; PG8_SCHED;
            PG8_STAGE(PG8_SB(1, 1), b3 + hstepB, voffB);
            PG8_WAIT_V(6); PG8_BAR; PG8_MMA(1, 1, At, B1); PG8_BAR;
            }
        }
        if constexpr (ALIGN_EPI) { if (wr == 0) PG8_BAR; }
        E(acc, cur, wr, wc, fr, fq);
        if (!has_next) break;
#pragma unroll
        for (int a = 0; a < 2; ++a)
#pragma unroll
            for (int b = 0; b < 2; ++b)
#pragma unroll
                for (int m = 0; m < 4; ++m)
#pragma unroll
                    for (int n = 0; n < 2; ++n) acc[a][b][m][n] = (f32x4){0.f, 0.f, 0.f, 0.f};
        cur = nxt; cA = nA; cB = nB; ++ui;
        if constexpr (ALIGN_EPI) { if (wr == 1) PG8_BAR; }
    }
    PG8_WAIT_V(0);
    if constexpr (!ALIGN_EPI) { if (wr == 0) PG8_BAR; }
    PG8_BAR;
#undef PG8_SA
#undef PG8_SB
#undef PG8_STAGE
#undef PG8_LDA
#undef PG8_LDB
#undef PG8_MMA
#undef PG8_WAIT_V
#undef PG8_WAIT_L
#undef PG8_BAR
#undef PG8_SCHED
}
}

using pg8::bf16_t; using pg8::f32x4; using pg8::f32x2; using pg8::u32x4; using pg8::u32x2; using pg8::bf16x8; using pg8::cvt_pk_bf16;
#define LAS __attribute__((address_space(3)))

__device__ __forceinline__ int batch_of(int r) { return r < MP ? (r >> 12) : 8 + ((r - MP) >> 14); }
__device__ __forceinline__ float wave_sum(float v) {
#pragma unroll
    for (int o = 1; o < 64; o <<= 1) v += __shfl_xor(v, o);
    return v;
}
__device__ __forceinline__ float bf_lo(unsigned w) { return __uint_as_float(w << 16); }
__device__ __forceinline__ float bf_hi(unsigned w) { return __uint_as_float(w & 0xffff0000u); }
__device__ __forceinline__ float row_rstd(const float* rss, int row, int fq) {
    const f32x4 p = *(const f32x4*)(rss + (size_t)row * 16 + 4 * fq);
    float s = (p[0] + p[1]) + (p[2] + p[3]);
    s += __shfl_xor(s, 16); s += __shfl_xor(s, 32);
    return rsqrtf(s * (1.0f / D) + EPS);
}

__device__ __forceinline__ void rows_rstd8(const float* rss, int row0, int fq, float (&rs)[8]) {
    f32x4 pr[8];
#pragma unroll
    for (int i = 0; i < 8; ++i) pr[i] = *(const f32x4*)(rss + (size_t)(row0 + (i >> 2) * 128 + (i & 3) * 16) * 16 + 4 * fq);
#pragma unroll
    for (int i = 0; i < 8; ++i) { float t = (pr[i][0] + pr[i][1]) + (pr[i][2] + pr[i][3]); t += __shfl_xor(t, 16); t += __shfl_xor(t, 32); rs[i] = rsqrtf(t * (1.0f / D) + EPS); }
}
__device__ __forceinline__ void rows_rstd8_lds(const LAS unsigned char* xl, int lrow0, int fq, float (&rs)[8]) {
#pragma unroll
    for (int i = 0; i < 8; ++i) { const f32x4 p = *(const LAS f32x4*)(xl + (lrow0 + (i >> 2) * 128 + (i & 3) * 16) * 64 + 16 * fq);
        float t = (p[0] + p[1]) + (p[2] + p[3]); t += __shfl_xor(t, 16); t += __shfl_xor(t, 32); rs[i] = rsqrtf(t * (1.0f / D) + EPS); }
}
struct EpiUp {
    static constexpr bool PERM = true; static constexpr int PRE = 1;
    bf16_t* H; const float* rss; const float* S; int rowbase; LAS unsigned char* xl;
    __device__ __forceinline__ void pre(const pg8::Unit& u, const char*& rsrc, const char*& ssrc) const {
        rsrc = (const char*)(rss + (size_t)(rowbase + u.pm * 256) * 16); ssrc = (const char*)(S + (size_t)batch_of(rowbase + u.pm * 256) * NUP + u.pn * 256); }
    __device__ __forceinline__ void operator()(const f32x4 (&acc)[2][2][4][2], const pg8::Unit& u, int wr, int wc, int fr_, int fq_) const {
        const int lane_ = pg8::lane_id_v(); const int fr = lane_ & 15, fq = lane_ >> 4;
        const int lrow0 = u.pm * 256 + wr * 64 + fr;
        const int b = batch_of(rowbase + u.pm * 256);
        f32x4 sv[2][2];
#pragma unroll
        for (int bj = 0; bj < 2; ++bj)
#pragma unroll
            for (int n = 0; n < 2; ++n) sv[bj][n] = *(const LAS f32x4*)(xl + 16384 + (bj * 128 + wc * 32 + 8 * fq + 4 * n) * 4);
        float rs8[8]; rows_rstd8_lds(xl, wr * 64 + fr, fq, rs8);
        const int hcol = u.pn * 128 + wc * 32 + 8 * fq;
#pragma unroll
        for (int ai = 0; ai < 2; ++ai)
#pragma unroll
            for (int m = 0; m < 4; ++m) {
                const int lr = lrow0 + ai * 128 + m * 16;
                const float rs = rs8[ai * 4 + m];
                const f32x4 g0 = acc[ai][0][m][0] * rs + sv[0][0], g1 = acc[ai][0][m][1] * rs + sv[0][1];
                const f32x4 u0 = acc[ai][1][m][0] * rs + sv[1][0], u1 = acc[ai][1][m][1] * rs + sv[1][1];
                const f32x2 ha = pg8::silu_mul_pk((f32x2){g0[0], g0[1]}, (f32x2){u0[0], u0[1]}), hb = pg8::silu_mul_pk((f32x2){g0[2], g0[3]}, (f32x2){u0[2], u0[3]});
                const f32x2 hc = pg8::silu_mul_pk((f32x2){g1[0], g1[1]}, (f32x2){u1[0], u1[1]}), hd = pg8::silu_mul_pk((f32x2){g1[2], g1[3]}, (f32x2){u1[2], u1[3]});
                u32x4 w; w.x = cvt_pk_bf16(ha.x, ha.y); w.y = cvt_pk_bf16(hb.x, hb.y); w.z = cvt_pk_bf16(hc.x, hc.y); w.w = cvt_pk_bf16(hd.x, hd.y);
                *(u32x4*)(H + (size_t)lr * FF + hcol) = w;
            }
    }
};

#ifndef RES_DEPTH
#define RES_DEPTH 2
#endif
__device__ __forceinline__ f32x4 dpp_ror8(f32x4 v) { f32x4 r;
#pragma unroll
    for (int j = 0; j < 4; ++j) r[j] = __int_as_float(__builtin_amdgcn_update_dpp(0, __float_as_int(v[j]), 0x128, 0xF, 0xF, false));
    return r; }
__device__ __forceinline__ u32x2 dpp_ror8(u32x2 v) { u32x2 r; r.x = (unsigned)__builtin_amdgcn_update_dpp(0, (int)v.x, 0x128, 0xF, 0xF, false); r.y = (unsigned)__builtin_amdgcn_update_dpp(0, (int)v.y, 0x128, 0xF, 0xF, false); return r; }
struct EpiRes {
    static constexpr bool PERM = false; static constexpr int PRE = 0;
    __device__ __forceinline__ void pre(const pg8::Unit&, const char*&, const char*&) const {}
    const float* xp; const float* xs; int first;
    float* out; bf16_t* xg; float* rss; const float* gate; const float* gm; float coef; int rowbase; int dostore;
    __device__ __forceinline__ void operator()(const f32x4 (&acc)[2][2][4][2], const pg8::Unit& u, int wr, int wc, int fr_, int fq_) const {
        const int lane_ = pg8::lane_id_v(); const int fr = lane_ & 15, fq = lane_ >> 4;
        const bool hi = (fr & 8) != 0; const int r8 = fr & 7;
        const int grow0 = rowbase + u.pm * 256 + wr * 64 + fr;
        const int mrow0 = rowbase + u.pm * 256 + wr * 64 + r8;
        const int b = batch_of(rowbase + u.pm * 256);
        const int col0 = u.pn * 256 + wc * 32 + 4 * fq;
        const int mcol = col0 + (hi ? 16 : 0);
        const float* rp0 = (first ? (mrow0 < MP ? xp + (size_t)mrow0 * D : xs + (size_t)(mrow0 - MP) * D) : out + (size_t)mrow0 * D) + mcol;
        f32x4 xi[RES_DEPTH][4];
#pragma unroll
        for (int r = 0; r < RES_DEPTH; ++r)
#pragma unroll
            for (int q = 0; q < 4; ++q) xi[r][q] = *(const f32x4*)(rp0 + (size_t)((r >> 2) * 128 + (r & 3) * 16 + (q & 1) * 8) * D + (q >> 1) * 128);
        const float* gp = gate + (size_t)b * NMOD + col0;
        f32x4 gv[2][2], mv[2][2];
#pragma unroll
        for (int bj = 0; bj < 2; ++bj)
#pragma unroll
            for (int n = 0; n < 2; ++n) { gv[bj][n] = *(const f32x4*)(gp + bj * 128 + n * 16) * coef;
                mv[bj][n] = gm ? *(const f32x4*)(gm + b * D + col0 + bj * 128 + n * 16) : (f32x4){0.f, 0.f, 0.f, 0.f}; }
#pragma unroll
        for (int r = 0; r < 8; ++r) {
            const int ai = r >> 2, m = r & 3;
            const int grow = grow0 + ai * 128 + m * 16;
            const size_t mo0 = (size_t)(mrow0 + ai * 128 + m * 16) * D + mcol, mo1 = mo0 + (size_t)8 * D;
            f32x4 xo[2][2];
#pragma unroll
            for (int bj = 0; bj < 2; ++bj) {
                const f32x4 L1 = xi[r % RES_DEPTH][bj * 2], L2 = xi[r % RES_DEPTH][bj * 2 + 1];
                const f32x4 T = dpp_ror8(hi ? L1 : L2);
                const f32x4 x0 = hi ? T : L1, x1 = hi ? L2 : T;
                xo[bj][0] = x0 + gv[bj][0] * acc[ai][bj][m][0]; xo[bj][1] = x1 + gv[bj][1] * acc[ai][bj][m][1];
            }
            if (r + RES_DEPTH < 8) {
                const int r2 = r + RES_DEPTH;
#pragma unroll
                for (int q = 0; q < 4; ++q) xi[r % RES_DEPTH][q] = *(const f32x4*)(rp0 + (size_t)((r2 >> 2) * 128 + (r2 & 3) * 16 + (q & 1) * 8) * D + (q >> 1) * 128);
            }
            float ss = 0.f;
#pragma unroll
            for (int bj = 0; bj < 2; ++bj) {
                const f32x4 a0 = xo[bj][0], a1 = xo[bj][1];
                ss += ((a0[0] * a0[0] + a0[1] * a0[1]) + (a0[2] * a0[2] + a0[3] * a0[3])) + ((a1[0] * a1[0] + a1[1] * a1[1]) + (a1[2] * a1[2] + a1[3] * a1[3]));
                const f32x4 T2 = dpp_ror8(hi ? a0 : a1);
                const f32x4 d1 = hi ? T2 : a0, d2 = hi ? a1 : T2;
                *(f32x4*)(out + mo0 + bj * 128) = d1; *(f32x4*)(out + mo1 + bj * 128) = d2;
                if (gm) { const f32x4 o0 = a0 * mv[bj][0], o1 = a1 * mv[bj][1];
                    u32x2 w0, w1; w0.x = cvt_pk_bf16(o0[0], o0[1]); w0.y = cvt_pk_bf16(o0[2], o0[3]); w1.x = cvt_pk_bf16(o1[0], o1[1]); w1.y = cvt_pk_bf16(o1[2], o1[3]);
                    const u32x2 T3 = dpp_ror8(hi ? w0 : w1);
                    const u32x2 e1 = hi ? T3 : w0, e2 = hi ? w1 : T3;
                    *(u32x2*)(xg + mo0 + bj * 128) = e1; *(u32x2*)(xg + mo1 + bj * 128) = e2; }
            }
            ss += __shfl_xor(ss, 16); ss += __shfl_xor(ss, 32);
            if (fq == 0) rss[(size_t)grow * 16 + u.pn * 4 + wc] = ss;
        }
    }
};

struct EpiMixIn {
    static constexpr bool PERM = true; static constexpr int PRE = 1;
    bf16_t* Z; const float* rss; const float* S; float* vst; LAS unsigned char* xl;
    __device__ __forceinline__ void pre(const pg8::Unit& u, const char*& rsrc, const char*& ssrc) const {
        rsrc = (const char*)(rss + (size_t)(u.pm * 256) * 16); ssrc = (const char*)(S + (size_t)batch_of(u.pm * 256) * DIN + u.pn * 256); }
    __device__ __forceinline__ void operator()(const f32x4 (&acc)[2][2][4][2], const pg8::Unit& u, int wr, int wc, int fr_, int fq_) const {
        const int lane_ = pg8::lane_id_v(); const int fr = lane_ & 15, fq = lane_ >> 4;
        const int row0 = u.pm * 256 + wr * 64 + fr;
        const int b = batch_of(u.pm * 256);
        f32x4 sv[2][2];
#pragma unroll
        for (int bj = 0; bj < 2; ++bj)
#pragma unroll
            for (int n = 0; n < 2; ++n) sv[bj][n] = *(const LAS f32x4*)(xl + 16384 + (bj * 128 + wc * 32 + 8 * fq + 4 * n) * 4);
        float rs8[8]; rows_rstd8_lds(xl, wr * 64 + fr, fq, rs8);
        const int pn = u.pn;
        const int lc = wc * 32 + 8 * fq;
#pragma unroll
        for (int ai = 0; ai < 2; ++ai)
#pragma unroll
            for (int m = 0; m < 4; ++m) {
                const int row = row0 + ai * 128 + m * 16;
                const float rs = rs8[ai * 4 + m];
                f32x4 v00 = acc[ai][0][m][0] * rs + sv[0][0], v01 = acc[ai][0][m][1] * rs + sv[0][1];
                f32x4 v10 = acc[ai][1][m][0] * rs + sv[1][0], v11 = acc[ai][1][m][1] * rs + sv[1][1];
                bf16_t* zr = Z + (size_t)row * ZW;
                if (pn >= 2 && pn < 6) {
                    const f32x4 o0 = v00 * v10, o1 = v01 * v11;
                    u32x4 w; w.x = cvt_pk_bf16(o0[0], o0[1]); w.y = cvt_pk_bf16(o0[2], o0[3]); w.z = cvt_pk_bf16(o1[0], o1[1]); w.w = cvt_pk_bf16(o1[2], o1[3]);
                    *(u32x4*)(zr + 1024 + (pn - 2) * 128 + lc) = w;
                } else {
                    int cbase = pn * 256;
                    if (pn >= 6) {
                        v00 = pg8::gelu4(v00); v01 = pg8::gelu4(v01); v10 = pg8::gelu4(v10); v11 = pg8::gelu4(v11);
                        cbase = pn < 8 ? 512 + (pn - 6) * 256 : 1536 + (pn - 8) * 256;
                    }
                    u32x4 w0, w1;
                    w0.x = cvt_pk_bf16(v00[0], v00[1]); w0.y = cvt_pk_bf16(v00[2], v00[3]); w0.z = cvt_pk_bf16(v01[0], v01[1]); w0.w = cvt_pk_bf16(v01[2], v01[3]);
                    w1.x = cvt_pk_bf16(v10[0], v10[1]); w1.y = cvt_pk_bf16(v10[2], v10[3]); w1.z = cvt_pk_bf16(v11[0], v11[1]); w1.w = cvt_pk_bf16(v11[2], v11[3]);
                    *(u32x4*)(zr + cbase + lc) = w0;
                    *(u32x4*)(zr + cbase + 128 + lc) = w1;
                    if (pn >= 8) {
                        const f32x4 s4 = (v00 + v01) + (v10 + v11);
                        const f32x4 q4 = (v00 * v00 + v01 * v01) + (v10 * v10 + v11 * v11);
                        float s1 = (s4[0] + s4[1]) + (s4[2] + s4[3]), s2 = (q4[0] + q4[1]) + (q4[2] + q4[3]);
                        s1 += __shfl_xor(s1, 16); s1 += __shfl_xor(s1, 32); s2 += __shfl_xor(s2, 16); s2 += __shfl_xor(s2, 32);
                        if (fq == 0) *(f32x2*)(vst + (size_t)row * 16 + ((pn - 8) * 4 + wc) * 2) = (f32x2){s1, s2};
                    }
                }
            }
    }
};

struct Args {
    const float* xp; const float* xs; const float* cp; const float* cs; const float* ada_w; const float* ada_b; const float* norm_g;
    const float* ffn_w1; const float* ffn_w2; const float* mix_w_in; const float* conv_w; const float* sg_norm_g; const float* sg_ws;
    const float* sg_bs; const float* grp_g; const float* mix_w_out; const float* final_g;
    float* out; unsigned char* ws; int ph_lo, ph_hi;
};

__device__ __forceinline__ unsigned f2bf(float f) { unsigned u = __float_as_uint(f); return (u + 0x7fffu + ((u >> 16) & 1u)) >> 16; }
__device__ __forceinline__ unsigned pk2(float lo, float hi) { return f2bf(lo) | (f2bf(hi) << 16); }

__device__ __forceinline__ int map_col(int mode, int s) {
    if (mode == 1) { const int bj = s >= FF ? 1 : 0, h = s - bj * FF; return 256 * (h >> 7) + 128 * bj + (h & 127); }
    if (mode == 2) { if (s >= 512 && s < 1024) { const int q = s - 512; return 512 + 256 * (q >> 7) + (q & 127); }
                     if (s >= 1024 && s < 1536) { const int q = s - 1024; return 512 + 256 * (q >> 7) + 128 + (q & 127); } }
    return s;
}
__device__ __forceinline__ void transpose_item(const float* W, int K, int N, bf16_t* WT, int mode, LAS float* scr, int item, int lane) {
    const int nblk = N / 32, kb = item / nblk, nb = item % nblk, k0 = 64 * kb, n0 = 32 * nb, dn0 = map_col(mode, n0);
    float tv[32];
#pragma unroll
    for (int i = 0; i < 32; ++i) { const int kk = 2 * i + (lane >> 5); tv[i] = W[(size_t)(k0 + kk) * N + n0 + (lane & 31)]; }
#pragma unroll
    for (int i = 0; i < 32; ++i) { const int kk = 2 * i + (lane >> 5); scr[kk * 33 + (lane & 31)] = tv[i]; }
    asm volatile("s_waitcnt lgkmcnt(0)" ::: "memory");
    const int c = lane & 7;
#pragma unroll
    for (int j = 0; j < 4; ++j) { const int n = (lane >> 3) + 8 * j; const LAS float* s = scr + (8 * c) * 33 + n;
        u32x4 o; o.x = pk2(s[0 * 33], s[1 * 33]); o.y = pk2(s[2 * 33], s[3 * 33]); o.z = pk2(s[4 * 33], s[5 * 33]); o.w = pk2(s[6 * 33], s[7 * 33]);
        *(u32x4*)(WT + (size_t)(dn0 + n) * K + k0 + 8 * c) = o; }
    asm volatile("s_waitcnt lgkmcnt(0)" ::: "memory");
}

__device__ __forceinline__ void phase_p0a(const Args& a, LAS unsigned char* lds, int bid, int G, int wave) {
    const int lane = pg8::lane_id_v(), tid = wave * 64 + lane;
    LAS float* sc = (LAS float*)lds;
    LAS float* scr = (LAS float*)(lds + 49152 + wave * 10240);
    float* mod = (float*)(a.ws + WS_MOD);
    if (bid < 288) {
        for (int i = tid; i < NBATCH * D; i += NTHREADS) { const int b = i >> 10, k = i & 1023; const float c = b < 8 ? a.cp[b * D + k] : a.cs[(b - 8) * D + k]; sc[i] = c / (1.0f + __expf(-c)); }
        __syncthreads();
        for (int it = bid; it < 288; it += G) {
            const int l = it / 144, n0 = (it % 144) * 64;
            const float* W = a.ada_w + (size_t)l * D * NMOD + n0 + lane;
            float acc[NBATCH];
#pragma unroll
            for (int b = 0; b < NBATCH; ++b) acc[b] = 0.f;
#pragma unroll 16
            for (int kk = 0; kk < 128; ++kk) { const int k = wave * 128 + kk; const float w = W[(size_t)k * NMOD];
#pragma unroll
                for (int b = 0; b < NBATCH; ++b) acc[b] += sc[b * D + k] * w; }
#pragma unroll
            for (int b = 0; b < NBATCH; ++b) scr[b * 64 + lane] = acc[b];
            __syncthreads();
            for (int i = tid; i < NBATCH * 64; i += NTHREADS) { const int b = i >> 6, c = i & 63; float s = 0.f;
#pragma unroll
                for (int w = 0; w < NWAVES; ++w) s += ((LAS float*)(lds + 49152 + w * 10240))[b * 64 + c];
                mod[((size_t)l * NBATCH + b) * NMOD + n0 + c] = s + a.ada_b[(size_t)l * NMOD + n0 + c]; }
            __syncthreads();
        }
    }
    const int gw = bid * NWAVES + wave, NGW = G * NWAVES;
    constexpr int I_W1 = (D / 64) * (NUP / 32), I_W2 = (FF / 64) * (D / 32), I_WIN = (D / 64) * (DIN / 32), I_WOUT = (D / 64) * (D / 32);
    constexpr int NITEMS = 4 * I_W1 + 4 * I_W2 + 2 * I_WIN + 2 * I_WOUT;
    for (int it = gw; it < NITEMS; it += NGW) {
        int r = it;
        if (r < 4 * I_W1) { const int mi = r / I_W1; transpose_item(a.ffn_w1 + (size_t)mi * D * NUP, D, NUP, (bf16_t*)(a.ws + WS_W1T) + (size_t)mi * NUP * D, 1, scr, r % I_W1, lane); continue; } r -= 4 * I_W1;
        if (r < 4 * I_W2) { const int mi = r / I_W2; transpose_item(a.ffn_w2 + (size_t)mi * FF * D, FF, D, (bf16_t*)(a.ws + WS_W2T) + (size_t)mi * D * FF, 0, scr, r % I_W2, lane); continue; } r -= 4 * I_W2;
        if (r < 2 * I_WIN) { const int mi = r / I_WIN; transpose_item(a.mix_w_in + (size_t)mi * D * DIN, D, DIN, (bf16_t*)(a.ws + WS_WINT) + (size_t)mi * DIN * D, 2, scr, r % I_WIN, lane); continue; } r -= 2 * I_WIN;
        { const int mi = r / I_WOUT; transpose_item(a.mix_w_out + (size_t)mi * D * D, D, D, (bf16_t*)(a.ws + WS_WOUTT) + (size_t)mi * D * D, 0, scr, r % I_WOUT, lane); }
    }
    { const f32x4* src = (const f32x4*)a.sg_ws; u32x2* dst = (u32x2*)(a.ws + WS_WSG);
      for (int i = bid * NTHREADS + tid; i < 2 * 8 * 128 * 128 / 4; i += G * NTHREADS) { const f32x4 v = src[i]; u32x2 w; w.x = pk2(v[0], v[1]); w.y = pk2(v[2], v[3]); dst[i] = w; } }
}

__device__ __forceinline__ void phase_p0b(const Args& a, LAS unsigned char* lds, int bid, int G, int wave) {
    const int lane = pg8::lane_id_v(), tid = wave * 64 + lane;
    const float* mod = (const float*)(a.ws + WS_MOD);
    float* gmt = (float*)(a.ws + WS_GM);
    for (int i = bid * NTHREADS + tid; i < 6 * NBATCH * D; i += G * NTHREADS) {
        const int d = i & 1023, b = (i >> 10) % NBATCH, lk = i / (NBATCH * D), l = lk / 3, k = lk % 3;
        gmt[i] = a.norm_g[(l * 3 + k) * D + d] * (1.0f + mod[((size_t)l * NBATCH + b) * NMOD + (3 * k + 1) * D + d]);
    }
    const int gw = bid * NWAVES + wave, NGW = G * NWAVES;
    for (int t = gw; t < 2 * 864; t += NGW) {
        const int l = t / 864, r = t % 864;
        int k, tile; if (r < 352) { k = 0; tile = r; } else if (r < 512) { k = 1; tile = r - 352; } else { k = 2; tile = r - 512; }
        const int Nk = (k == 1) ? DIN : NUP;
        const bf16_t* WT = (k == 1) ? (const bf16_t*)(a.ws + WS_WINT) + (size_t)l * DIN * D : (const bf16_t*)(a.ws + WS_W1T) + (size_t)(l * 2 + (k == 2 ? 1 : 0)) * NUP * D;
        float* Sout = (float*)(a.ws + WS_SV) + (size_t)l * SV_LAYER + (k == 0 ? 0 : (k == 1 ? NBATCH * NUP : NBATCH * (NUP + DIN)));
        const int p0 = tile * 16, ii = lane & 15, kq = lane >> 4;
        const bf16_t* xrow = WT + (size_t)(p0 + ii) * D + kq * 8;
        const float* yrow = mod + ((size_t)l * NBATCH + (ii < NBATCH ? ii : 0)) * NMOD + (3 * k) * D + kq * 8;
        const float ymask = ii < NBATCH ? 1.0f : 0.0f;
        f32x4 sacc = (f32x4){0.f, 0.f, 0.f, 0.f};
#pragma unroll 8
        for (int ks = 0; ks < 32; ++ks) {
            const bf16x8 xf = *(const bf16x8*)(xrow + ks * 32);
            const f32x4 y0 = *(const f32x4*)(yrow + ks * 32) * ymask, y1 = *(const f32x4*)(yrow + ks * 32 + 4) * ymask;
            u32x4 yp; yp.x = cvt_pk_bf16(y0[0], y0[1]); yp.y = cvt_pk_bf16(y0[2], y0[3]); yp.z = cvt_pk_bf16(y1[0], y1[1]); yp.w = cvt_pk_bf16(y1[2], y1[3]);
            sacc = __builtin_amdgcn_mfma_f32_16x16x32_bf16(xf, __builtin_bit_cast(bf16x8, yp), sacc, 0, 0, 0);
        }
        if (ii < NBATCH) *(f32x4*)(Sout + (size_t)ii * Nk + p0 + 4 * kq) = sacc;
    }
    const float* gm0 = nullptr; (void)gm0;
    bf16_t* xg = (bf16_t*)(a.ws + WS_XG); float* rss = (float*)(a.ws + WS_RSS);
#pragma unroll 2
    for (int r = gw; r < MTOT; r += NGW) {
        const int b = batch_of(r);
        const float* xr = r < MP ? a.xp + (size_t)r * D : a.xs + (size_t)(r - MP) * D;
        float ss = 0.f; f32x4 v[4];
#pragma unroll
        for (int j = 0; j < 4; ++j) { v[j] = *(const f32x4*)(xr + 4 * lane + 256 * j); ss += (v[j][0] * v[j][0] + v[j][1] * v[j][1]) + (v[j][2] * v[j][2] + v[j][3] * v[j][3]); }
        ss = wave_sum(ss);
        if (lane < 16) rss[(size_t)r * 16 + lane] = lane == 0 ? ss : 0.f;
#pragma unroll
        for (int j = 0; j < 4; ++j) { const int d = 4 * lane + 256 * j;
            const f32x4 g = *(const f32x4*)(a.norm_g + d); const f32x4 sc = *(const f32x4*)(mod + (size_t)b * NMOD + D + d);
            const f32x4 o = v[j] * (g * (sc + 1.0f));
            u32x2 w; w.x = cvt_pk_bf16(o[0], o[1]); w.y = cvt_pk_bf16(o[2], o[3]); *(u32x2*)(xg + (size_t)r * D + d) = w; }
    }
}

__device__ __forceinline__ void phase_final(const Args& a, int bid, int G, int wave) {
    const int lane = pg8::lane_id_v();
    const int gw = bid * NWAVES + wave, NGW = G * NWAVES;
    const float* rss = (const float*)(a.ws + WS_RSS);
    f32x4 fg[4];
#pragma unroll
    for (int j = 0; j < 4; ++j) fg[j] = *(const f32x4*)(a.final_g + 4 * lane + 256 * j);
    for (int r = gw; r < MTOT; r += NGW) {
        float s = rss[(size_t)r * 16 + (lane & 15)];
        s += __shfl_xor(s, 1); s += __shfl_xor(s, 2); s += __shfl_xor(s, 4); s += __shfl_xor(s, 8);
        const float rs = rsqrtf(s * (1.0f / D) + EPS);
        float* xr = a.out + (size_t)r * D;
#pragma unroll
        for (int j = 0; j < 4; ++j) { f32x4 v = *(const f32x4*)(xr + 4 * lane + 256 * j); v = v * rs * fg[j]; *(f32x4*)(xr + 4 * lane + 256 * j) = v; }
    }
}

__device__ __forceinline__ bool seq_start(int t) { return t < MP ? (t & 4095) == 0 : (t & 16383) == 0; }
__device__ __forceinline__ void unpack8(const u32x4 w, float (&f)[8]) {
#pragma unroll
    for (int j = 0; j < 4; ++j) { f[2 * j] = bf_lo(w[j]); f[2 * j + 1] = bf_hi(w[j]); }
}
constexpr int VT_LD = 136;
__device__ __forceinline__ void phase_mixer(const Args& a, LAS unsigned char* lds, int l, int bid, int G, int dostore, int wave) {
    const int lane = pg8::lane_id_v(), tid = wave * 64 + lane, fr = lane & 15, fq = lane >> 4;
    bf16_t* Z = (bf16_t*)(a.ws + WS_ZH);
    const float* vst = (const float*)(a.ws + WS_VST);
    const float* convw = a.conv_w + (size_t)l * 3 * 512;
    const float* sgn = a.sg_norm_g + (size_t)l * 512;
    const bf16_t* wsg = (const bf16_t*)(a.ws + WS_WSG) + (size_t)l * 8 * 128 * 128;
    const float* sgb = a.sg_bs + (size_t)l * 8 * 128;
    const float* gg = a.grp_g + (size_t)l * 1024;
    LAS f32x2* st = (LAS f32x2*)lds;
    LAS bf16_t* vT = (LAS bf16_t*)(lds + 1024);
    for (int ch = bid; ch < MTOT / 128; ch += G) {
        const int r0 = ch * 128;
        if (tid < 128) {
            const f32x4* p = (const f32x4*)(vst + (size_t)(r0 + tid) * 16); float s1 = 0.f, s2 = 0.f;
#pragma unroll
            for (int i = 0; i < 4; ++i) { const f32x4 v = p[i]; s1 += v[0] + v[2]; s2 += v[1] + v[3]; }
            const float mean = s1 * (1.0f / 512.0f); const float var = fmaxf(s2 * (1.0f / 512.0f) - mean * mean, 0.f);
            st[tid] = (f32x2){mean, rsqrtf(var + EPS)};
        }
        {
            const int t0 = r0 + 16 * wave, c0 = 8 * lane;
            float w0[8], w1[8], w2[8], g8[8];
#pragma unroll
            for (int j = 0; j < 8; ++j) { w0[j] = convw[c0 + j]; w1[j] = convw[512 + c0 + j]; w2[j] = convw[1024 + c0 + j]; g8[j] = gg[c0 + j]; }
            float prev[8], cur[8], nxt[8];
            { u32x4 w = (u32x4){0u, 0u, 0u, 0u}; if (!seq_start(t0)) w = *(const u32x4*)(Z + (size_t)(t0 - 1) * ZW + 1024 + c0); unpack8(w, prev); }
            { const u32x4 w = *(const u32x4*)(Z + (size_t)t0 * ZW + 1024 + c0); unpack8(w, cur); }
#pragma unroll 4
            for (int i = 0; i < 16; ++i) {
                const int t = t0 + i;
                { u32x4 w = (u32x4){0u, 0u, 0u, 0u}; if (!(t + 1 >= MTOT || seq_start(t + 1))) w = *(const u32x4*)(Z + (size_t)(t + 1) * ZW + 1024 + c0); unpack8(w, nxt); }
                float bg[8]; { const u32x4 w = *(const u32x4*)(Z + (size_t)t * ZW + c0); unpack8(w, bg); }
                float y[8]; float ss = 0.f;
#pragma unroll
                for (int j = 0; j < 8; ++j) { y[j] = bg[j] * (w0[j] * prev[j] + w1[j] * cur[j] + w2[j] * nxt[j]); ss += y[j] * y[j]; }
                ss = wave_sum(ss);
                const float rs = rsqrtf(ss * (1.0f / 512.0f) + EPS);
                u32x4 o;
                o.x = cvt_pk_bf16(y[0] * rs * g8[0], y[1] * rs * g8[1]); o.y = cvt_pk_bf16(y[2] * rs * g8[2], y[3] * rs * g8[3]);
                o.z = cvt_pk_bf16(y[4] * rs * g8[4], y[5] * rs * g8[5]); o.w = cvt_pk_bf16(y[6] * rs * g8[6], y[7] * rs * g8[7]);
                if (dostore) *(u32x4*)(Z + (size_t)t * ZW + c0) = o;
#pragma unroll
                for (int j = 0; j < 8; ++j) { prev[j] = cur[j]; cur[j] = nxt[j]; }
            }
        }
        __syncthreads();
        f32x4 acc[8][4];
        float ss = 0.f;
        const int prow = 16 * wave + fr;
        const int sq = tid >> 3, sdc = tid & 7;
        u32x4 vw[2]; bf16x8 wf[4];
#pragma unroll
        for (int i = 0; i < 2; ++i) vw[i] = *(const u32x4*)(Z + (size_t)(r0 + sq + 64 * i) * ZW + 1536 + sdc * 8);
#pragma unroll
        for (int ks = 0; ks < 4; ++ks) wf[ks] = *(const bf16x8*)(wsg + ((size_t)prow) * 128 + fq * 8 + 32 * ks);
#pragma unroll
        for (int h = 0; h < 8; ++h) {
            LAS bf16_t* vb = vT + (h & 1) * 64 * VT_LD;
            const f32x4 ga = *(const f32x4*)(sgn + h * 64 + sdc * 8), gb = *(const f32x4*)(sgn + h * 64 + sdc * 8 + 4);
#pragma unroll
            for (int i = 0; i < 2; ++i) {
                const int q = sq + 64 * i;
                float f[8]; unpack8(vw[i], f);
                const f32x2 ms = st[q];
                const int qs = (((q >> 3) ^ sdc) << 3) | (q & 7);
#pragma unroll
                for (int j = 0; j < 8; ++j) { const float gj = j < 4 ? ga[j] : gb[j - 4]; const float vn = (f[j] - ms.x) * ms.y * gj; vb[(sdc * 8 + j) * VT_LD + qs] = (bf16_t)f2bf(vn); }
            }
            bf16x8 wcur[4];
#pragma unroll
            for (int ks = 0; ks < 4; ++ks) wcur[ks] = wf[ks];
            u32x2 uw[4];
#pragma unroll
            for (int nd = 0; nd < 4; ++nd) uw[nd] = *(const u32x2*)(Z + (size_t)(r0 + prow) * ZW + 512 + h * 64 + 16 * nd + 4 * fq);
            const float bias = sgb[h * 128 + prow];
            if (h + 1 < 8) {
#pragma unroll
                for (int i = 0; i < 2; ++i) vw[i] = *(const u32x4*)(Z + (size_t)(r0 + sq + 64 * i) * ZW + 1536 + (h + 1) * 64 + sdc * 8);
#pragma unroll
                for (int ks = 0; ks < 4; ++ks) wf[ks] = *(const bf16x8*)(wsg + ((size_t)((h + 1) * 128 + prow)) * 128 + fq * 8 + 32 * ks);
            }
            __syncthreads();
#pragma unroll
            for (int nd = 0; nd < 4; ++nd) {
                f32x4 c = (f32x4){0.f, 0.f, 0.f, 0.f};
                const int rowv = 16 * nd + fr, sw = (rowv >> 3) & 7;
#pragma unroll
                for (int ks = 0; ks < 4; ++ks) {
                    const bf16x8 vf = *(const LAS bf16x8*)(vb + rowv * VT_LD + (((fq + 4 * ks) ^ sw) << 3));
                    c = __builtin_amdgcn_mfma_f32_16x16x32_bf16(vf, wcur[ks], c, 0, 0, 0);
                }
                f32x4 y; y[0] = bf_lo(uw[nd].x) * (c[0] + bias); y[1] = bf_hi(uw[nd].x) * (c[1] + bias); y[2] = bf_lo(uw[nd].y) * (c[2] + bias); y[3] = bf_hi(uw[nd].y) * (c[3] + bias);
                ss += (y[0] * y[0] + y[1] * y[1]) + (y[2] * y[2] + y[3] * y[3]);
                acc[h][nd] = y;
            }
        }
        ss += __shfl_xor(ss, 16); ss += __shfl_xor(ss, 32);
        const float rs = rsqrtf(ss * (1.0f / 512.0f) + EPS);
#pragma unroll
        for (int h = 0; h < 8; ++h)
#pragma unroll
            for (int nd = 0; nd < 4; ++nd) {
                const int c = h * 64 + 16 * nd + 4 * fq;
                const f32x4 g = *(const f32x4*)(gg + 512 + c);
                const f32x4 o = acc[h][nd] * rs * g;
                u32x2 w; w.x = cvt_pk_bf16(o[0], o[1]); w.y = cvt_pk_bf16(o[2], o[3]);
                if (dostore) *(u32x2*)(Z + (size_t)(r0 + prow) * ZW + 512 + c) = w;
            }
        __syncthreads();
    }
}


#define XB_TMO      128
#define XB_XCNT(j)  (256  + 64 * (j))
#define XB_XSUB(j)  (1280 + 64 * (j))
#define XB_XGEN(j)  (2304 + 64 * (j))
#define XB_TOP      3328
#define XB_TOPGEN   3392
#define XCD_BAR_WORDS 3456
#define XB_SPIN_CAP (1u << 20)
__device__ __forceinline__ unsigned xb_ld(unsigned* p)              { return __hip_atomic_load(p, __ATOMIC_RELAXED, __HIP_MEMORY_SCOPE_AGENT); }
__device__ __forceinline__ unsigned xb_add(unsigned* p, unsigned v) { return __hip_atomic_fetch_add(p, v, __ATOMIC_RELAXED, __HIP_MEMORY_SCOPE_AGENT); }
__device__ __forceinline__ unsigned xb_xcc_id() { return (unsigned)__builtin_amdgcn_s_getreg((3 << 11) | 20) & 0xFu; }
#define XB_SPIN(cond, bar) do { unsigned _sp = 0; while (cond) { __builtin_amdgcn_s_sleep(1); \
    if ((++_sp & 255u) == 0u) { if (xb_ld(&(bar)[XB_TMO])) break; if (_sp > XB_SPIN_CAP) { atomicAdd(&(bar)[XB_TMO], 1u); break; } } } } while (0)
struct XcdBarrier { unsigned* bar; unsigned x; volatile LAS unsigned* st; };
__device__ __forceinline__ XcdBarrier xcd_barrier_post(unsigned* bar, volatile LAS unsigned* st, int wave) {
    XcdBarrier b; b.bar = bar; b.x = xb_xcc_id(); b.st = st;
    if (wave == 0 && pg8::lane_id_v() == 0) (void)xb_add(&bar[XB_XCNT(b.x)], 1u);
    return b;
}
__device__ __forceinline__ void xcd_barrier_complete(unsigned* bar, unsigned x, unsigned& nloc, unsigned& nx) {
    const unsigned G = gridDim.x * gridDim.y * gridDim.z;
    unsigned sum, cnt, mine, sp = 0u;
    for (;;) {
        sum = 0u; cnt = 0u; mine = 0u;
#pragma unroll
        for (unsigned j = 0; j < 16; ++j) { const unsigned c = xb_ld(&bar[XB_XCNT(j)]); sum += c; cnt += (c > 0u) ? 1u : 0u; mine = (j == x) ? c : mine; }
        if (sum == G) break;
        __builtin_amdgcn_s_sleep(1);
        if ((++sp & 255u) == 0u) { if (xb_ld(&bar[XB_TMO])) break; if (sp > XB_SPIN_CAP) { atomicAdd(&bar[XB_TMO], 1u); break; } }
    }
    nloc = mine > 0u ? mine : 1u; nx = cnt > 0u ? cnt : 1u;
}
__device__ __forceinline__ void xcd_barrier(const XcdBarrier& b, int wave) {
    asm volatile("s_waitcnt vmcnt(0)" ::: "memory");
    __syncthreads();
    if (wave == 0 && pg8::lane_id_v() == 0) {
        unsigned* bar = b.bar;
        __builtin_amdgcn_s_waitcnt(0);
        unsigned nloc = b.st[0], nx = b.st[1];
        if (nloc == 0u) { xcd_barrier_complete(bar, b.x, nloc, nx); b.st[0] = nloc; b.st[1] = nx; }
        const unsigned old = xb_add(&bar[XB_XSUB(b.x)], 1u);
        const unsigned gen = old / nloc;
        if (old + 1u == (gen + 1u) * nloc) {
            __builtin_amdgcn_fence(__ATOMIC_RELEASE, "agent");
            asm volatile("s_waitcnt vmcnt(0)" ::: "memory");
            const unsigned og = xb_add(&bar[XB_TOP], 1u);
            const unsigned tg = og / nx;
            if (og + 1u == (tg + 1u) * nx) xb_add(&bar[XB_TOPGEN], 1u);
            else XB_SPIN(xb_ld(&bar[XB_TOPGEN]) == tg, bar);
            __builtin_amdgcn_fence(__ATOMIC_ACQUIRE, "agent");
            xb_add(&bar[XB_XGEN(b.x)], 1u);
            asm volatile("s_waitcnt vmcnt(0)" ::: "memory");
        } else {
            XB_SPIN(xb_ld(&bar[XB_XGEN(b.x)]) == gen, bar);
            __builtin_amdgcn_fence(__ATOMIC_ACQUIRE, "agent");
            asm volatile("s_waitcnt vmcnt(0)" ::: "memory");
        }
    }
    __syncthreads();
}

__global__ void __launch_bounds__(NTHREADS, 2) fwd_megakernel(Args a) {
    extern __shared__ __attribute__((aligned(16))) unsigned char lds_raw[];
    LAS unsigned char* lds = (LAS unsigned char*)lds_raw;
    const int G = gridDim.x, bid = blockIdx.x;
    unsigned char* ws = a.ws;
    volatile LAS unsigned* bst = (volatile LAS unsigned*)(lds + LDS_RING + 512);
    if (threadIdx.x < 2) bst[threadIdx.x] = 0u;
    __syncthreads();
    XcdBarrier xbar; xbar.bar = (unsigned*)ws; xbar.x = 0; xbar.st = bst;
    const int wave = __builtin_amdgcn_readfirstlane(threadIdx.x >> 6);
    if (a.ph_hi - a.ph_lo > 1) xbar = xcd_barrier_post((unsigned*)ws, bst, wave);
    int ph0 = a.ph_lo;
    if (ph0 == 0 && a.ph_hi > 1) { phase_p0a(a, lds, bid, G, wave); cg::this_grid().sync(); ph0 = 1; }
#define GRID_SYNC(first) do { xcd_barrier(xbar, wave); } while (0)
    for (int ph = ph0; ph < a.ph_hi; ++ph) {
        int nrep = 1;
#if MK_PROBE == 1
        if (ph <= 1) nrep = 2;
#elif MK_PROBE == 2
        if (ph >= 2 && ph < NPHASES - 1) { const int s_ = (ph - 2) % 11; if (s_ == 0 || s_ == 2 || s_ == 7 || s_ == 9) nrep = 2; }
#elif MK_PROBE == 5
        if (ph >= 2 && ph < NPHASES - 1) { const int s_ = (ph - 2) % 11; if (s_ == 5) nrep = 2; }
#elif MK_PROBE == 6
        if (ph >= 2 && ph < NPHASES - 1) { const int s_ = (ph - 2) % 11; if (s_ == 1 || s_ == 3 || s_ == 6 || s_ == 8 || s_ == 10) nrep = 2; }
#elif MK_PROBE == 4
        if (ph >= 2 && ph < NPHASES - 1) { const int s_ = (ph - 2) % 11; if (s_ == 4) nrep = 2; }
#endif
        asm volatile("" : "+s"(nrep));
        for (int rep = 0; rep < nrep; ++rep) {
        int dostore = (rep + 1 == nrep) ? 1 : 0; dostore = __builtin_amdgcn_readfirstlane(dostore);
        if (ph == 0) phase_p0a(a, lds, bid, G, wave);
        else if (ph == 1) phase_p0b(a, lds, bid, G, wave);
        else if (ph == NPHASES - 1) phase_final(a, bid, G, wave);
        else {
            const int q = ph - 2, l = q / 11, s = q % 11;
            const float* mod_l = (const float*)(ws + WS_MOD) + (size_t)l * NBATCH * NMOD;
            const float* gmt = (const float*)(ws + WS_GM);
            const float* svl = (const float*)(ws + WS_SV) + (size_t)l * SV_LAYER;
            float* rss = (float*)(ws + WS_RSS);
            bf16_t* xg = (bf16_t*)(ws + WS_XG);
            bf16_t* zh = (bf16_t*)(ws + WS_ZH);
            if (s == 5) phase_mixer(a, lds, l, bid, G, dostore, wave);
            else if (s == 4) {
                pg8::Gemm g{xg, (const bf16_t*)(ws + WS_WINT) + (size_t)l * DIN * D, MTOT, DIN, D, D};
                pg8::StaticOrder S; S.init(MTOT, DIN, G, bid);
                EpiMixIn E{zh, rss, svl + NBATCH * NUP, (float*)(ws + WS_VST), lds + LDS_XOFF};
                pg8::gemm_phase<EpiMixIn, pg8::StaticOrder, true, true>(lds, g, S, E, wave);
            } else if (s == 6) {
                pg8::Gemm g{zh, (const bf16_t*)(ws + WS_WOUTT) + (size_t)l * D * D, MTOT, D, D, ZW};
                pg8::StaticOrder S; S.init(MTOT, D, G, bid);
                EpiRes E{a.xp, a.xs, 0, a.out, xg, rss, mod_l + 5 * D, gmt + (size_t)(l * 3 + 2) * NBATCH * D, 1.0f, 0, dostore};
                pg8::gemm_phase<EpiRes, pg8::StaticOrder, true, true>(lds, g, S, E, wave);
            } else {
                const int f = s >= 7 ? 1 : 0, s2 = f ? s - 7 : s, half = s2 >> 1, rowbase = half * MP;
                if ((s2 & 1) == 0) {
                    pg8::Gemm g{xg + (size_t)rowbase * D, (const bf16_t*)(ws + WS_W1T) + (size_t)(l * 2 + f) * NUP * D, MP, NUP, D, D};
                    pg8::StaticOrder S; S.init(MP, NUP, G, bid);
                    EpiUp E{zh, rss, svl + (f ? NBATCH * (NUP + DIN) : 0), rowbase, lds + LDS_XOFF};
                    pg8::gemm_phase<EpiUp, pg8::StaticOrder, true, true>(lds, g, S, E, wave);
                } else {
                    pg8::Gemm g{zh, (const bf16_t*)(ws + WS_W2T) + (size_t)(l * 2 + f) * D * FF, MP, D, FF, FF};
                    pg8::StaticOrder S; S.init(MP, D, G, bid);
                    const float* gmn = f == 0 ? gmt + (size_t)(l * 3 + 1) * NBATCH * D : (l == 0 ? gmt + (size_t)3 * NBATCH * D : nullptr);
                    EpiRes E{a.xp, a.xs, (l == 0 && f == 0) ? 1 : 0, a.out, xg, rss, mod_l + (f ? 8 : 2) * D, gmn, 0.5f, rowbase, dostore};
                    pg8::gemm_phase<EpiRes, pg8::StaticOrder, true, true>(lds, g, S, E, wave);
                }
            }
        }
        if (rep + 1 < nrep) GRID_SYNC(0);
        }
        if (ph + 1 < a.ph_hi) GRID_SYNC(ph == a.ph_lo);
#if MK_PROBE == 3
        if (ph + 1 < a.ph_hi) GRID_SYNC(0);
#endif
    }
}

extern "C" void kernel_launch(void* const* d_in, const int* in_sizes, int n_in, void* d_out, int out_size, void* d_ws, size_t ws_size, hipStream_t stream) {
    static int grid = 0;
    if (grid == 0) {
        if (n_in != 17 || out_size != MTOT * D || ws_size < WS_END) { fprintf(stderr, "kernel_launch: unexpected shapes (n_in %d out %d ws %zu)\n", n_in, out_size, ws_size); grid = -1; return; }
        int dev = 0, cus = 0, per_cu = 0;
        hipGetDevice(&dev);
        hipDeviceGetAttribute(&cus, hipDeviceAttributeMultiprocessorCount, dev);
        if (hipFuncSetAttribute((const void*)fwd_megakernel, hipFuncAttributeMaxDynamicSharedMemorySize, LDS_BYTES) != hipSuccess) { fprintf(stderr, "kernel_launch: hipFuncSetAttribute failed\n"); grid = -1; return; }
        if (hipOccupancyMaxActiveBlocksPerMultiprocessor(&per_cu, (const void*)fwd_megakernel, NTHREADS, LDS_BYTES) != hipSuccess || per_cu < 1) { fprintf(stderr, "kernel_launch: occupancy query says %d\n", per_cu); per_cu = 1; }
        (void)hipGetLastError();
        grid = cus * per_cu;
        fprintf(stderr, "kernel_launch: grid %d (cus %d x %d)\n", grid, cus, per_cu);
    }
    if (grid < 0) return;
    Args a{};
    a.xp = (const float*)d_in[0]; a.xs = (const float*)d_in[1]; a.cp = (const float*)d_in[2]; a.cs = (const float*)d_in[3];
    a.ada_w = (const float*)d_in[4]; a.ada_b = (const float*)d_in[5]; a.norm_g = (const float*)d_in[6]; a.ffn_w1 = (const float*)d_in[7];
    a.ffn_w2 = (const float*)d_in[8]; a.mix_w_in = (const float*)d_in[9]; a.conv_w = (const float*)d_in[10]; a.sg_norm_g = (const float*)d_in[11];
    a.sg_ws = (const float*)d_in[12]; a.sg_bs = (const float*)d_in[13]; a.grp_g = (const float*)d_in[14]; a.mix_w_out = (const float*)d_in[15];
    a.final_g = (const float*)d_in[16];
    a.out = (float*)d_out; a.ws = (unsigned char*)d_ws;
#if MK_ONE_LAUNCH
    a.ph_lo = 0; a.ph_hi = NPHASES;
    if (hipMemsetAsync(d_ws, 0, XCD_BAR_WORDS * 4, stream) != hipSuccess) { fprintf(stderr, "kernel_launch: memset failed\n"); return; }
    void* args[] = {&a};
    hipError_t e = hipLaunchCooperativeKernel((const void*)fwd_megakernel, dim3(grid), dim3(NTHREADS), args, LDS_BYTES, stream);
    if (e != hipSuccess) fprintf(stderr, "cooperative launch failed: %s (grid %d)\n", hipGetErrorString(e), grid);
#else
    for (int ph = 0; ph < NPHASES; ++ph) {
        a.ph_lo = ph; a.ph_hi = ph + 1;
        hipLaunchKernelGGL(fwd_megakernel, dim3(grid), dim3(NTHREADS), LDS_BYTES, stream, a);
    }
#endif
}
```
